# Optimizing an MI355X kernel written in HIP

```python
import math
import jax, jax.numpy as jnp
from jax import lax
import numpy as np

D_MODEL = 1024
BATCH = 8
SEQ = 4096
DEPTH = 4

N_MEM = 256
NORM_EPS = 1e-6
A_HEAD_DIM = 64
A_WIDTH = D_MODEL // 2
A_HEADS = A_WIDTH // A_HEAD_DIM
A_DECAY_LORA = 64
A_ICLR_LORA = 64
A_GATE_LORA = 128
A_COLS = 3 * A_WIDTH + A_DECAY_LORA + A_ICLR_LORA + A_GATE_LORA
A_GN_EPS = 64e-5
B_HEAD_DIM = 64
B_WIDTH = D_MODEL // 2
B_HEADS = B_WIDTH // B_HEAD_DIM
B_COLS = 4 * B_WIDTH
RET_CHUNK = 128
ROPE_BASE = 10000.0
HYB_COLS = A_COLS + B_COLS
C_HEAD_DIM = 64
C_V_DIM = 2 * C_HEAD_DIM
C_HEADS = D_MODEL // C_V_DIM
Q_BLOCK = 128
REL_BUCKETS = 32
REL_MAX_DIST = 128
X_HEADS = 4
X_HEAD_DIM = D_MODEL // X_HEADS
D_FF = 4 * D_MODEL
N_EVEN = (DEPTH + 1) // 2
N_ODD = DEPTH // 2

kernel_name = "hybrid_rwkv7_retnet_diffattn_trunk"


def rms_norm(x, w, eps=NORM_EPS):
    xf = x.astype(jnp.float32)
    y = xf * lax.rsqrt(jnp.mean(xf * xf, axis=-1, keepdims=True) + eps)
    return y.astype(x.dtype) * w


def group_norm(x, w, b, eps):
    xf = x.astype(jnp.float32)
    mu = jnp.mean(xf, axis=-1, keepdims=True)
    var = jnp.mean(jnp.square(xf - mu), axis=-1, keepdims=True)
    y = ((xf - mu) * lax.rsqrt(var + eps)).astype(x.dtype)
    h, d = x.shape[-2:]
    return y * w.reshape(h, d) + b.reshape(h, d)


def token_shift(x):
    return jnp.pad(x[:, :-1], ((0, 0), (1, 0), (0, 0)))


def rotary(x):
    s, d = x.shape[1], x.shape[-1]
    inv = ROPE_BASE ** (-jnp.arange(0, d, 2, dtype=jnp.float32) / d)
    ang = jnp.arange(s, dtype=jnp.float32)[:, None] * inv[None, :]
    cos = jnp.cos(ang)[None, :, None, :]
    sin = jnp.sin(ang)[None, :, None, :]
    x1, x2 = jnp.split(x, 2, axis=-1)
    return jnp.concatenate([x1 * cos - x2 * sin, x1 * sin + x2 * cos], axis=-1).astype(x.dtype)


def t5_bucket(rel):
    n = jnp.maximum(rel, 0)
    max_exact = REL_BUCKETS // 2
    large = max_exact + (jnp.log(jnp.maximum(n, max_exact).astype(jnp.float32) / max_exact)
                         / math.log(REL_MAX_DIST / max_exact) * (REL_BUCKETS - max_exact)).astype(jnp.int32)
    large = jnp.minimum(large, REL_BUCKETS - 1)
    return jnp.where(n < max_exact, n, large)


def wkv7_scan(r, w, k, v, a, b):
    dt = r.dtype
    bsz, _, h, n = r.shape
    xs = tuple(jnp.moveaxis(t.astype(jnp.float32), 1, 0) for t in (r, w, k, v, a, b))

    def step(state, inp):
        r_t, w_t, k_t, v_t, a_t, b_t = inp
        sa = jnp.einsum('bhvk,bhk->bhv', state, a_t)
        state = (state * w_t[:, :, None, :] + sa[..., None] * b_t[:, :, None, :]
                 + v_t[..., None] * k_t[:, :, None, :])
        return state, jnp.einsum('bhvk,bhk->bhv', state, r_t)

    s0 = jnp.zeros((bsz, h, n, n), jnp.float32)
    _, ys = lax.scan(step, s0, xs)
    return jnp.moveaxis(ys, 0, 1).astype(dt)


def rwkv7_time_mix(pa, mu, w0, w2, a0, a2, g2, k_k, k_a, r_k, ln_w, ln_b):
    bsz, s, _ = pa.shape
    pa = pa + (token_shift(pa) - pa) * mu
    c1 = A_WIDTH
    c3 = 3 * A_WIDTH
    r, k, v, wd, ad, gd = jnp.split(pa, [c1, 2 * c1, c3, c3 + A_DECAY_LORA, c3 + A_DECAY_LORA + A_ICLR_LORA], axis=-1)
    w_log = -jax.nn.softplus(-(w0 + jnp.tanh(wd) @ w2)) - 0.5
    decay = jnp.exp(-jnp.exp(w_log.astype(jnp.float32)))
    a = jax.nn.sigmoid(a0 + ad @ a2)
    g = jax.nn.sigmoid(gd) @ g2
    hd = lambda t: t.reshape(bsz, s, A_HEADS, A_HEAD_DIM)
    kk = hd(k * k_k).astype(jnp.float32)
    kk = (kk / jnp.maximum(jnp.sqrt(jnp.sum(kk * kk, axis=-1, keepdims=True)), 1e-12)).astype(pa.dtype)
    k = k * (1.0 + (a - 1.0) * k_a)
    r_h, k_h, v_h, a_h = hd(r), hd(k), hd(v), hd(a)
    y = wkv7_scan(r_h, hd(decay), k_h, v_h, -kk, kk * a_h)
    y = group_norm(y, ln_w, ln_b, A_GN_EPS)
    y = y + jnp.sum(r_h * k_h * r_k, axis=-1, keepdims=True) * v_h
    return y.reshape(bsz, s, A_WIDTH) * g


def retention(pb, ln_w):
    bsz, s, _ = pb.shape
    q, k, v, g = jnp.split(pb, 4, axis=-1)
    q = rotary(q.reshape(bsz, s, B_HEADS, B_HEAD_DIM))
    k = rotary(k.reshape(bsz, s, B_HEADS, B_HEAD_DIM)) * (B_HEAD_DIM ** -0.5)
    v = v.reshape(bsz, s, B_HEADS, B_HEAD_DIM)
    n_chunks = s // RET_CHUNK
    to_chunks = lambda t: t.reshape(bsz, n_chunks, RET_CHUNK, B_HEADS, -1).transpose(0, 3, 1, 2, 4).astype(jnp.float32)
    qc, kc, vc = to_chunks(q), to_chunks(k), to_chunks(v)
    gamma = 1.0 - 2.0 ** (-5.0 - jnp.arange(B_HEADS, dtype=jnp.float32))
    lg = jnp.log(gamma)[:, None]
    idx = jnp.arange(RET_CHUNK, dtype=jnp.float32)
    rel = idx[:, None] - idx[None, :]
    dmat = jnp.where(rel >= 0, jnp.exp(jnp.maximum(rel, 0.0)[None] * lg[..., None]), 0.0)
    scores = jnp.einsum('bhncd,bhnmd->bhncm', qc, kc) * dmat[None, :, None]
    inner = jnp.einsum('bhncm,bhnme->bhnce', scores, vc)
    zeta = jnp.exp((RET_CHUNK - 1 - idx)[None, :] * lg)
    xi = jnp.exp((idx + 1)[None, :] * lg)
    chunk_decay = jnp.exp(RET_CHUNK * lg)[:, :, None]
    upd = jnp.einsum('bhnmd,bhnme->bhnde', kc * zeta[None, :, None, :, None], vc)

    def step(state, u_i):
        return state * chunk_decay[None] + u_i, state

    s0 = jnp.zeros((bsz, B_HEADS, B_HEAD_DIM, B_HEAD_DIM), jnp.float32)
    _, r_prev = lax.scan(step, s0, jnp.moveaxis(upd, 2, 0))
    r_prev = jnp.moveaxis(r_prev, 0, 2)
    cross = jnp.einsum('bhncd,bhnde->bhnce', qc * xi[None, :, None, :, None], r_prev)
    o = (inner + cross).transpose(0, 2, 3, 1, 4).reshape(bsz, s, B_HEADS, B_HEAD_DIM).astype(pb.dtype)
    o = rms_norm(o, ln_w.reshape(B_HEADS, B_HEAD_DIM))
    return o.reshape(bsz, s, B_WIDTH) * jax.nn.silu(g)


def diff_attention(h, w_in, lq1, lk1, lq2, lk2, ln_w, w_out, rel_bias, lam_init):
    bsz, s, _ = h.shape
    q, k, v = jnp.split(h @ w_in, 3, axis=-1)
    q = q.reshape(bsz, s, C_HEADS, 2, C_HEAD_DIM).transpose(0, 2, 3, 1, 4)
    k = k.reshape(bsz, s, C_HEADS, 2, C_HEAD_DIM).transpose(0, 2, 3, 1, 4)
    v = v.reshape(bsz, s, C_HEADS, C_V_DIM).transpose(0, 2, 1, 3)
    lam = (jnp.exp(jnp.sum(lq1 * lk1).astype(jnp.float32))
           - jnp.exp(jnp.sum(lq2 * lk2).astype(jnp.float32)) + lam_init)
    n_blk = s // Q_BLOCK
    qb = q.reshape(bsz, C_HEADS, 2, n_blk, Q_BLOCK, C_HEAD_DIM).transpose(3, 0, 1, 2, 4, 5)
    k_pos = jnp.arange(s, dtype=jnp.int32)
    scale = C_HEAD_DIM ** -0.5

    def block(args):
        q_blk, blk = args
        q_pos = blk * Q_BLOCK + jnp.arange(Q_BLOCK, dtype=jnp.int32)
        rel = q_pos[:, None] - k_pos[None, :]
        bias = rel_bias[t5_bucket(rel)].transpose(2, 0, 1).astype(jnp.float32)
        logits = jnp.einsum('bhcqd,bhckd->bhcqk', q_blk, k).astype(jnp.float32) * scale + bias[None, :, None]
        logits = jnp.where(rel >= 0, logits, -jnp.inf)
        p = jax.nn.softmax(logits, axis=-1)
        attn = p[:, :, 0] - lam * p[:, :, 1]
        return jnp.einsum('bhqk,bhke->bhqe', attn.astype(v.dtype), v)

    o = lax.map(block, (qb, jnp.arange(n_blk, dtype=jnp.int32)))
    o = o.transpose(1, 0, 3, 2, 4).reshape(bsz, s, C_HEADS, C_V_DIM)
    o = rms_norm(o, ln_w) * (1.0 - lam_init)
    return o.reshape(bsz, s, C_HEADS * C_V_DIM) @ w_out


def memory_cross_attention(h, mem_n, w_q, w_kv, w_o):
    bsz, s, _ = h.shape
    m = mem_n.shape[1]
    q = (h @ w_q).reshape(bsz, s, X_HEADS, X_HEAD_DIM)
    k, v = jnp.split(mem_n @ w_kv, 2, axis=-1)
    k = k.reshape(bsz, m, X_HEADS, X_HEAD_DIM)
    v = v.reshape(bsz, m, X_HEADS, X_HEAD_DIM)
    logits = jnp.einsum('bshd,bmhd->bhsm', q, k).astype(jnp.float32) * (X_HEAD_DIM ** -0.5)
    p = jax.nn.softmax(logits, axis=-1)
    o = jnp.einsum('bhsm,bmhd->bshd', p.astype(v.dtype), v)
    return o.reshape(bsz, s, D_MODEL) @ w_o


def squared_relu_mlp(h, w1, w2):
    return jnp.square(jax.nn.relu(h @ w1)) @ w2


def setup_inputs(seed: int = 0) -> dict:
    key = jax.random.key(seed)
    ks = iter(jax.random.split(key, 48))
    f32 = jnp.float32
    D = D_MODEL

    def nrm(shape, scale):
        return jax.random.normal(next(ks), shape, f32) * scale

    def gain(shape):
        return 1.0 + nrm(shape, 0.02)

    return {
        "x": nrm((BATCH, SEQ, D), 1.0),
        "mem": nrm((BATCH, N_MEM, D), 1.0),
        "rel_bias": nrm((REL_BUCKETS, C_HEADS), 0.5),
        "mem_norm_w": gain((D,)),
        "final_norm_w": gain((D,)),
        "norm_mix_w": gain((DEPTH, D)),
        "norm_cross_w": gain((DEPTH, D)),
        "norm_mlp_w": gain((DEPTH, D)),
        "xattn_w_q": nrm((DEPTH, D, D), D ** -0.5),
        "xattn_w_kv": nrm((DEPTH, D, 2 * D), D ** -0.5),
        "xattn_w_o": nrm((DEPTH, D, D), D ** -0.5),
        "mlp_w1": nrm((DEPTH, D, D_FF), D ** -0.5),
        "mlp_w2": nrm((DEPTH, D_FF, D), D_FF ** -0.5),
        "hyb_w_in": nrm((N_EVEN, D, HYB_COLS), D ** -0.5),
        "rwkv_mu": jax.random.uniform(next(ks), (N_EVEN, A_COLS), f32),
        "rwkv_w0": jax.random.uniform(next(ks), (N_EVEN, A_WIDTH), f32, minval=-6.5, maxval=-1.0),
        "rwkv_w2": nrm((N_EVEN, A_DECAY_LORA, A_WIDTH), 0.5 * A_DECAY_LORA ** -0.5),
        "rwkv_a0": nrm((N_EVEN, A_WIDTH), 0.5),
        "rwkv_a2": nrm((N_EVEN, A_ICLR_LORA, A_WIDTH), A_ICLR_LORA ** -0.5),
        "rwkv_g2": nrm((N_EVEN, A_GATE_LORA, A_WIDTH), A_GATE_LORA ** -0.5),
        "rwkv_k_k": 0.85 + nrm((N_EVEN, A_WIDTH), 0.05),
        "rwkv_k_a": 1.0 + nrm((N_EVEN, A_WIDTH), 0.05),
        "rwkv_r_k": nrm((N_EVEN, A_HEADS, A_HEAD_DIM), 0.1),
        "rwkv_ln_w": gain((N_EVEN, A_WIDTH)),
        "rwkv_ln_b": nrm((N_EVEN, A_WIDTH), 0.02),
        "ret_ln_w": gain((N_EVEN, B_WIDTH)),
        "hyb_w_out": nrm((N_EVEN, A_WIDTH + B_WIDTH, D), (A_WIDTH + B_WIDTH) ** -0.5),
        "diff_w_in": nrm((N_ODD, D, 3 * D), D ** -0.5),
        "diff_lq1": nrm((N_ODD, C_HEAD_DIM), 0.1),
        "diff_lk1": nrm((N_ODD, C_HEAD_DIM), 0.1),
        "diff_lq2": nrm((N_ODD, C_HEAD_DIM), 0.1),
        "diff_lk2": nrm((N_ODD, C_HEAD_DIM), 0.1),
        "diff_ln_w": gain((N_ODD, C_V_DIM)),
        "diff_w_out": nrm((N_ODD, C_HEADS * C_V_DIM, D), D ** -0.5),
    }


def reference(x, mem, rel_bias, mem_norm_w, final_norm_w, norm_mix_w, norm_cross_w, norm_mlp_w,
              xattn_w_q, xattn_w_kv, xattn_w_o, mlp_w1, mlp_w2, hyb_w_in, rwkv_mu, rwkv_w0, rwkv_w2,
              rwkv_a0, rwkv_a2, rwkv_g2, rwkv_k_k, rwkv_k_a, rwkv_r_k, rwkv_ln_w, rwkv_ln_b, ret_ln_w,
              hyb_w_out, diff_w_in, diff_lq1, diff_lk1, diff_lq2, diff_lk2, diff_ln_w, diff_w_out):
    mem_n = rms_norm(mem, mem_norm_w)
    h = x
    for layer in range(DEPTH):
        i = layer // 2
        hn = rms_norm(h, norm_mix_w[layer])
        if layer % 2 == 0:
            proj = hn @ hyb_w_in[i]
            y_a = rwkv7_time_mix(proj[..., :A_COLS], rwkv_mu[i], rwkv_w0[i], rwkv_w2[i], rwkv_a0[i],
                                 rwkv_a2[i], rwkv_g2[i], rwkv_k_k[i], rwkv_k_a[i], rwkv_r_k[i],
                                 rwkv_ln_w[i], rwkv_ln_b[i])
            y_b = retention(proj[..., A_COLS:], ret_ln_w[i])
            mix = jnp.concatenate([y_a, y_b], axis=-1) @ hyb_w_out[i]
        else:
            lam_init = 0.8 - 0.6 * math.exp(-0.3 * layer)
            mix = diff_attention(hn, diff_w_in[i], diff_lq1[i], diff_lk1[i], diff_lq2[i], diff_lk2[i],
                                 diff_ln_w[i], diff_w_out[i], rel_bias, lam_init)
        h = h + mix
        h = h + memory_cross_attention(rms_norm(h, norm_cross_w[layer]), mem_n,
                                       xattn_w_q[layer], xattn_w_kv[layer], xattn_w_o[layer])
        h = h + squared_relu_mlp(rms_norm(h, norm_mlp_w[layer]), mlp_w1[layer], mlp_w2[layer])
    return rms_norm(h, final_norm_w)
```

```cpp
#include <hip/hip_runtime.h>
#include <cstdio>
#include <cstdint>
#ifndef PG8_KREV
#define PG8_KREV 0
#endif
namespace pg8 {
#define PG8_LAS __attribute__((address_space(3)))
typedef unsigned short bf16_t;
typedef short bf16x8 __attribute__((ext_vector_type(8)));
typedef float f32x4 __attribute__((ext_vector_type(4)));
typedef unsigned u32x4 __attribute__((ext_vector_type(4)));
constexpr int BM = 256, BK = 64, HALF = 128, HTB = HALF * BK * 2  , STAGE_BYTES = 8 * HTB, NXCD = 8, WGM = 8;

__host__ __device__ __forceinline__ int lds_byte(int r, int c) { const int st = (r >> 4) * 2 + (c >> 5), rr = r & 15, cc = c & 31, ob = rr * 64 + cc * 2; return st * 1024 + (ob ^ (((ob >> 9) & 1) << 5)); }
__host__ __device__ __forceinline__ void stage_rc(int b, int& R, int& C) { const int st = b / 1024, sb = b % 1024, swz = sb ^ (((sb >> 9) & 1) << 5); R = (st >> 1) * 16 + swz / 64; C = (st & 1) * 32 + (swz % 64) / 2; }
__host__ __device__ __forceinline__ int perm32(int rho) { const int n = rho >> 4, i = rho & 15; return 8 * (i >> 2) + 4 * n + (i & 3); }

struct Unit { int pm, pn, z; };
struct Gemm { const bf16_t* A; const bf16_t* Bt; int M, N, K, lda, ldb, nz, zdiv; size_t sA1, sA2, sB1, sB2; int krev = 0; };
__host__ __device__ __forceinline__ Gemm gemm_plain(const bf16_t* A, const bf16_t* Bt, int M, int N, int K) { return Gemm{A, Bt, M, N, K, K, K, 1, 1, 0, 0, 0, 0, 0}; }

struct StaticOrder {
    int nM, nN, per_z, nwg, G, c; int rev = 0;
    __host__ __device__ void init(const Gemm& g, int G_, int c_) { nM = g.M / BM; nN = g.N / BM; per_z = nM * nN; nwg = per_z * g.nz; G = G_; c = c_; }
    __host__ __device__ bool next(int i, Unit& u) const {
        const int nr = c < nwg ? (nwg - c + G - 1) / G : 0; if (i >= nr) return false;
        const long L = (long)(rev ? nr - 1 - i : i) * G + c;
        int wgid = (int)L; { const int q = nwg / NXCD, r = nwg % NXCD, xcd = wgid % NXCD, off = wgid / NXCD; wgid = (xcd < r ? xcd * (q + 1) : r * (q + 1) + (xcd - r) * q) + off; }
        u.z = wgid / per_z; wgid -= u.z * per_z;
        const int nig = WGM * nN, gid = wgid / nig, fm = gid * WGM, gsz = (nM - fm) < WGM ? (nM - fm) : WGM;
        u.pm = fm + ((wgid % nig) % gsz); u.pn = (wgid % nig) / gsz; return true;
    }
    __device__ __forceinline__ void a_ready(const Unit&) const {}
    __device__ __forceinline__ void done(const Unit&) const {}
};

struct PanelOrder {
    int nM, nN, G, c;
    __host__ __device__ void init(const Gemm& g, int G_, int c_) { nM = g.M / BM; nN = g.N / BM; G = G_; c = c_; }
    __host__ __device__ __forceinline__ bool next(int i, Unit& u) const {
        const unsigned L = (unsigned)(i * G + c), CP = 2u * (unsigned)nM; const int lap = (int)(L / CP), w = (int)(L - (unsigned)lap * CP);
        if (lap >= nN / 2) return false;
        u.z = 0; u.pm = w >> 1; u.pn = (w & 1) * (nN / 2) + lap; return true;
    }
    __device__ __forceinline__ void a_ready(const Unit&) const {}
    __device__ __forceinline__ void done(const Unit&) const {}
};

__device__ __forceinline__ unsigned cvt_pk_bf16(float lo, float hi) { unsigned r; asm volatile("v_cvt_pk_bf16_f32 %0, %1, %2" : "=v"(r) : "v"(lo), "v"(hi)); return r; }
#ifndef NT_STORES
#define NT_STORES 1
#endif
#ifndef WT_STORES
#define WT_STORES 0
#endif
template <int ACT  , bool NORM = false> struct EpiBf16 {
    static constexpr bool PERM = true, AFTER_DRAIN = false, PRE = NORM, PF = false;
    bf16_t* O; int ldc, zdiv; size_t sO1, sO2; float scale; int scale_cols; const float* ssp; PG8_LAS float* rsl;
    __device__ __forceinline__ void pre_issue(const Unit& u, int tid, int ui) const {
        if (tid < 256) __builtin_amdgcn_global_load_lds((const unsigned*)(ssp + ((size_t)u.pm * BM + tid) * 4), (PG8_LAS unsigned*)(rsl + (ui & 1) * 1024 + (tid >> 6) * 256), 16, 0, 0); }
    __device__ __forceinline__ void operator()(const f32x4 (&acc)[2][2][4][2], const Unit& u, int wr, int wc, int fr, int fq, int ui) const {
        const int row0 = u.pm * BM + wr * 64 + fr, col0 = u.pn * BM + wc * 32 + 8 * fq;
        bf16_t* base = O + (size_t)(u.z / zdiv) * sO1 + (size_t)(u.z % zdiv) * sO2;
        const float sc0 = (u.pn * BM < scale_cols) ? scale : 1.f;
#pragma unroll
        for (int ai = 0; ai < 2; ++ai)
#pragma unroll
            for (int m = 0; m < 4; ++m) { bf16_t* rowp = base + (size_t)(row0 + ai * HALF + m * 16) * ldc + col0;
                float sc = sc0; if constexpr (NORM) { const f32x4 s4 = *(const PG8_LAS f32x4*)(rsl + (ui & 1) * 1024 + (ai * HALF + wr * 64 + m * 16 + fr) * 4); sc *= rsqrtf(((s4[0] + s4[1]) + (s4[2] + s4[3])) * (1.f / 1024.f) + 1e-6f); }
#pragma unroll
                for (int bj = 0; bj < 2; ++bj) { f32x4 v0 = acc[ai][bj][m][0] * sc, v1 = acc[ai][bj][m][1] * sc;
                    if (ACT == 1) {
#pragma unroll
                        for (int e = 0; e < 4; ++e) { const float a = v0[e] > 0.f ? v0[e] : 0.f, b = v1[e] > 0.f ? v1[e] : 0.f; v0[e] = a * a; v1[e] = b * b; } }
                    u32x4 w; w.x = cvt_pk_bf16(v0[0], v0[1]); w.y = cvt_pk_bf16(v0[2], v0[3]); w.z = cvt_pk_bf16(v1[0], v1[1]); w.w = cvt_pk_bf16(v1[2], v1[3]);
                    if (WT_STORES) asm volatile("global_store_dwordx4 %0, %1, off sc1\n\ts_nop 1" :: "v"(rowp + bj * HALF), "v"(w) : "memory");
                    else if (NT_STORES) __builtin_nontemporal_store(w, (u32x4*)(rowp + bj * HALF));
                    else *(u32x4*)(rowp + bj * HALF) = w; } }
    }
};
struct EpiResid {
    static constexpr bool PERM = true, AFTER_DRAIN = false, PRE = false, PF = false; static constexpr int PF_LEAD = 8;
    const bf16_t* base; bf16_t* hb; int ldc; size_t sO1; float* ssp; PG8_LAS float* xch; int rows_per_z; int mode = 0;
    __device__ __forceinline__ void prefetch(const Unit& u, int tid_) const {
        int tid = tid_; asm volatile("" : "+v"(tid));
        const bf16_t* p = base + (size_t)u.z * sO1 + (size_t)(u.pm * BM + (tid >> 1)) * ldc + u.pn * BM + (tid & 1) * 128;
        PG8_LAS unsigned* d = (PG8_LAS unsigned*)(xch + 2048) + (tid >> 6) * 128;
        __builtin_amdgcn_global_load_lds((const unsigned*)p, d, 4, 0, 0); __builtin_amdgcn_global_load_lds((const unsigned*)(p + 64), d + 64, 4, 0, 0); }
    __device__ __forceinline__ void operator()(const f32x4 (&acc)[2][2][4][2], const Unit& u, int wr, int wc, int fr, int fq, int ui) const {
        if (mode == 1) return;
        const int row0 = u.pm * BM + wr * 64 + fr, col0 = u.pn * BM + wc * 32 + 8 * fq;
        const size_t zo = (size_t)u.z * sO1;
        u32x4 bw[4][2];
#define PG8_RLOAD(q) do { _Pragma("unroll") for (int bj = 0; bj < 2; ++bj) bw[(q) & 3][bj] = *(const u32x4*)(base + zo + (size_t)(row0 + ((q) >> 2) * HALF + ((q) & 3) * 16) * ldc + col0 + bj * HALF); } while (0)
        PG8_RLOAD(0); PG8_RLOAD(1); PG8_RLOAD(2); PG8_RLOAD(3);
#pragma unroll
        for (int q = 0; q < 8; ++q) { const int ai = q >> 2, m = q & 3;
            const size_t off = zo + (size_t)(row0 + ai * HALF + m * 16) * ldc + col0; float ss = 0.f;
#pragma unroll
            for (int bj = 0; bj < 2; ++bj) { const u32x4 b = bw[q & 3][bj]; f32x4 v0 = acc[ai][bj][m][0], v1 = acc[ai][bj][m][1];
                v0[0] += __uint_as_float(b.x << 16); v0[1] += __uint_as_float(b.x & 0xffff0000u); v0[2] += __uint_as_float(b.y << 16); v0[3] += __uint_as_float(b.y & 0xffff0000u);
                v1[0] += __uint_as_float(b.z << 16); v1[1] += __uint_as_float(b.z & 0xffff0000u); v1[2] += __uint_as_float(b.w << 16); v1[3] += __uint_as_float(b.w & 0xffff0000u);
                ss += ((v0[0] * v0[0] + v0[1] * v0[1]) + (v0[2] * v0[2] + v0[3] * v0[3])) + ((v1[0] * v1[0] + v1[1] * v1[1]) + (v1[2] * v1[2] + v1[3] * v1[3]));
                u32x4 w; w.x = cvt_pk_bf16(v0[0], v0[1]); w.y = cvt_pk_bf16(v0[2], v0[3]); w.z = cvt_pk_bf16(v1[0], v1[1]); w.w = cvt_pk_bf16(v1[2], v1[3]);
                *(u32x4*)(hb + off + bj * HALF) = w; }
            if (q + 4 < 8) PG8_RLOAD(q + 4);
            { auto r16 = __builtin_amdgcn_permlane16_swap(__float_as_uint(ss), __float_as_uint(ss), false, false); const unsigned a_ = r16[0], b_ = r16[1]; ss = __uint_as_float(a_) + __uint_as_float(b_); }
            { auto r32 = __builtin_amdgcn_permlane32_swap(__float_as_uint(ss), __float_as_uint(ss), false, false); const unsigned a_ = r32[0], b_ = r32[1]; ss = __uint_as_float(a_) + __uint_as_float(b_); }
            if (fq == 0) xch[(ai * HALF + wr * 64 + m * 16 + fr) * 4 + wc] = ss; }
#undef PG8_RLOAD
        asm volatile("s_waitcnt lgkmcnt(0)" ::: "memory"); __builtin_amdgcn_s_barrier(); asm volatile("" ::: "memory");
        { const int t = (wr * 4 + wc) * 64 + fq * 16 + fr;
          if (t < 256) { const f32x4 p = *(const PG8_LAS f32x4*)(xch + t * 4); ssp[((size_t)u.z * rows_per_z + (size_t)u.pm * BM + t) * 4 + u.pn] = (p[0] + p[1]) + (p[2] + p[3]); } }
    }
};
struct EpiSoftmax {
    static constexpr bool PERM = true, AFTER_DRAIN = false, PRE = true, PF = false;
    bf16_t* O; int ldc; size_t sO1; PG8_LAS float* xch; const float* ssp;
    int rows_per_z; PG8_LAS float* rsl;
    __device__ __forceinline__ void pre_issue(const Unit& u, int tid, int ui) const {
        if (tid < 256) __builtin_amdgcn_global_load_lds((const unsigned*)(ssp + ((size_t)u.z * rows_per_z + (size_t)u.pm * BM + tid) * 4), (PG8_LAS unsigned*)(rsl + (ui & 1) * 1024 + (tid >> 6) * 256), 16, 0, 0); }
    __device__ __forceinline__ void operator()(const f32x4 (&acc_)[2][2][4][2], const Unit& u, int wr, int wc, int fr, int fq, int ui) const {
        f32x4 (&acc)[2][2][4][2] = const_cast<f32x4 (&)[2][2][4][2]>(acc_);
#define PG8_XSWAP16(v) ({ auto r_ = __builtin_amdgcn_permlane16_swap(__float_as_uint(v), __float_as_uint(v), false, false); const unsigned a_ = r_[0], b_ = r_[1]; (a_ == __float_as_uint(v)) ? __uint_as_float(b_) : __uint_as_float(a_); })
#pragma unroll
        for (int ai = 0; ai < 2; ++ai)
#pragma unroll
            for (int m = 0; m < 4; ++m) {
                const f32x4 s4 = *(const PG8_LAS f32x4*)(rsl + (ui & 1) * 1024 + (ai * HALF + wr * 64 + m * 16 + fr) * 4);
                const float rsc = rsqrtf(((s4[0] + s4[1]) + (s4[2] + s4[3])) * (1.f / 1024.f) + 1e-6f);
                float c = -3.0e38f;
#pragma unroll
                for (int bj = 0; bj < 2; ++bj)
#pragma unroll
                    for (int n = 0; n < 2; ++n)
#pragma unroll
                        for (int e = 0; e < 4; ++e) { acc[ai][bj][m][n][e] *= rsc; c = fmaxf(c, acc[ai][bj][m][n][e]); }
                { auto r16 = __builtin_amdgcn_permlane16_swap(__float_as_uint(c), __float_as_uint(c), false, false); const unsigned a_ = r16[0], b_ = r16[1]; c = fmaxf(__uint_as_float(a_), __uint_as_float(b_)); }
                { auto r32 = __builtin_amdgcn_permlane32_swap(__float_as_uint(c), __float_as_uint(c), false, false); const unsigned a_ = r32[0], b_ = r32[1]; c = fmaxf(__uint_as_float(a_), __uint_as_float(b_)); }
                float s = 0.f;
#pragma unroll
                for (int bj = 0; bj < 2; ++bj)
#pragma unroll
                    for (int n = 0; n < 2; ++n)
#pragma unroll
                        for (int e = 0; e < 4; ++e) { const float p = __builtin_amdgcn_exp2f(acc[ai][bj][m][n][e] - c); acc[ai][bj][m][n][e] = p; s += p; }
                { auto r16 = __builtin_amdgcn_permlane16_swap(__float_as_uint(s), __float_as_uint(s), false, false); const unsigned a_ = r16[0], b_ = r16[1]; s = __uint_as_float(a_) + __uint_as_float(b_); }
                { auto r32 = __builtin_amdgcn_permlane32_swap(__float_as_uint(s), __float_as_uint(s), false, false); const unsigned a_ = r32[0], b_ = r32[1]; s = __uint_as_float(a_) + __uint_as_float(b_); }
                const int row = ai * HALF + wr * 64 + m * 16 + fr;
                if (fq == 0) { xch[(row * 4 + wc) * 2] = c; xch[(row * 4 + wc) * 2 + 1] = s; }
            }
#undef PG8_XSWAP16
        asm volatile("s_waitcnt lgkmcnt(0)" ::: "memory"); __builtin_amdgcn_s_barrier(); asm volatile("" ::: "memory");
        const int col0 = u.pn * BM + wc * 32 + 8 * fq;
        bf16_t* base = O + (size_t)u.z * sO1;
#pragma unroll
        for (int ai = 0; ai < 2; ++ai)
#pragma unroll
            for (int m = 0; m < 4; ++m) {
                const int row = ai * HALF + wr * 64 + m * 16 + fr;
                const f32x4 x0 = *(const PG8_LAS f32x4*)(xch + row * 8), x1 = *(const PG8_LAS f32x4*)(xch + row * 8 + 4);
                const float mx = fmaxf(fmaxf(x0[0], x0[2]), fmaxf(x1[0], x1[2]));
                const float tot = x0[1] * __builtin_amdgcn_exp2f(x0[0] - mx) + x0[3] * __builtin_amdgcn_exp2f(x0[2] - mx) + x1[1] * __builtin_amdgcn_exp2f(x1[0] - mx) + x1[3] * __builtin_amdgcn_exp2f(x1[2] - mx);
                const float cl = wc == 0 ? x0[0] : wc == 1 ? x0[2] : wc == 2 ? x1[0] : x1[2];
                const float f = __builtin_amdgcn_exp2f(cl - mx) * __builtin_amdgcn_rcpf(tot);
                bf16_t* rowp = base + (size_t)(u.pm * BM + row) * ldc + col0;
#pragma unroll
                for (int bj = 0; bj < 2; ++bj) { const f32x4 v0 = acc[ai][bj][m][0] * f, v1 = acc[ai][bj][m][1] * f;
                    u32x4 w; w.x = cvt_pk_bf16(v0[0], v0[1]); w.y = cvt_pk_bf16(v0[2], v0[3]); w.z = cvt_pk_bf16(v1[0], v1[1]); w.w = cvt_pk_bf16(v1[2], v1[3]);
                    *(u32x4*)(rowp + bj * HALF) = w; }
            }
    }
};
struct EpiLora {
    static constexpr bool PERM = true, AFTER_DRAIN = false, PRE = false, PF = false;
    unsigned char* ws; size_t off_dec, off_alpha, off_g; const float* w0; const float* a0;
    __device__ __forceinline__ void operator()(const f32x4 (&acc)[2][2][4][2], const Unit& u, int wr, int wc, int fr, int fq, int ui) const {
        const int kind = u.pn >> 1;
        const size_t off = off_dec + (size_t)(kind >= 1) * (off_alpha - off_dec) + (size_t)(kind >= 2) * (off_g - off_alpha);
        bf16_t* O = (bf16_t*)(ws + off);
        const float* bias = kind == 0 ? w0 : a0;
        const int row0 = u.pm * BM + wr * 64 + fr, col0 = (u.pn & 1) * BM + wc * 32 + 8 * fq;
        f32x4 bv[2][2];
#pragma unroll
        for (int bj = 0; bj < 2; ++bj)
#pragma unroll
            for (int n = 0; n < 2; ++n) bv[bj][n] = kind < 2 ? *(const f32x4*)(bias + col0 + bj * HALF + 4 * n) : (f32x4){0.f, 0.f, 0.f, 0.f};
        const float osc = kind == 0 ? 0.60653066f : 1.f;
#pragma unroll
        for (int ai = 0; ai < 2; ++ai)
#pragma unroll
            for (int m = 0; m < 4; ++m) { bf16_t* rowp = O + (size_t)(row0 + ai * HALF + m * 16) * 512 + col0;
#pragma unroll
                for (int bj = 0; bj < 2; ++bj) { f32x4 v0 = acc[ai][bj][m][0] + bv[bj][0], v1 = acc[ai][bj][m][1] + bv[bj][1];
                    if (kind < 2) {
#pragma unroll
                        for (int e = 0; e < 4; ++e) { v0[e] = osc * __builtin_amdgcn_rcpf(1.f + __builtin_amdgcn_exp2f(-1.4426950408889634f * v0[e])); v1[e] = osc * __builtin_amdgcn_rcpf(1.f + __builtin_amdgcn_exp2f(-1.4426950408889634f * v1[e])); } }
                    if (kind == 0) {
#pragma unroll
                        for (int e = 0; e < 4; ++e) { float a = -1.4426950408889634f * v0[e], b = -1.4426950408889634f * v1[e];
#define PG8_SHR(x, C) __builtin_bit_cast(float, __builtin_amdgcn_update_dpp(0, __builtin_bit_cast(int, x), C, 0xF, 0xF, true))
                            a += PG8_SHR(a, 0x111); a += PG8_SHR(a, 0x112); a += PG8_SHR(a, 0x114); a += PG8_SHR(a, 0x118);
                            b += PG8_SHR(b, 0x111); b += PG8_SHR(b, 0x112); b += PG8_SHR(b, 0x114); b += PG8_SHR(b, 0x118);
#undef PG8_SHR
                            v0[e] = a; v1[e] = b; }
                        typedef _Float16 h2_t __attribute__((ext_vector_type(2))); typedef float f2_t __attribute__((ext_vector_type(2)));
                        u32x4 w;
                        w.x = __builtin_bit_cast(unsigned, __builtin_convertvector((f2_t){v0[0], v0[1]}, h2_t)); w.y = __builtin_bit_cast(unsigned, __builtin_convertvector((f2_t){v0[2], v0[3]}, h2_t));
                        w.z = __builtin_bit_cast(unsigned, __builtin_convertvector((f2_t){v1[0], v1[1]}, h2_t)); w.w = __builtin_bit_cast(unsigned, __builtin_convertvector((f2_t){v1[2], v1[3]}, h2_t));
                        *(u32x4*)(rowp + bj * HALF) = w; continue; }
                    u32x4 w; w.x = cvt_pk_bf16(v0[0], v0[1]); w.y = cvt_pk_bf16(v0[2], v0[3]); w.z = cvt_pk_bf16(v1[0], v1[1]); w.w = cvt_pk_bf16(v1[2], v1[3]);
                    *(u32x4*)(rowp + bj * HALF) = w; } }
    }
};
template <class Epi, class Sched, bool ALIGN_EPI = false, bool SP2 = false>
__device__ __forceinline__ void gemm_phase(PG8_LAS unsigned char* lds, const Gemm g, const Sched& S, const Epi& E, const int tid) {
    const int wid = __builtin_amdgcn_readfirstlane(tid >> 6), lane = tid & 63, wr = wid >> 2, wc = wid & 3, fr = lane & 15, fq = lane >> 4;
    const int K = g.K, nt = K / BK;
    unsigned voffA[2], voffB[2];
#pragma unroll
    for (int i = 0; i < 2; ++i) { int R, C; stage_rc(tid * 16 + i * 8192, R, C); const int Rb = Epi::PERM ? ((R & ~31) + perm32(R & 31)) : R;
        voffA[i] = (unsigned)(R * g.lda + C) * 2u; voffB[i] = (unsigned)(Rb * g.ldb + C) * 2u; }
    const size_t kstep = (size_t)(BK * 2);
#define PG8_KR(ui_) (g.krev == 2 || ((PG8_KREV || g.krev == 1) && ((ui_) & 1)))
#define PG8_KS(ui_) (PG8_KR(ui_) ? -(int)(BK * 2) : (int)(BK * 2))
#define PG8_K0(ui_) (PG8_KR(ui_) ? (nt - 1) * (BK * 2) : 0)
    const size_t hstepA = (size_t)HALF * g.lda * 2, hstepB = (size_t)HALF * g.ldb * 2;
#define PG8_BASEA(u) ((const char*)g.A + ((size_t)((u).z / g.zdiv) * g.sA1 + (size_t)((u).z % g.zdiv) * g.sA2) * 2 + (size_t)(u).pm * 2 * hstepA)
#define PG8_BASEB(u) ((const char*)g.Bt + ((size_t)((u).z / g.zdiv) * g.sB1 + (size_t)((u).z % g.zdiv) * g.sB2) * 2 + (size_t)(u).pn * 2 * hstepB)
    const unsigned ldsw = (unsigned)wid * 1024u;
    const int aoff = lds_byte(wr * 64 + fr, fq * 8), boff = lds_byte(wc * 32 + fr, fq * 8);
#define PG8_SA(b, h) (((b) * 2 + (h)) * HTB)
#define PG8_SB(b, h) ((4 + (b) * 2 + (h)) * HTB)
#define PG8_STAGE(bufoff, gbase, voff) do { _Pragma("unroll") for (int _i = 0; _i < 2; ++_i) \
        __builtin_amdgcn_global_load_lds((const unsigned*)((const char*)(gbase) + (voff)[_i]), (PG8_LAS unsigned*)(lds + (bufoff) + ldsw + _i * 8192), 16, 0, 0); } while (0)
#define PG8_LDA(dst, b, h) do { _Pragma("unroll") for (int m = 0; m < 4; ++m) _Pragma("unroll") for (int k = 0; k < 2; ++k) dst[m][k] = *(const PG8_LAS bf16x8*)(lds + PG8_SA(b, h) + aoff + m * 2048 + k * 1024); } while (0)
#define PG8_LDB(dst, b, h) do { _Pragma("unroll") for (int n = 0; n < 2; ++n) _Pragma("unroll") for (int k = 0; k < 2; ++k) dst[n][k] = *(const PG8_LAS bf16x8*)(lds + PG8_SB(b, h) + boff + n * 2048 + k * 1024); } while (0)
#define PG8_MMA(ai, bj, At, Bt) do { __builtin_amdgcn_s_setprio(1); _Pragma("unroll") for (int m = 0; m < 4; ++m) _Pragma("unroll") for (int n = 0; n < 2; ++n) _Pragma("unroll") for (int k = 0; k < 2; ++k) \
        acc[ai][bj][m][n] = __builtin_amdgcn_mfma_f32_16x16x32_bf16(Bt[n][k], At[m][k], acc[ai][bj][m][n], 0, 0, 0); __builtin_amdgcn_s_setprio(0); } while (0)
#define PG8_WAIT_V(n) asm volatile("s_waitcnt vmcnt(" #n ")" ::: "memory")
#define PG8_WAIT_L(n) asm volatile("s_waitcnt lgkmcnt(" #n ")" ::: "memory")
#define PG8_BAR __builtin_amdgcn_s_barrier()
#define PG8_SCHED __builtin_amdgcn_sched_barrier(0)
    Unit cur, nxt; int ui = 0;
    if (!S.next(0, cur)) return;
    f32x4 acc[2][2][4][2];
#pragma unroll
    for (int a = 0; a < 2; ++a)
#pragma unroll
        for (int b = 0; b < 2; ++b)
#pragma unroll
            for (int m = 0; m < 4; ++m)
#pragma unroll
                for (int n = 0; n < 2; ++n) acc[a][b][m][n] = (f32x4){0.f, 0.f, 0.f, 0.f};
    bf16x8 At[4][2], B0[2][2], B1[2][2];
    const char* cA = PG8_BASEA(cur) + PG8_K0(0); const char* cB = PG8_BASEB(cur) + PG8_K0(0); int ksc = PG8_KS(0);
    S.a_ready(cur);
    if constexpr (SP2) {
        PG8_STAGE(PG8_SB(0, 0), cB, voffB); PG8_STAGE(PG8_SB(0, 1), cB + hstepB, voffB); PG8_STAGE(PG8_SA(0, 0), cA, voffA); PG8_STAGE(PG8_SA(0, 1), cA + hstepA, voffA);
        if (wr == 1) PG8_BAR;
        PG8_WAIT_V(2); PG8_BAR;
        PG8_STAGE(PG8_SB(1, 0), cB + ksc, voffB); PG8_STAGE(PG8_SA(1, 0), cA + ksc, voffA); PG8_STAGE(PG8_SB(1, 1), cB + hstepB + ksc, voffB);
        PG8_WAIT_V(6); PG8_BAR;
    } else {
        PG8_STAGE(PG8_SB(0, 0), cB, voffB); PG8_STAGE(PG8_SA(0, 0), cA, voffA); PG8_STAGE(PG8_SB(0, 1), cB + hstepB, voffB); PG8_STAGE(PG8_SA(0, 1), cA + hstepA, voffA);
        if (wr == 1) PG8_BAR;
        PG8_WAIT_V(4); PG8_BAR;
        PG8_STAGE(PG8_SB(1, 0), cB + ksc, voffB); PG8_STAGE(PG8_SA(1, 0), cA + ksc, voffA); PG8_STAGE(PG8_SB(1, 1), cB + hstepB + ksc, voffB);
        PG8_WAIT_V(6); PG8_BAR;
    }
    for (;;) {
        const bool has_next = S.next(ui + 1, nxt);
        const char* nA = has_next ? PG8_BASEA(nxt) + PG8_K0(ui + 1) : cA; const char* nB = has_next ? PG8_BASEB(nxt) + PG8_K0(ui + 1) : cB; const int ksn = has_next ? PG8_KS(ui + 1) : ksc;
        if constexpr (Epi::PRE) { static_assert(SP2, "PRE epilogues ride on the SP2 wait pattern"); E.pre_issue(cur, tid, ui); }
        for (int t = 0; t < nt; t += 2) {
            const bool last = (t == nt - 2);
            if constexpr (Epi::PF) { if (t == nt - Epi::PF_LEAD) E.prefetch(cur, tid); }
            const char* a1 = cA + (t + 1) * ksc;
            const char* a2 = last ? nA : cA + (t + 2) * ksc; const char* b2 = last ? nB : cB + (t + 2) * ksc;
            const int ks3 = last ? ksn : ksc; const char* a3 = a2 + ks3; const char* b3 = b2 + ks3;
            if (last && has_next) S.a_ready(nxt);
            if constexpr (SP2) {
            PG8_LDB(B0, 0, 0); PG8_LDB(B1, 0, 1); PG8_SCHED; PG8_LDA(At, 0, 0); PG8_STAGE(PG8_SA(1, 1), a1 + hstepA, voffA);
            PG8_WAIT_V(8); PG8_WAIT_L(0); PG8_BAR; PG8_MMA(0, 0, At, B0); PG8_MMA(0, 1, At, B1); PG8_BAR; PG8_SCHED;
            PG8_LDA(At, 0, 1); PG8_STAGE(PG8_SB(0, 0), b2, voffB); PG8_STAGE(PG8_SB(0, 1), b2 + hstepB, voffB); PG8_STAGE(PG8_SA(0, 0), a2, voffA);
            PG8_WAIT_V(8); PG8_WAIT_L(0); PG8_BAR; PG8_MMA(1, 0, At, B0); PG8_MMA(1, 1, At, B1); PG8_BAR; PG8_SCHED;
            PG8_LDB(B0, 1, 0); PG8_LDB(B1, 1, 1); PG8_SCHED; PG8_LDA(At, 1, 0); PG8_STAGE(PG8_SA(0, 1), a2 + hstepA, voffA);
            PG8_WAIT_V(8); PG8_WAIT_L(0); PG8_BAR; PG8_MMA(0, 0, At, B0); PG8_MMA(0, 1, At, B1); PG8_BAR; PG8_SCHED;
            PG8_LDA(At, 1, 1); PG8_STAGE(PG8_SB(1, 0), b3, voffB); PG8_STAGE(PG8_SB(1, 1), b3 + hstepB, voffB); PG8_STAGE(PG8_SA(1, 0), a3, voffA);
            PG8_WAIT_V(8); PG8_WAIT_L(0); PG8_BAR; PG8_MMA(1, 0, At, B0); PG8_MMA(1, 1, At, B1); PG8_BAR; PG8_SCHED;
            } else {
            PG8_LDB(B0, 0, 0); PG8_SCHED; PG8_LDA(At, 0, 0); PG8_STAGE(PG8_SA(1, 1), a1 + hstepA, voffA);
            PG8_WAIT_L(8); PG8_BAR; PG8_WAIT_L(0); PG8_MMA(0, 0, At, B0); PG8_BAR; PG8_SCHED;
            PG8_LDB(B1, 0, 1); PG8_STAGE(PG8_SB(0, 0), b2, voffB);
            PG8_BAR; PG8_WAIT_L(0); PG8_MMA(0, 1, At, B1); PG8_BAR;
            PG8_LDA(At, 0, 1); PG8_STAGE(PG8_SA(0, 0), a2, voffA);
            PG8_BAR; PG8_WAIT_L(0); PG8_MMA(1, 0, At, B0); PG8_BAR; PG8_SCHED;
            PG8_STAGE(PG8_SB(0, 1), b2 + hstepB, voffB);
            PG8_WAIT_V(6); PG8_BAR; PG8_MMA(1, 1, At, B1); PG8_BAR;
            PG8_LDB(B0, 1, 0); PG8_SCHED; PG8_LDA(At, 1, 0); PG8_STAGE(PG8_SA(0, 1), a2 + hstepA, voffA);
            PG8_WAIT_L(8); PG8_BAR; PG8_WAIT_L(0); PG8_MMA(0, 0, At, B0); PG8_BAR; PG8_SCHED;
            PG8_LDB(B1, 1, 1); PG8_STAGE(PG8_SB(1, 0), b3, voffB);
            PG8_BAR; PG8_WAIT_L(0); PG8_MMA(0, 1, At, B1); PG8_BAR;
            PG8_LDA(At, 1, 1); PG8_STAGE(PG8_SA(1, 0), a3, voffA);
            PG8_BAR; PG8_WAIT_L(0); PG8_MMA(1, 0, At, B0); PG8_BAR; PG8_SCHED;
            PG8_STAGE(PG8_SB(1, 1), b3 + hstepB, voffB);
            PG8_WAIT_V(6); PG8_BAR; PG8_MMA(1, 1, At, B1); PG8_BAR;
            }
        }
        if constexpr (ALIGN_EPI) { if (wr == 0) PG8_BAR; }
        if constexpr (!Epi::AFTER_DRAIN) { E(acc, cur, wr, wc, fr, fq, ui); S.done(cur); }
        if (!has_next) break;
#pragma unroll
        for (int a = 0; a < 2; ++a)
#pragma unroll
            for (int b = 0; b < 2; ++b)
#pragma unroll
                for (int m = 0; m < 4; ++m)
#pragma unroll
                    for (int n = 0; n < 2; ++n) acc[a][b][m][n] = (f32x4){0.f, 0.f, 0.f, 0.f};
        cur = nxt; cA = nA; cB = nB; ksc = ksn; ++ui;
        if constexpr (ALIGN_EPI) { if (wr == 1) PG8_BAR; }
    }
    PG8_WAIT_V(0);
    if constexpr (!ALIGN_EPI) { if (wr == 0) PG8_BAR; }
    PG8_BAR;
    if constexpr (Epi::AFTER_DRAIN) { E.fused(acc, cur, wr, wc, fr, fq, lds, wid, lane); S.done(cur); }
#undef PG8_KS
#undef PG8_KR
#undef PG8_K0
#undef PG8_BASEA
#undef PG8_BASEB
#undef PG8_SA
#undef PG8_SB
#undef PG8_STAGE
#undef PG8_LDA
#undef PG8_LDB
#undef PG8_MMA
#undef PG8_WAIT_V
#undef PG8_WAIT_L
#undef PG8_BAR
#undef PG8_SCHED
}
}
#ifndef PG8_SP2
#define PG8_SP2 true
#endif
#ifndef PG8_ALIGN
#define PG8_ALIGN true
#endif

constexpr int BATCH = 8, SEQ = 4096, DM = 1024, NTOK = BATCH * SEQ, NMEM = 256, MROWS = BATCH * NMEM, DFF = 4096;
constexpr int HYB = 3840, QKVW = 3072;
constexpr int NWAVES = 8;
constexpr int PH_PER_LAYER = 13, PH_FINAL = 52, PH_TOTAL = 53;
#ifndef MK_ONE_LAUNCH
#define MK_ONE_LAUNCH 1
#endif

constexpr size_t MiB = 1u << 20;
constexpr size_t WS_CTL = 0, CTL_ZERO_BYTES = 1 * MiB;
constexpr size_t WS_MEMN = 1 * MiB;
constexpr size_t WS_KV = 8 * MiB;
constexpr size_t WS_W = 16 * MiB;
constexpr size_t WS_HN = 50 * MiB;
constexpr size_t WS_BIG = 114 * MiB;
constexpr size_t WS_LW = 5 * MiB;
constexpr size_t WS_ROT = 6 * MiB;
constexpr size_t WS_BONUS = 7 * MiB;
constexpr size_t WS_XL = WS_BIG + 240 * MiB;
constexpr size_t WS_DEC = 370 * MiB;
constexpr size_t WS_ALPHA = 434 * MiB;
constexpr size_t WS_G = 466 * MiB;
constexpr size_t WS_WQK = WS_DEC;
constexpr size_t WS_VWO = WS_DEC + 16 * MiB;
constexpr size_t WS_SSP = 498 * MiB;
constexpr size_t WS_HB2 = WS_BIG + 64 * MiB;
constexpr size_t WS_WKV2 = WS_DEC + 32 * MiB;
constexpr size_t WS_KV2 = WS_DEC + 36 * MiB;
constexpr size_t WS_END = 500 * MiB;
constexpr size_t WO_IN = 0, WO_OUT = WO_IN + (size_t)3840 * 1024, WO_Q = WO_OUT + (size_t)1024 * 1024, WO_KV = WO_Q + (size_t)1024 * 1024, WO_O = WO_KV + (size_t)2048 * 1024,
                 WO_1 = WO_O + (size_t)1024 * 1024, WO_2 = WO_1 + (size_t)4096 * 1024, WO_END = WO_2 + (size_t)4096 * 1024;
static_assert(WS_W + WO_END * 2 <= WS_HN, "weights fit");
constexpr int CW_BAR = 4096;

constexpr int RING_BYTES = 131072, LDSCTL_OFF = RING_BYTES, MISC_OFF = LDSCTL_OFF + 320, XCH_OFF = 135168, LDS_BYTES = 151552;

#define GAS __attribute__((address_space(1)))
#define LAS __attribute__((address_space(3)))
typedef unsigned short bf16;
typedef unsigned v4u __attribute__((ext_vector_type(4)));
typedef unsigned v2u __attribute__((ext_vector_type(2)));
typedef float f32x4 __attribute__((ext_vector_type(4)));
#define LDS_WAIT() asm volatile("s_waitcnt lgkmcnt(0)" ::: "memory")
__device__ __forceinline__ unsigned f2bf(float f) { unsigned u = __builtin_bit_cast(unsigned, f); return (u + 0x7fffu + ((u >> 16) & 1u)) >> 16; }
typedef float cf32x2_t __attribute__((ext_vector_type(2))); typedef __bf16 cbf16x2_t __attribute__((ext_vector_type(2)));
__device__ __forceinline__ unsigned pk2(float lo, float hi) { cf32x2_t v = {lo, hi}; cbf16x2_t b = __builtin_convertvector(v, cbf16x2_t); return __builtin_bit_cast(unsigned, b); }
__device__ __forceinline__ float bf2f(unsigned v) { return __builtin_bit_cast(float, v << 16); }
template <int CTRL> __device__ __forceinline__ float cdpp0(float v) { return __builtin_bit_cast(float, __builtin_amdgcn_update_dpp(0, __builtin_bit_cast(int, v), CTRL, 0xF, 0xF, true)); }
__device__ __forceinline__ float wave_sum(float x) {
    x += cdpp0<0xB1>(x); x += cdpp0<0x4E>(x); x += cdpp0<0x141>(x); x += cdpp0<0x140>(x);
    { auto r = __builtin_amdgcn_permlane16_swap(__float_as_uint(x), __float_as_uint(x), false, false); const unsigned a_ = r[0], b_ = r[1]; x = __uint_as_float(a_) + __uint_as_float(b_); }
    { auto r = __builtin_amdgcn_permlane32_swap(__float_as_uint(x), __float_as_uint(x), false, false); const unsigned a_ = r[0], b_ = r[1]; x = __uint_as_float(a_) + __uint_as_float(b_); }
    return x; }
template <int CTRL> __device__ __forceinline__ float cdpp(float v) { return __builtin_bit_cast(float, __builtin_amdgcn_update_dpp(0, __builtin_bit_cast(int, v), CTRL, 0xF, 0xF, true)); }
__device__ __forceinline__ float wave_sum_dpp(float x) {
    x += cdpp<0xB1>(x); x += cdpp<0x4E>(x); x += cdpp<0x141>(x); x += cdpp<0x140>(x);
    { auto r = __builtin_amdgcn_permlane16_swap(__float_as_uint(x), __float_as_uint(x), false, false); const unsigned a_ = r[0], b_ = r[1]; x = __uint_as_float(a_) + __uint_as_float(b_); }
    { auto r = __builtin_amdgcn_permlane32_swap(__float_as_uint(x), __float_as_uint(x), false, false); const unsigned a_ = r[0], b_ = r[1]; x = __uint_as_float(a_) + __uint_as_float(b_); }
    return x; }
__device__ __forceinline__ float rl(float v, int l) { return __builtin_bit_cast(float, __builtin_amdgcn_readlane(__builtin_bit_cast(int, v), l)); }
__device__ __forceinline__ float wave_max(float v) {
#pragma unroll
    for (int o = 1; o < 64; o <<= 1) v = fmaxf(v, __shfl_xor(v, o));
    return v;
}

#define XB_TMO      128
#define XB_XCNT(j)  (256  + 64 * (j))
#define XB_XSUB(j)  (1280 + 64 * (j))
#define XB_XGEN(j)  (2304 + 64 * (j))
#define XB_TOP      3328
#define XB_TOPGEN   3392
#define XCD_BAR_WORDS 3456
#define XB_SPIN_CAP (1u << 18)
__device__ __forceinline__ unsigned xb_ld(unsigned* p)              { return __hip_atomic_load(p, __ATOMIC_RELAXED, __HIP_MEMORY_SCOPE_AGENT); }
__device__ __forceinline__ unsigned xb_add(unsigned* p, unsigned v) { return __hip_atomic_fetch_add(p, v, __ATOMIC_RELAXED, __HIP_MEMORY_SCOPE_AGENT); }
__device__ __forceinline__ unsigned xb_xcc_id() { return (unsigned)__builtin_amdgcn_s_getreg((3 << 11) | 20) & 0xFu; }
#define XB_SPIN(cond, bar) do { unsigned _sp = 0; while (cond) { __builtin_amdgcn_s_sleep(1); \
    if ((++_sp & 255u) == 0u) { if (xb_ld(&(bar)[XB_TMO])) break; if (_sp > XB_SPIN_CAP) { atomicAdd(&(bar)[XB_TMO], 1u); break; } } } } while (0)
struct XcdBarrier { unsigned* bar; unsigned x; volatile LAS unsigned* st; };
__device__ __forceinline__ XcdBarrier xcd_barrier_post(unsigned* bar, volatile LAS unsigned* st) {
    XcdBarrier b; b.bar = bar; b.x = xb_xcc_id(); b.st = st;
    if (threadIdx.x == 0) (void)xb_add(&bar[XB_XCNT(b.x)], 1u);
    return b;
}
__device__ __forceinline__ void xcd_barrier_complete(unsigned* bar, unsigned x, unsigned& nloc, unsigned& nx) {
    const unsigned G = gridDim.x * gridDim.y * gridDim.z;
    unsigned sum, cnt, mine, sp = 0u;
    for (;;) {
        sum = 0u; cnt = 0u; mine = 0u;
#pragma unroll
        for (unsigned j = 0; j < 16; ++j) { const unsigned c = xb_ld(&bar[XB_XCNT(j)]); sum += c; cnt += (c > 0u) ? 1u : 0u; mine = (j == x) ? c : mine; }
        if (sum == G) break;
        __builtin_amdgcn_s_sleep(1);
        if ((++sp & 255u) == 0u) { if (xb_ld(&bar[XB_TMO])) break; if (sp > XB_SPIN_CAP) { atomicAdd(&bar[XB_TMO], 1u); break; } }
    }
    nloc = mine > 0u ? mine : 1u; nx = cnt > 0u ? cnt : 1u;
}
__device__ __forceinline__ void xcd_barrier(const XcdBarrier& b, int wave0_ = -1) {
    asm volatile("s_waitcnt vmcnt(0)" ::: "memory");
    __syncthreads();
    bool leader_;
    if (wave0_ < 0) leader_ = threadIdx.x == 0;
    else { int l_; asm volatile("v_mbcnt_lo_u32_b32 %0, -1, 0\n\tv_mbcnt_hi_u32_b32 %0, -1, %0" : "=v"(l_)); leader_ = (wave0_ == 0) && (l_ == 0); }
    if (leader_) {
        unsigned* bar = b.bar;
        __builtin_amdgcn_s_waitcnt(0);
        unsigned nloc = b.st[0], nx = b.st[1];
        if (nloc == 0u) { xcd_barrier_complete(bar, b.x, nloc, nx); b.st[0] = nloc; b.st[1] = nx; }
        const unsigned old = xb_add(&bar[XB_XSUB(b.x)], 1u);
        const unsigned gen = old / nloc;
        if (old + 1u == (gen + 1u) * nloc) {
            __builtin_amdgcn_fence(__ATOMIC_RELEASE, "agent");
            asm volatile("s_waitcnt vmcnt(0)" ::: "memory");
            const unsigned og = xb_add(&bar[XB_TOP], 1u);
            const unsigned tg = og / nx;
            if (og + 1u == (tg + 1u) * nx) xb_add(&bar[XB_TOPGEN], 1u);
            else XB_SPIN(xb_ld(&bar[XB_TOPGEN]) == tg, bar);
            __builtin_amdgcn_fence(__ATOMIC_ACQUIRE, "agent");
            xb_add(&bar[XB_XGEN(b.x)], 1u);
            asm volatile("s_waitcnt vmcnt(0)" ::: "memory");
        } else {
            XB_SPIN(xb_ld(&bar[XB_XGEN(b.x)]) == gen, bar);
            __builtin_amdgcn_fence(__ATOMIC_ACQUIRE, "agent");
            asm volatile("s_waitcnt vmcnt(0)" ::: "memory");
        }
    }
    __syncthreads();
}

__device__ __forceinline__ void grp_barrier(unsigned* cnt, unsigned members, unsigned& gen, unsigned* tmo) {
    asm volatile("s_waitcnt vmcnt(0)" ::: "memory");
    __syncthreads();
    ++gen;
    if (threadIdx.x == 0) {
        __builtin_amdgcn_fence(__ATOMIC_RELEASE, "agent");
        asm volatile("s_waitcnt vmcnt(0)" ::: "memory");
        (void)xb_add(cnt, 1u);
        const unsigned target = gen * members; unsigned sp = 0u;
        while (xb_ld(cnt) < target) { __builtin_amdgcn_s_sleep(1); if ((++sp & 255u) == 0u) { if (xb_ld(tmo)) break; if (sp > XB_SPIN_CAP) { atomicAdd(tmo, 1u); break; } } }
        __builtin_amdgcn_fence(__ATOMIC_ACQUIRE, "agent");
        asm volatile("s_waitcnt vmcnt(0)" ::: "memory");
    }
    __syncthreads();
}

__device__ __forceinline__ void transpose_item(const float* W, int K, int N, bf16* WT, LAS float* scr, int item, int lane, const float* ks) {
    const int nblk = N / 32, kb = item / nblk, nb = item % nblk, k0 = 64 * kb, n0 = 32 * nb;
    f32x4 wv[8];
#pragma unroll
    for (int i = 0; i < 8; ++i) wv[i] = *(const f32x4*)(W + (size_t)(k0 + 8 * i + (lane >> 3)) * N + n0 + 4 * (lane & 7));
#pragma unroll
    for (int i = 0; i < 8; ++i) { const int kk = 8 * i + (lane >> 3); const float g_ = ks ? ks[k0 + kk] : 1.f; LAS float* d_ = scr + kk * 33 + 4 * (lane & 7);
        d_[0] = wv[i].x * g_; d_[1] = wv[i].y * g_; d_[2] = wv[i].z * g_; d_[3] = wv[i].w * g_; }
    LDS_WAIT(); asm volatile("" ::: "memory");
    const int c = lane & 7;
#pragma unroll
    for (int j = 0; j < 4; ++j) { const int n = (lane >> 3) + 8 * j; const LAS float* s = scr + (8 * c) * 33 + n;
        v4u o; o.x = pk2(s[0 * 33], s[1 * 33]); o.y = pk2(s[2 * 33], s[3 * 33]); o.z = pk2(s[4 * 33], s[5 * 33]); o.w = pk2(s[6 * 33], s[7 * 33]);
        *(GAS v4u*)(WT + (size_t)(n0 + n) * K + k0 + 8 * c) = o; }
    LDS_WAIT(); asm volatile("" ::: "memory");
}
__device__ __forceinline__ void rms_row_to_bf16(const float* xrow, const float* w, bf16* orow, int lane) {
    const f32x4* xr = (const f32x4*)xrow + lane; const f32x4* wr = (const f32x4*)w + lane;
    f32x4 v[4]; float s = 0.f;
#pragma unroll
    for (int j = 0; j < 4; ++j) { v[j] = xr[64 * j]; s += (v[j].x * v[j].x + v[j].y * v[j].y) + (v[j].z * v[j].z + v[j].w * v[j].w); }
    const float rstd = rsqrtf(wave_sum(s) * (1.f / 1024.f) + 1e-6f);
    unsigned long long* o8 = (unsigned long long*)orow + lane;
#pragma unroll
    for (int j = 0; j < 4; ++j) { const f32x4 wv = wr[64 * j]; const f32x4 o = v[j] * rstd * wv;
        o8[64 * j] = (unsigned long long)pk2(o.x, o.y) | ((unsigned long long)pk2(o.z, o.w) << 32); }
}
__device__ __forceinline__ void row_to_bf16_ss(const float* xrow, bf16* orow, float* ssp4, int lane) {
    const f32x4* xr = (const f32x4*)xrow + lane; float s = 0.f; unsigned long long* o8 = (unsigned long long*)orow + lane;
#pragma unroll
    for (int j = 0; j < 4; ++j) { const f32x4 v = xr[64 * j]; s += (v.x * v.x + v.y * v.y) + (v.z * v.z + v.w * v.w); o8[64 * j] = (unsigned long long)pk2(v.x, v.y) | ((unsigned long long)pk2(v.z, v.w) << 32); }
    s = wave_sum(s); if (lane < 4) ssp4[lane] = lane == 0 ? s : 0.f;
}
__device__ __forceinline__ void rows4_to_bf16_ss(const float* x, bf16* U, float* ssp, int m, int st, int nrows, int lane) {
    f32x4 v[4][4];
#pragma unroll
    for (int r = 0; r < 4; ++r) { const int row = m + r * st; const f32x4* xr = (const f32x4*)(x + (size_t)(row < nrows ? row : m) * 1024) + lane;
#pragma unroll
        for (int j = 0; j < 4; ++j) v[r][j] = xr[64 * j]; }
#pragma unroll
    for (int r = 0; r < 4; ++r) { const int row = m + r * st; if (row < nrows) { float s = 0.f; unsigned long long* o8 = (unsigned long long*)(U + (size_t)row * 1024) + lane;
#pragma unroll
        for (int j = 0; j < 4; ++j) { const f32x4 q = v[r][j]; s += (q.x * q.x + q.y * q.y) + (q.z * q.z + q.w * q.w); o8[64 * j] = (unsigned long long)pk2(q.x, q.y) | ((unsigned long long)pk2(q.z, q.w) << 32); }
        s = wave_sum_dpp(s); if (lane < 4) ssp[(size_t)row * 4 + lane] = lane == 0 ? s : 0.f; } }
}
__device__ __forceinline__ void rows4_bf16_to_f32_norm(const bf16* H, const float* w, float* out, int m, int st, int nrows, int lane) {
    v4u q[4][2];
#pragma unroll
    for (int r = 0; r < 4; ++r) { const int row = m + r * st; const bf16* hr = H + (size_t)(row < nrows ? row : m) * 1024;
#pragma unroll
        for (int j = 0; j < 2; ++j) q[r][j] = *(const v4u*)(hr + j * 512 + lane * 8); }
    f32x4 wv[2][2];
#pragma unroll
    for (int j = 0; j < 2; ++j) { wv[j][0] = *(const f32x4*)(w + j * 512 + lane * 8); wv[j][1] = *(const f32x4*)(w + j * 512 + lane * 8 + 4); }
#pragma unroll
    for (int r = 0; r < 4; ++r) { const int row = m + r * st; if (row < nrows) { float v[2][8]; float s = 0.f;
#pragma unroll
        for (int j = 0; j < 2; ++j) { const v4u t = q[r][j];
            v[j][0] = __uint_as_float(t.x << 16); v[j][1] = __uint_as_float(t.x & 0xffff0000u); v[j][2] = __uint_as_float(t.y << 16); v[j][3] = __uint_as_float(t.y & 0xffff0000u);
            v[j][4] = __uint_as_float(t.z << 16); v[j][5] = __uint_as_float(t.z & 0xffff0000u); v[j][6] = __uint_as_float(t.w << 16); v[j][7] = __uint_as_float(t.w & 0xffff0000u);
#pragma unroll
            for (int e = 0; e < 8; ++e) s += v[j][e] * v[j][e]; }
        const float rstd = rsqrtf(wave_sum_dpp(s) * (1.f / 1024.f) + 1e-6f); float* orow = out + (size_t)row * 1024;
#pragma unroll
        for (int j = 0; j < 2; ++j) { f32x4 o0, o1; o0.x = v[j][0] * rstd * wv[j][0].x; o0.y = v[j][1] * rstd * wv[j][0].y; o0.z = v[j][2] * rstd * wv[j][0].z; o0.w = v[j][3] * rstd * wv[j][0].w;
            o1.x = v[j][4] * rstd * wv[j][1].x; o1.y = v[j][5] * rstd * wv[j][1].y; o1.z = v[j][6] * rstd * wv[j][1].z; o1.w = v[j][7] * rstd * wv[j][1].w;
            *(f32x4*)(orow + j * 512 + lane * 8) = o0; *(f32x4*)(orow + j * 512 + lane * 8 + 4) = o1; } } }
}
__device__ __forceinline__ void rms_row_bf16_to_f32(const bf16* hrow, const float* w, float* orow, int lane) {
    float v[2][8]; float s = 0.f;
#pragma unroll
    for (int j = 0; j < 2; ++j) { const v4u q = *(const v4u*)(hrow + j * 512 + lane * 8);
        v[j][0] = __uint_as_float(q.x << 16); v[j][1] = __uint_as_float(q.x & 0xffff0000u); v[j][2] = __uint_as_float(q.y << 16); v[j][3] = __uint_as_float(q.y & 0xffff0000u);
        v[j][4] = __uint_as_float(q.z << 16); v[j][5] = __uint_as_float(q.z & 0xffff0000u); v[j][6] = __uint_as_float(q.w << 16); v[j][7] = __uint_as_float(q.w & 0xffff0000u);
#pragma unroll
        for (int e = 0; e < 8; ++e) s += v[j][e] * v[j][e]; }
    const float rstd = rsqrtf(wave_sum(s) * (1.f / 1024.f) + 1e-6f);
#pragma unroll
    for (int j = 0; j < 2; ++j) { const f32x4 w0 = *(const f32x4*)(w + j * 512 + lane * 8), w1 = *(const f32x4*)(w + j * 512 + lane * 8 + 4);
        f32x4 o0, o1; o0.x = v[j][0] * rstd * w0.x; o0.y = v[j][1] * rstd * w0.y; o0.z = v[j][2] * rstd * w0.z; o0.w = v[j][3] * rstd * w0.w;
        o1.x = v[j][4] * rstd * w1.x; o1.y = v[j][5] * rstd * w1.y; o1.z = v[j][6] * rstd * w1.z; o1.w = v[j][7] * rstd * w1.w;
        *(f32x4*)(orow + j * 512 + lane * 8) = o0; *(f32x4*)(orow + j * 512 + lane * 8 + 4) = o1; }
}
__device__ __forceinline__ void rms_row_inplace(float* xrow, const float* w, int lane) {
    f32x4* xr = (f32x4*)xrow + lane; const f32x4* wr = (const f32x4*)w + lane;
    f32x4 v[4]; float s = 0.f;
#pragma unroll
    for (int j = 0; j < 4; ++j) { v[j] = xr[64 * j]; s += (v[j].x * v[j].x + v[j].y * v[j].y) + (v[j].z * v[j].z + v[j].w * v[j].w); }
    const float rstd = rsqrtf(wave_sum(s) * (1.f / 1024.f) + 1e-6f);
#pragma unroll
    for (int j = 0; j < 4; ++j) { const f32x4 wv = wr[64 * j]; xr[64 * j] = v[j] * rstd * wv; }
}

namespace dattn {
typedef short bf16x8 __attribute__((ext_vector_type(8)));
typedef short s16x4 __attribute__((ext_vector_type(4)));
typedef float f32x16 __attribute__((ext_vector_type(16)));
typedef unsigned u32x4 __attribute__((ext_vector_type(4)));
typedef short v4i16_t __attribute__((ext_vector_type(4)));
typedef __attribute__((address_space(3))) const char* lds_cptr;
constexpr int PITCH = 3072, QB = 128, KVBLK = 64, SEQL = 4096;
constexpr int TBX = 392;
constexpr int SLOTB = 16384, LDS_K = 0, LDS_V = 3 * SLOTB, LDS_WS = 6 * SLOTB, LDS_TBL = LDS_WS + 8 * 256, LDS_END = LDS_TBL + 4 * TBX * 4;
constexpr int STG_F = 0, STG_B = 65536;
constexpr float C2 = 0.125f * 1.4426950408889634f;
constexpr int THRL = 8;
#define DA_SBAR() __builtin_amdgcn_sched_barrier(0)
#define DA_WAIT_BAR(N) asm volatile("s_waitcnt vmcnt(" #N ") lgkmcnt(0)\n\ts_barrier" ::: "memory")
#define DA_MFMA(a, b, c) __builtin_amdgcn_mfma_f32_32x32x16_bf16(a, b, c, 0, 0, 0)
__device__ __forceinline__ int crow(int r, int hi) { return (r & 3) + 8 * (r >> 2) + 4 * hi; }
__device__ __forceinline__ void glds16x2(const void* g0, const void* g1, unsigned d0, unsigned d1) {
    asm volatile("s_mov_b32 m0, %2\n\ts_nop 0\n\tglobal_load_lds_dwordx4 %0, off\n\ts_mov_b32 m0, %3\n\ts_nop 0\n\tglobal_load_lds_dwordx4 %1, off" :: "v"(g0), "v"(g1), "s"(d0), "s"(d1) : "memory", "m0"); }
__device__ __forceinline__ void glds16(const void* gsrc, unsigned lds_dst) { unsigned keep;
    asm volatile("s_mov_b32 %0, m0\n\ts_mov_b32 m0, %2\n\ts_nop 0\n\tglobal_load_lds_dwordx4 %1, off\n\ts_mov_b32 m0, %0" : "=&s"(keep) : "v"(gsrc), "s"(lds_dst) : "memory"); }
typedef float f32x2_t __attribute__((ext_vector_type(2))); typedef __bf16 bf16x2_t __attribute__((ext_vector_type(2)));
__device__ __forceinline__ unsigned cvtpk(float lo, float hi) { f32x2_t v = {lo, hi}; bf16x2_t b = __builtin_convertvector(v, bf16x2_t); return __builtin_bit_cast(unsigned, b); }
__device__ __forceinline__ void kload2(bf16x8* kf, lds_cptr kp, int j) { kf[2 * j] = *(const __attribute__((address_space(3))) bf16x8*)(kp + j * 2048); kf[2 * j + 1] = *(const __attribute__((address_space(3))) bf16x8*)(kp + j * 2048 + 512); }
__device__ __forceinline__ s16x4 vtr(lds_cptr p) { return __builtin_bit_cast(s16x4, __builtin_amdgcn_ds_read_tr16_b64_v4i16((__attribute__((address_space(3))) v4i16_t*)p)); }
#define DA_MX3(a, b, c) __builtin_fmaxf(__builtin_fmaxf((a), (b)), (c))
__device__ __forceinline__ float rowmax(const f32x16& p0, const f32x16& p1) {
    float a = DA_MX3(p0[0], p0[1], p1[0]), b = DA_MX3(p0[2], p0[3], p1[1]); a = DA_MX3(a, p1[2], p1[3]);
#pragma unroll
    for (int r = 4; r < 16; r += 4) { a = DA_MX3(a, p0[r], p0[r + 1]); b = DA_MX3(b, p0[r + 2], p0[r + 3]); a = DA_MX3(a, p1[r], p1[r + 1]); b = DA_MX3(b, p1[r + 2], p1[r + 3]); }
    float m = __builtin_fmaxf(a, b); auto rr = __builtin_amdgcn_permlane32_swap(__float_as_uint(m), __float_as_uint(m), false, false);
    return __builtin_fmaxf(__uint_as_float(rr[0]), __uint_as_float(rr[1])); }
__device__ __forceinline__ void band(f32x16& p0, f32x16& p1, int nrel, int hi, const __attribute__((address_space(3))) float* tbl, bool mask) {
    const int lim = mask ? 0 : -100000;
#pragma unroll
    for (int j = 0; j < 4; ++j) { int u0 = nrel - (8 * j + 4 * hi); asm volatile("" : "+v"(u0));
        { const int a0 = 256 - u0; const f32x4 b0 = *(const __attribute__((address_space(3))) f32x4*)(tbl + (a0 & 3) * TBX + (a0 & ~3));
#pragma unroll
          for (int k = 0; k < 4; ++k) { const int r = 4 * j + k; p0[r] = (u0 - k < lim) ? -INFINITY : p0[r] + b0[k]; } }
        { const int a1 = 288 - u0; const f32x4 b1 = *(const __attribute__((address_space(3))) f32x4*)(tbl + (a1 & 3) * TBX + (a1 & ~3));
#pragma unroll
          for (int k = 0; k < 4; ++k) { const int r = 4 * j + k; p1[r] = (u0 - 32 - k < lim) ? -INFINITY : p1[r] + b1[k]; } } } }

template <bool NOBAR> __device__ __forceinline__ void unit(int b, int h, int qb, const unsigned short* QKV, unsigned short* YC, __attribute__((address_space(3))) unsigned char* lds, const float* ln_w, float lam, float osc, int tid) {
    typedef unsigned short bf16;
    const int wid = __builtin_amdgcn_readfirstlane(tid >> 6); const int qs = wid & 3, c = wid >> 2;
    const long rowbase = (long)b * SEQL; const int q0 = qb * QB, NT = (q0 + QB) / KVBLK;
    const bf16* Qw = QKV + (rowbase + q0 + qs * 32) * PITCH + h * 128 + c * 64;
    f32x16 o[4]; float l_reg = 0.f;
    __attribute__((address_space(3))) float* wsf = (__attribute__((address_space(3))) float*)(lds + LDS_WS) + wid * 64;
    {
    const int lane = tid & 63, r32 = lane & 31, hi = lane >> 5;
    const bf16* Kh = QKV + rowbase * PITCH + 1024 + h * 128; const bf16* Vh = QKV + rowbase * PITCH + 2048 + h * 128;
    const unsigned lds0 = (unsigned)(uintptr_t)lds;
    const __attribute__((address_space(3))) float* tbl = (const __attribute__((address_space(3))) float*)(lds + LDS_TBL);
    const bf16* ksrc = Kh + (long)lane * PITCH + wid * 8;
    const bf16* vsrc = Vh + (long)(16 * (wid & 3) + (lane >> 2)) * PITCH + (wid >> 2) * 32 + (lane & 3) * 8;
    const unsigned kdst = lds0 + LDS_K + wid * 1024, vdst = lds0 + LDS_V + wid * 1024;
#define DA_DMA_K(t, slot) do { glds16x2(ksrc + (long)(t) * KVBLK * PITCH, ksrc + (long)(t) * KVBLK * PITCH + 64, (unsigned)__builtin_amdgcn_readfirstlane(kdst + (slot)), (unsigned)__builtin_amdgcn_readfirstlane(kdst + (slot) + 8192)); } while (0)
#define DA_DMA_V(t, slot) do { glds16x2(vsrc + (long)(t) * KVBLK * PITCH, vsrc + (long)(t) * KVBLK * PITCH + 64, (unsigned)__builtin_amdgcn_readfirstlane(vdst + (slot)), (unsigned)__builtin_amdgcn_readfirstlane(vdst + (slot) + 8192)); } while (0)
    const lds_cptr shm3 = (lds_cptr)lds;
    const lds_cptr kp0 = shm3 + LDS_K + c * 8192 + hi * 1024 + r32 * 16;
    const lds_cptr vp0 = shm3 + LDS_V + ((lane >> 4) & 1) * 32 + (lane & 3) * 8 + (4 * hi + ((lane & 15) >> 2)) * 64;
    DA_DMA_K(0, 0); DA_DMA_V(0, 0); DA_DMA_K(1, SLOTB);
    bf16x8 qr[4];
#pragma unroll
    for (int d0 = 0; d0 < 4; ++d0) qr[d0] = *reinterpret_cast<const bf16x8*>(&Qw[(long)r32 * PITCH + d0 * 16 + hi * 8]);
    float mhat = 0.f;
    const int qn = q0 + qs * 32 + r32;
    bool resc = false;
    int sl_prev = 2 * SLOTB, sl_cur = 0, sl_next = SLOTB;
#define DA_ROT() do { sl_prev = sl_cur; sl_cur = sl_next; sl_next = (sl_next == 2 * SLOTB) ? 0 : sl_next + SLOTB; } while (0)
#define DA_RESC() do { if (resc) { asm volatile("s_waitcnt lgkmcnt(0)" ::: "memory"); \
      _Pragma("unroll") for (int d_ = 0; d_ < 4; ++d_) _Pragma("unroll") for (int r = 0; r < 16; ++r) o[d_][r] *= wsf[crow(r, hi)]; } } while (0)
#define DA_BAND(P0, P1, t) do { if ((t) >= NT - 4) band(P0, P1, qn - (t) * KVBLK, hi, tbl, (t) >= NT - 2); } while (0)
    DA_DMA_K(2, 2 * SLOTB);
    if (wid >= 4) __builtin_amdgcn_s_setprio(1);
    DA_WAIT_BAR(2);
    float zf = 0.f; asm volatile("" : "+v"(zf));
    f32x16 negm;
#pragma unroll
    for (int r = 0; r < 16; ++r) { o[0][r] = zf; o[1][r] = zf; o[2][r] = zf; o[3][r] = zf; negm[r] = zf; }
    asm volatile("" : "+v"(negm));
    f32x16 C0, C1; bf16x8 kf[8]; s16x4 vlo[8], vhi[8];
    u32x4 pw0, pw1, pw2, pw3;
#pragma unroll
    for (int j = 0; j < 4; ++j) kload2(kf, kp0, j);
    C0 = DA_MFMA(kf[0], qr[0], negm); C1 = DA_MFMA(kf[1], qr[0], negm);
#pragma unroll
    for (int j = 1; j < 4; ++j) { C0 = DA_MFMA(kf[2 * j], qr[j], C0); C1 = DA_MFMA(kf[2 * j + 1], qr[j], C1); }
    DA_BAND(C0, C1, 0);
    { const float rm = rowmax(C0, C1); mhat = rm;
#pragma unroll
      for (int r = 0; r < 16; ++r) { C0[r] = __builtin_amdgcn_exp2f(C0[r] - rm); C1[r] = __builtin_amdgcn_exp2f(C1[r] - rm); negm[r] = -rm; }
      asm volatile("" : "+v"(negm));
      float sacc = 0.f;
#pragma unroll
      for (int r = 0; r < 16; ++r) sacc += C0[r] + C1[r];
      l_reg = sacc; }
#define DA_PK4(P, i) (u32x4){cvtpk(P[i], P[i + 1]), cvtpk(P[i + 2], P[i + 3]), cvtpk(P[i + 4], P[i + 5]), cvtpk(P[i + 6], P[i + 7])}
    pw0 = DA_PK4(C0, 0); pw1 = DA_PK4(C0, 8); pw2 = DA_PK4(C1, 0); pw3 = DA_PK4(C1, 8);
    DA_DMA_V(1, SLOTB);
    kload2(kf, kp0 + sl_next, 0); kload2(kf, kp0 + sl_next, 1);
    if (NT == 2) { DA_WAIT_BAR(0); } else { DA_WAIT_BAR(2); }
    DA_ROT();
#define DA_PAF(k) __builtin_bit_cast(bf16x8, pw##k)
#define DA_VFR(i) (bf16x8){vlo[i][0], vlo[i][1], vlo[i][2], vlo[i][3], vhi[i][0], vhi[i][1], vhi[i][2], vhi[i][3]}
#define DA_VRD(slot, db, ks) do { vlo[slot] = vtr(vp_ + ((db) * 4096 + (ks) * 1024)); vhi[slot] = vtr(vp_ + ((db) * 4096 + (ks) * 1024 + 512)); } while (0)
#define DA_PIN(x) asm volatile("" : "+v"(x))
#define DA_EX2(X, i) do { X[i] = __builtin_amdgcn_exp2f(X[i]); X[(i) + 1] = __builtin_amdgcn_exp2f(X[(i) + 1]); } while (0)
#define DA_STEP(t, GK, GV, GL, BANDON) do { DA_SBAR(); \
    if (GK) { DA_DMA_K((t) + 2, sl_prev); } \
    const lds_cptr vp_ = vp0 + sl_prev; const lds_cptr kp_ = kp0 + sl_cur; \
    kload2(kf, kp_, 2); DA_VRD(0, 0, 0); DA_SBAR(); \
    C0 = DA_MFMA(kf[0], qr[0], negm); kload2(kf, kp_, 3); DA_SBAR(); \
    C1 = DA_MFMA(kf[1], qr[0], negm); DA_VRD(1, 1, 0); DA_SBAR(); \
    C0 = DA_MFMA(kf[2], qr[1], C0);   DA_VRD(2, 2, 0); DA_SBAR(); \
    C1 = DA_MFMA(kf[3], qr[1], C1);   DA_VRD(3, 3, 0); DA_SBAR(); \
    C0 = DA_MFMA(kf[4], qr[2], C0);   DA_VRD(4, 0, 1); DA_SBAR(); \
    C1 = DA_MFMA(kf[5], qr[2], C1);   DA_VRD(5, 1, 1); DA_SBAR(); \
    C0 = DA_MFMA(kf[6], qr[3], C0);   DA_VRD(6, 2, 1); DA_SBAR(); \
    C1 = DA_MFMA(kf[7], qr[3], C1);   DA_VRD(7, 3, 1); DA_SBAR(); \
    if (GV) { DA_DMA_V((t) + 1, sl_next); } \
    if (BANDON) { DA_BAND(C0, C1, t); } \
    { float rm = rowmax(C0, C1); resc = false; \
      if (__builtin_expect(__any(rm > (float)THRL), 0)) { const float dl = __builtin_fmaxf(rm, 0.f); mhat += dl; \
        _Pragma("unroll") for (int r = 0; r < 16; ++r) { C0[r] -= dl; C1[r] -= dl; } \
        _Pragma("unroll") for (int r = 0; r < 16; ++r) negm[r] = -mhat; asm volatile("" : "+v"(negm)); \
        const float f = __builtin_amdgcn_exp2f(-dl); l_reg *= f; if (hi == 0) wsf[r32] = f; resc = true; } } \
    DA_SBAR(); float sacc = 0.f; \
    o[0] = DA_MFMA(DA_PAF(0), DA_VFR(0), o[0]); DA_EX2(C0, 0);  DA_PIN(C0); DA_VRD(0, 0, 2); DA_SBAR(); \
    o[1] = DA_MFMA(DA_PAF(0), DA_VFR(1), o[1]); DA_EX2(C0, 2);  DA_PIN(C0); DA_VRD(1, 1, 2); DA_SBAR(); \
    o[2] = DA_MFMA(DA_PAF(0), DA_VFR(2), o[2]); DA_EX2(C0, 4);  DA_PIN(C0); DA_VRD(2, 2, 2); DA_SBAR(); \
    o[3] = DA_MFMA(DA_PAF(0), DA_VFR(3), o[3]); DA_EX2(C0, 6);  DA_PIN(C0); DA_VRD(3, 3, 2); DA_SBAR(); \
    o[0] = DA_MFMA(DA_PAF(1), DA_VFR(4), o[0]); DA_EX2(C0, 8);  sacc += C0[0] + C0[1]; pw0[0] = cvtpk(C0[0], C0[1]); pw0[1] = cvtpk(C0[2], C0[3]); DA_PIN(C0); DA_PIN(pw0); DA_PIN(sacc); DA_VRD(4, 0, 3); DA_SBAR(); \
    o[1] = DA_MFMA(DA_PAF(1), DA_VFR(5), o[1]); DA_EX2(C0, 10); sacc += C0[2] + C0[3]; pw0[2] = cvtpk(C0[4], C0[5]); pw0[3] = cvtpk(C0[6], C0[7]); DA_PIN(C0); DA_PIN(pw0); DA_PIN(sacc); DA_VRD(5, 1, 3); DA_SBAR(); \
    o[2] = DA_MFMA(DA_PAF(1), DA_VFR(6), o[2]); DA_EX2(C0, 12); sacc += C0[4] + C0[5]; sacc += C0[6] + C0[7]; DA_PIN(C0); DA_PIN(sacc); DA_VRD(6, 2, 3); DA_SBAR(); \
    o[3] = DA_MFMA(DA_PAF(1), DA_VFR(7), o[3]); DA_EX2(C0, 14); sacc += C0[8] + C0[9]; sacc += C0[10] + C0[11]; DA_PIN(C0); DA_PIN(sacc); DA_VRD(7, 3, 3); DA_SBAR(); \
    o[0] = DA_MFMA(DA_PAF(2), DA_VFR(0), o[0]); DA_EX2(C1, 0);  pw1[0] = cvtpk(C0[8], C0[9]); pw1[1] = cvtpk(C0[10], C0[11]); sacc += C0[12] + C0[13]; DA_PIN(C1); DA_PIN(pw1); DA_PIN(sacc); DA_SBAR(); \
    o[1] = DA_MFMA(DA_PAF(2), DA_VFR(1), o[1]); DA_EX2(C1, 2);  pw1[2] = cvtpk(C0[12], C0[13]); pw1[3] = cvtpk(C0[14], C0[15]); sacc += C0[14] + C0[15]; DA_PIN(C1); DA_PIN(pw1); DA_PIN(sacc); DA_SBAR(); \
    o[2] = DA_MFMA(DA_PAF(2), DA_VFR(2), o[2]); DA_EX2(C1, 4);  sacc += C1[0] + C1[1]; sacc += C1[2] + C1[3]; DA_PIN(C1); DA_PIN(sacc); DA_SBAR(); \
    o[3] = DA_MFMA(DA_PAF(2), DA_VFR(3), o[3]); DA_EX2(C1, 6);  sacc += C1[4] + C1[5]; DA_PIN(C1); DA_PIN(sacc); DA_SBAR(); \
    o[0] = DA_MFMA(DA_PAF(3), DA_VFR(4), o[0]); DA_EX2(C1, 8);  pw2[0] = cvtpk(C1[0], C1[1]); pw2[1] = cvtpk(C1[2], C1[3]); sacc += C1[6] + C1[7]; DA_PIN(C1); DA_PIN(pw2); DA_PIN(sacc); if (GL) { kload2(kf, kp0 + sl_next, 0); } DA_SBAR(); \
    o[1] = DA_MFMA(DA_PAF(3), DA_VFR(5), o[1]); DA_EX2(C1, 10); pw2[2] = cvtpk(C1[4], C1[5]); pw2[3] = cvtpk(C1[6], C1[7]); DA_PIN(C1); DA_PIN(pw2); if (GL) { kload2(kf, kp0 + sl_next, 1); } DA_SBAR(); \
    o[2] = DA_MFMA(DA_PAF(3), DA_VFR(6), o[2]); DA_EX2(C1, 12); sacc += C1[8] + C1[9]; sacc += C1[10] + C1[11]; DA_PIN(C1); DA_PIN(sacc); DA_SBAR(); \
    o[3] = DA_MFMA(DA_PAF(3), DA_VFR(7), o[3]); DA_EX2(C1, 14); DA_PIN(C1); DA_SBAR(); \
    sacc += C1[12] + C1[13]; sacc += C1[14] + C1[15]; pw3 = DA_PK4(C1, 8); l_reg += sacc; \
    } while (0)
#define DA_ENDW(tt) do { if ((tt) + 2 < NT) { DA_WAIT_BAR(2); } else { DA_WAIT_BAR(0); } } while (0)
    int t = 1;
    for (; t + 5 < NT; t += 2) {
        DA_STEP(t, true, true, true, false);     if (NOBAR) asm volatile("s_waitcnt vmcnt(2) lgkmcnt(0)" ::: "memory"); else DA_WAIT_BAR(2); DA_RESC(); DA_ROT();
        DA_STEP(t + 1, true, true, true, false); if (NOBAR) asm volatile("s_waitcnt vmcnt(2) lgkmcnt(0)" ::: "memory"); else DA_WAIT_BAR(2); DA_RESC(); DA_ROT();
    }
    for (; t + 1 < NT; t += 2) {
        DA_STEP(t, (t + 2 < NT), (t + 1 < NT), (t + 1 < NT), true);         DA_ENDW(t);     DA_RESC(); DA_ROT();
        DA_STEP(t + 1, (t + 3 < NT), (t + 2 < NT), (t + 2 < NT), true);     DA_ENDW(t + 1); DA_RESC(); DA_ROT();
    }
    DA_STEP(NT - 1, false, false, false, true); DA_RESC();
    { const lds_cptr vp_ = vp0 + sl_cur;
#pragma unroll
      for (int ks = 0; ks < 4; ++ks) {
#pragma unroll
          for (int db = 0; db < 4; ++db) DA_VRD(db, db, ks);
          const bf16x8 pa = ks == 0 ? DA_PAF(0) : ks == 1 ? DA_PAF(1) : ks == 2 ? DA_PAF(2) : DA_PAF(3);
#pragma unroll
          for (int db = 0; db < 4; ++db) o[db] = DA_MFMA(pa, DA_VFR(db), o[db]); } }
    __builtin_amdgcn_s_setprio(0);
    }
    int te_ = tid; asm volatile("" : "+v"(te_)); const int lane_e = te_ & 63;
    const int r32 = lane_e & 31, hi = lane_e >> 5, lane = lane_e;
    float lnw[4];
#pragma unroll
    for (int db = 0; db < 4; ++db) lnw[db] = ln_w[db * 32 + r32];
    {
    { auto rr = __builtin_amdgcn_permlane32_swap(__float_as_uint(l_reg), __float_as_uint(l_reg), false, false); l_reg = __uint_as_float(rr[0]) + __uint_as_float(rr[1]); }
    if (hi == 0) wsf[32 + r32] = l_reg; asm volatile("s_waitcnt lgkmcnt(0)" ::: "memory");
    { const float cs = c == 0 ? 1.f : -lam;
#pragma unroll
      for (int r = 0; r < 16; ++r) { const float rl_ = __builtin_amdgcn_rcpf(wsf[32 + crow(r, hi)]) * cs;
#pragma unroll
          for (int db = 0; db < 4; ++db) o[db][r] *= rl_; } }
    asm volatile("s_waitcnt lgkmcnt(0)\n\ts_barrier" ::: "memory");
    __attribute__((address_space(3))) float* stf = (__attribute__((address_space(3))) float*)(lds + STG_F) + qs * 4096;
    if (c == 1) {
#pragma unroll
        for (int r = 0; r < 16; ++r)
#pragma unroll
            for (int db = 0; db < 4; ++db) stf[crow(r, hi) * 128 + db * 32 + r32] = o[db][r];
    }
    asm volatile("s_waitcnt lgkmcnt(0)\n\ts_barrier" ::: "memory");
    if (c == 0) {
        float ss[16];
#pragma unroll
        for (int r = 0; r < 16; ++r) { float s = 0.f;
#pragma unroll
            for (int db = 0; db < 4; ++db) { o[db][r] += stf[crow(r, hi) * 128 + db * 32 + r32]; s += o[db][r] * o[db][r]; }
            ss[r] = s; }
#pragma unroll
        for (int r = 0; r < 16; ++r) { float s = ss[r];
            s += cdpp<0xB1>(s); s += cdpp<0x4E>(s); s += cdpp<0x141>(s); s += cdpp<0x140>(s);
            { auto r16_ = __builtin_amdgcn_permlane16_swap(__float_as_uint(s), __float_as_uint(s), false, false); const unsigned a_ = r16_[0], b_ = r16_[1]; s = __uint_as_float(a_) + __uint_as_float(b_); }
            ss[r] = rsqrtf(s * (1.f / 128.f) + 1e-6f) * osc; }
        __attribute__((address_space(3))) bf16* stb = (__attribute__((address_space(3))) bf16*)(lds + STG_B) + qs * 4096;
#pragma unroll
        for (int r = 0; r < 16; ++r)
#pragma unroll
            for (int db = 0; db < 4; ++db) { const float v = o[db][r] * ss[r] * lnw[db]; stb[crow(r, hi) * 128 + db * 32 + r32] = (bf16)cvtpk(v, 0.f); }
        asm volatile("s_waitcnt lgkmcnt(0)" ::: "memory");
        bf16* Ow = YC + (rowbase + q0 + qs * 32) * 1024 + h * 128;
#pragma unroll
        for (int i = 0; i < 8; ++i) { const int row = i * 4 + (lane >> 4), ch = lane & 15; const u32x4 v = *(const __attribute__((address_space(3))) u32x4*)(stb + row * 128 + ch * 8); *(u32x4*)(Ow + (long)row * 1024 + ch * 8) = v; }
    }
    }
    asm volatile("s_waitcnt lgkmcnt(0)\n\ts_barrier" ::: "memory");
#undef DA_DMA_K
#undef DA_DMA_V
#undef DA_ROT
#undef DA_RESC
#undef DA_BAND
#undef DA_PK4
#undef DA_PAF
#undef DA_VFR
#undef DA_VRD
#undef DA_PIN
#undef DA_EX2
#undef DA_STEP
#undef DA_ENDW
}
template <bool NOBAR = false> __device__ __forceinline__ void phase(__attribute__((address_space(3))) unsigned char* lds, int bid, int G, int tid, const unsigned short* QKV, unsigned short* YC, const float* rel_bias, const float* ln_w, float lam, float lam_init) {
    const int vcu = (G % 8 == 0) ? (bid % 8) * (G / 8) + bid / 8 : bid;
    __attribute__((address_space(3))) float* tbl = (__attribute__((address_space(3))) float*)(lds + LDS_TBL);
    int hprev = -1;
    for (int v = vcu; v < 256; v += G) {
        const int bh = v >> 2, s = v & 3, b = bh >> 3, h = bh & 7;
        int tq = tid; asm volatile("" : "+v"(tq));
        if (h != hprev) {
            for (int idx = tq; idx < 4 * TBX; idx += 512) { const int s_ = idx / TBX, y_ = idx - s_ * TBX, dist = 256 - (y_ + s_); float v = 0.f;
                if (dist >= 0 && dist < 128) { int bk; if (dist < 16) bk = dist; else { bk = 16 + (int)(logf((float)dist * (1.f / 16.f)) * (16.f / 2.0794415416798357f)); bk = bk > 31 ? 31 : bk; }
                    v = (rel_bias[bk * 8 + h] - rel_bias[31 * 8 + h]) * 1.4426950408889634f; }
                tbl[idx] = v; }
            hprev = h; }
#pragma unroll 1
        for (int i = 0; i < 8; ++i) { const int qb = (i & 1) ? 31 - 4 * (i >> 1) - s : 4 * (i >> 1) + s;
            int tl = tid; asm volatile("" : "+v"(tl));
            unit<NOBAR>(b, h, qb, QKV, YC, lds, ln_w, lam, 1.f - lam_init, tl); }
    }
}
#undef DA_SBAR
#undef DA_WAIT_BAR
#undef DA_MFMA
#undef DA_MX3
}
namespace mix {
typedef unsigned short bf16;
typedef float f32x2 __attribute__((ext_vector_type(2)));
typedef float f32x4 __attribute__((ext_vector_type(4)));
#define MLAS __attribute__((address_space(3)))
constexpr int REC = 640, BLK = 16, NBLK = 4096 / BLK, RSLOTS = 3;
constexpr int R_A = 0, R_WR = 64, R_W = 128, R_B = 192, R_KM = 256, R_V = 320, R_Q2 = 384, R_K2 = 448, R_V2 = 512, R_SC = 576;
template <int CTRL> __device__ __forceinline__ float dppf(float v) { return __builtin_bit_cast(float, __builtin_amdgcn_update_dpp(0, __builtin_bit_cast(int, v), CTRL, 0xF, 0xF, true)); }
__device__ __forceinline__ float xsum16(float v) { auto r = __builtin_amdgcn_permlane16_swap(__float_as_uint(v), __float_as_uint(v), false, false); const unsigned r0 = r[0], r1 = r[1]; return __uint_as_float(r0) + __uint_as_float(r1); }
__device__ __forceinline__ float xsum32(float v) { auto r = __builtin_amdgcn_permlane32_swap(__float_as_uint(v), __float_as_uint(v), false, false); const unsigned r0 = r[0], r1 = r[1]; return __uint_as_float(r0) + __uint_as_float(r1); }
__device__ __forceinline__ float xother32(float v) { auto r = __builtin_amdgcn_permlane32_swap(__float_as_uint(v), __float_as_uint(v), false, false); const unsigned r0 = r[0], r1 = r[1]; const int l = (int)__builtin_amdgcn_mbcnt_hi(~0u, __builtin_amdgcn_mbcnt_lo(~0u, 0u)); return l < 32 ? __uint_as_float(r1) : __uint_as_float(r0); }
__device__ __forceinline__ float rowsum16(float x) { x += dppf<0xB1>(x); x += dppf<0x4E>(x); x += dppf<0x124>(x); x += dppf<0x128>(x); return x; }
__device__ __forceinline__ float sum8(float x) { x += dppf<0xB1>(x); x += dppf<0x4E>(x); x += dppf<0x141>(x); return x; }
__device__ __forceinline__ float treduce4(float x0, float x1, float x2, float x3, bool p1, bool p2) {
    const float k01 = p1 ? x1 : x0, s01 = p1 ? x0 : x1; const float y01 = k01 + dppf<0xB1>(s01);
    const float k23 = p1 ? x3 : x2, s23 = p1 ? x2 : x3; const float y23 = k23 + dppf<0xB1>(s23);
    const float kk = p2 ? y23 : y01, ss = p2 ? y01 : y23; float z = kk + dppf<0x4E>(ss);
    z += dppf<0x124>(z); z += dppf<0x128>(z);
    z = xsum16(z); z = xsum32(z); return z; }
__device__ __forceinline__ float b2f(unsigned v) { return __builtin_bit_cast(float, v << 16); }
typedef float mf32x2_t __attribute__((ext_vector_type(2))); typedef __bf16 mbf16x2_t __attribute__((ext_vector_type(2)));
__device__ __forceinline__ unsigned mixpk(float lo, float hi) { mf32x2_t v = {lo, hi}; mbf16x2_t b = __builtin_convertvector(v, mbf16x2_t); return __builtin_bit_cast(unsigned, b); }
__device__ __forceinline__ unsigned short f2b(float f) { unsigned u = __builtin_bit_cast(unsigned, f); return (unsigned short)((u + 0x7fffu + ((u >> 16) & 1u)) >> 16); }

__device__ __forceinline__ void scan_phase(MLAS float* ring, int bid, int G, int wave, int lane, const bf16* PROJ, const bf16* DECB, const bf16* ALPHA, bf16* YR, float* BONUS, const f32x2* ROT,
                                           const float* mu, const float* k_k, const float* k_a, const float* r_k) {
    constexpr int HYBW = 3840;
    const int vcu = (G % 8 == 0) ? (bid % 8) * (G / 8) + bid / 8 : bid;
    for (int cu = vcu; cu < 256; cu += G) {
        const int bh = cu >> 2, quarter = cu & 3, b = bh >> 3, hh = bh & 7;
        const size_t mb = (size_t)b * 4096;
        if (wave < 4) {
            const int rl = lane >> 4, kp = lane & 15, row = quarter * 16 + wave * 4 + rl;
            const float gamma = 1.f - exp2f(-5.f - (float)hh);
            f32x4 S = {0.f, 0.f, 0.f, 0.f}, T = {0.f, 0.f, 0.f, 0.f};
            bf16* yo = YR + mb * 1024 + hh * 64 + row;
            f32x4 A[2], WR[2], W[2], B[2], KM[2], Q2[2], K2[2]; float VS[2], V2S[2]; f32x2 SC[2];
#define MIX_RD(s, rec_) do { const MLAS float* r_ = (rec_); A[s] = *(const MLAS f32x4*)(r_ + R_A + 4 * kp); WR[s] = *(const MLAS f32x4*)(r_ + R_WR + 4 * kp); W[s] = *(const MLAS f32x4*)(r_ + R_W + 4 * kp); \
            B[s] = *(const MLAS f32x4*)(r_ + R_B + 4 * kp); KM[s] = *(const MLAS f32x4*)(r_ + R_KM + 4 * kp); Q2[s] = *(const MLAS f32x4*)(r_ + R_Q2 + 4 * kp); K2[s] = *(const MLAS f32x4*)(r_ + R_K2 + 4 * kp); \
            VS[s] = r_[R_V + row]; V2S[s] = r_[R_V2 + row]; SC[s] = *(const MLAS f32x2*)(r_ + R_SC); } while (0)
#define MIX_STEP(s, t_) do { \
            float z = (S[0] * A[s][0] + S[1] * A[s][1]) + (S[2] * A[s][2] + S[3] * A[s][3]); \
            float q = (S[0] * WR[s][0] + S[1] * WR[s][1]) + (S[2] * WR[s][2] + S[3] * WR[s][3]); \
            z = rowsum16(z); q = rowsum16(q); \
            const float y = q + z * SC[s][0] + VS[s] * SC[s][1]; \
            S = S * W[s] + (z * B[s] + VS[s] * KM[s]); \
            T = T * gamma + K2[s] * V2S[s]; \
            float o = (T[0] * Q2[s][0] + T[1] * Q2[s][1]) + (T[2] * Q2[s][2] + T[3] * Q2[s][3]); \
            o = rowsum16(o); \
            if (kp == 0) { bf16* yp = yo + (size_t)(t_) * 1024; yp[0] = f2b(y); yp[512] = f2b(o); } } while (0)
            asm volatile("s_waitcnt lgkmcnt(0)\n\ts_barrier" ::: "memory");
            for (int it = -2; it < NBLK; ++it) {
                if (it >= 0) {
                    const MLAS float* blk = ring + (it % RSLOTS) * (BLK * REC);
                    const MLAS float* nblk = ring + ((it + 1) % RSLOTS) * (BLK * REC);
                    if (it == 0) MIX_RD(0, blk);
#pragma unroll
                    for (int j = 0; j < BLK; j += 2) {
                        MIX_RD(1, blk + (j + 1) * REC);
                        MIX_STEP(0, it * BLK + j);
                        if (j + 2 < BLK) MIX_RD(0, blk + (j + 2) * REC); else if (it + 1 < NBLK) MIX_RD(0, nblk);
                        MIX_STEP(1, it * BLK + j + 1);
                    }
                }
                asm volatile("s_waitcnt lgkmcnt(0)\n\ts_barrier" ::: "memory");
            }
#undef MIX_RD
#undef MIX_STEP
        } else {
            const int pwv = wave - 4, par = pwv >> 1, sub = pwv & 1, tk = lane >> 3, ch = lane & 7, c0 = hh * 64 + 8 * ch;
            typedef unsigned v4u_ __attribute__((ext_vector_type(4)));
            const bf16* pr = PROJ + mb * HYBW + c0;
            v4u_ Lr[2][2], Lk[2][2], Lv[2][2], Lq[2], Lk2[2], Lv2[2], La[2], Le[2];
#define MIX_LOAD(s, blk_) do { const int t_ = (blk_) * BLK + 8 * sub + tk; const bf16* p_ = pr + (size_t)t_ * HYBW; const bool hp_ = t_ > 0; const bf16* pp_ = hp_ ? p_ - HYBW : p_; \
            Lr[s][0] = *(const v4u_*)(p_); Lk[s][0] = *(const v4u_*)(p_ + 512); Lv[s][0] = *(const v4u_*)(p_ + 1024); \
            Lr[s][1] = *(const v4u_*)(pp_); Lk[s][1] = *(const v4u_*)(pp_ + 512); Lv[s][1] = *(const v4u_*)(pp_ + 1024); \
            if (!hp_) { Lr[s][1] = (v4u_){0u, 0u, 0u, 0u}; Lk[s][1] = (v4u_){0u, 0u, 0u, 0u}; Lv[s][1] = (v4u_){0u, 0u, 0u, 0u}; } \
            Lq[s] = *(const v4u_*)(p_ + 1792); Lk2[s] = *(const v4u_*)(p_ + 2304); Lv2[s] = *(const v4u_*)(p_ + 2816); \
            La[s] = *(const v4u_*)(ALPHA + (mb + t_) * 512 + c0); Le[s] = *(const v4u_*)(DECB + (mb + t_) * 512 + c0); } while (0)
#define MIX_U(w_, e_) b2f(((e_) & 1) ? ((w_)[(e_) >> 1] >> 16) : ((w_)[(e_) >> 1] & 0xffffu))
#define MIX_PROC(s, blk_) do { const int t_ = (blk_) * BLK + 8 * sub + tk; \
            const f32x4* rp_ = (const f32x4*)(ROT + (size_t)t_ * 32 + 8 * (ch & 3)); f32x4 rot_[4]; rot_[0] = rp_[0]; rot_[1] = rp_[1]; rot_[2] = rp_[2]; rot_[3] = rp_[3];     \
            float p0 = 0.f, p1 = 0.f, p2 = 0.f, p3 = 0.f; \
            _Pragma("unroll") for (int e = 0; e < 8; ++e) { const float rc = MIX_U(Lr[s][0], e), rq = MIX_U(Lr[s][1], e), kc = MIX_U(Lk[s][0], e), kq = MIX_U(Lk[s][1], e); \
                const float r = rc + (rq - rc) * cst[0 * 64 + 8 * ch + e], kraw = kc + (kq - kc) * cst[1 * 64 + 8 * ch + e], al = MIX_U(La[s], e); \
                const float kkr = kraw * cst[3 * 64 + 8 * ch + e], km = kraw * (1.f + (al - 1.f) * cst[4 * 64 + 8 * ch + e]), x2 = km * r; \
                p0 += kkr * kkr; p1 += kkr * al * r; p2 += x2; p3 += x2 * cst[5 * 64 + 8 * ch + e]; } \
            p0 = sum8(p0); p1 = sum8(p1); p2 = sum8(p2); p3 = sum8(p3); \
            const float inv = rsqrtf(fmaxf(p0, 1e-24f)); \
            asm volatile("" : "+v"(Lr[s][0]), "+v"(Lr[s][1]), "+v"(Lk[s][0]), "+v"(Lk[s][1]), "+v"(La[s]));     \
            MLAS float* rec = ring + ((blk_) % RSLOTS) * (BLK * REC) + (8 * sub + tk) * REC + 8 * ch; \
            _Pragma("unroll") for (int h4 = 0; h4 < 2; ++h4) { f32x4 oa, owr, ow, ob, okm, ov, ov2, oq, ok; \
                _Pragma("unroll") for (int e4 = 0; e4 < 4; ++e4) { const int e = 4 * h4 + e4; \
                    const float rc = MIX_U(Lr[s][0], e), rq = MIX_U(Lr[s][1], e), kc = MIX_U(Lk[s][0], e), kq = MIX_U(Lk[s][1], e), vc = MIX_U(Lv[s][0], e), vq = MIX_U(Lv[s][1], e); \
                    const float r = rc + (rq - rc) * cst[0 * 64 + 8 * ch + e], kraw = kc + (kq - kc) * cst[1 * 64 + 8 * ch + e], v = vc + (vq - vc) * cst[2 * 64 + 8 * ch + e], al = MIX_U(La[s], e); \
                    const float dc = __builtin_amdgcn_exp2f(-1.4426950408889634f * MIX_U(Le[s], e)); \
                    const float kk = kraw * cst[3 * 64 + 8 * ch + e] * inv; \
                    oa[e4] = -kk; owr[e4] = dc * r; ow[e4] = dc; ob[e4] = kk * al; okm[e4] = kraw * (1.f + (al - 1.f) * cst[4 * 64 + 8 * ch + e]); ov[e4] = v; ov2[e4] = MIX_U(Lv2[s], e); \
                      \
                    const float cs = rot_[e >> 1][2 * (e & 1)], sn = rot_[e >> 1][2 * (e & 1) + 1]; const float qv = MIX_U(Lq[s], e), kv = MIX_U(Lk2[s], e); \
                    const float qp = __shfl_xor(qv, 4), kp = __shfl_xor(kv, 4); \
                    oq[e4] = ch < 4 ? qv * cs - qp * sn : qp * sn + qv * cs; ok[e4] = (ch < 4 ? kv * cs - kp * sn : kp * sn + kv * cs) * 0.125f; } \
                *(MLAS f32x4*)(rec + R_A + 4 * h4) = oa; *(MLAS f32x4*)(rec + R_WR + 4 * h4) = owr; *(MLAS f32x4*)(rec + R_W + 4 * h4) = ow; *(MLAS f32x4*)(rec + R_B + 4 * h4) = ob; \
                *(MLAS f32x4*)(rec + R_KM + 4 * h4) = okm; *(MLAS f32x4*)(rec + R_V + 4 * h4) = ov; *(MLAS f32x4*)(rec + R_V2 + 4 * h4) = ov2; *(MLAS f32x4*)(rec + R_Q2 + 4 * h4) = oq; *(MLAS f32x4*)(rec + R_K2 + 4 * h4) = ok; } \
            if (ch == 0) { rec[R_SC] = p1 * inv; rec[R_SC + 1] = p2; if (quarter == 0) BONUS[(mb + (size_t)t_) * 8 + hh] = p3; } \
            if ((blk_) + 4 < NBLK) MIX_LOAD(s, (blk_) + 4); } while (0)
#define MIX_BAR() asm volatile("s_waitcnt lgkmcnt(0)\n\ts_barrier" ::: "memory")
            MLAS float* cst = ring + RSLOTS * BLK * REC;
            if (wave == 4) { const int c = hh * 64 + lane; cst[lane] = mu[c]; cst[64 + lane] = mu[512 + c]; cst[128 + lane] = mu[1024 + c]; cst[192 + lane] = k_k[c]; cst[256 + lane] = k_a[c]; cst[320 + lane] = r_k[c]; }
            MIX_LOAD(0, par); MIX_LOAD(1, par + 2);
            MIX_BAR();
            if (par) MIX_BAR();
            for (int b2 = par; b2 < NBLK; b2 += 4) {
                MIX_PROC(0, b2); MIX_BAR(); MIX_BAR();
                MIX_PROC(1, b2 + 2); MIX_BAR(); MIX_BAR();
            }
            MIX_BAR(); if (!par) MIX_BAR();
#undef MIX_PROC
#undef MIX_BAR
#undef MIX_U
#undef MIX_LOAD
        }
    }
}

__device__ __forceinline__ void post_phase(int gw, int NGW, int lane, const bf16* PROJ, bf16* YR, const bf16* GG, const float* BONUS, const float* mu_v_, const float* ln_w, const float* ln_b, const float* ret_ln_w) {
    constexpr int HYBW = 3840;
    const bool p1 = (lane & 1) != 0, p2 = (lane & 2) != 0;
    float lw[8], lb[8], rw[8], muv[8];
#pragma unroll
    for (int j = 0; j < 8; ++j) { lw[j] = ln_w[j * 64 + lane]; lb[j] = ln_b[j * 64 + lane]; rw[j] = ret_ln_w[j * 64 + lane]; muv[j] = mu_v_[j * 64 + lane]; }
    for (int m = gw; m < 32768; m += NGW) {
        bf16* row = YR + (size_t)m * 1024; const bf16* prow = PROJ + (size_t)m * HYBW; const bool has_prev = (m & 4095) != 0;
        float y[8], o[8];
#pragma unroll
        for (int j = 0; j < 8; ++j) { y[j] = b2f(row[j * 64 + lane]); o[j] = b2f(row[512 + j * 64 + lane]); }
        float res[16];
#pragma unroll
        for (int g4 = 0; g4 < 2; ++g4) {
            const float zs = treduce4(y[4 * g4], y[4 * g4 + 1], y[4 * g4 + 2], y[4 * g4 + 3], p1, p2);
            const float m0 = dppf<0x00>(zs) * (1.f / 64.f), m1 = dppf<0x55>(zs) * (1.f / 64.f), m2 = dppf<0xAA>(zs) * (1.f / 64.f), m3 = dppf<0xFF>(zs) * (1.f / 64.f);
            const float d0 = y[4 * g4] - m0, d1 = y[4 * g4 + 1] - m1, d2 = y[4 * g4 + 2] - m2, d3 = y[4 * g4 + 3] - m3;
            const float zv = treduce4(d0 * d0, d1 * d1, d2 * d2, d3 * d3, p1, p2);
            const float r0 = rsqrtf(dppf<0x00>(zv) * (1.f / 64.f) + 64e-5f), r1 = rsqrtf(dppf<0x55>(zv) * (1.f / 64.f) + 64e-5f), r2 = rsqrtf(dppf<0xAA>(zv) * (1.f / 64.f) + 64e-5f), r3 = rsqrtf(dppf<0xFF>(zv) * (1.f / 64.f) + 64e-5f);
            const float dd[4] = {d0 * r0, d1 * r1, d2 * r2, d3 * r3};
#pragma unroll
            for (int q = 0; q < 4; ++q) { const int j = 4 * g4 + q, c = j * 64 + lane;
                const float vc = b2f(prow[1024 + c]), vp = has_prev ? b2f(prow[1024 + c - HYBW]) : 0.f; const float v = vc + (vp - vc) * muv[j];
                const float yn = dd[q] * lw[j] + lb[j];
                res[j] = (yn + BONUS[(size_t)m * 8 + j] * v) * b2f(GG[(size_t)m * 512 + c]); }
            const float zo = treduce4(o[4 * g4] * o[4 * g4], o[4 * g4 + 1] * o[4 * g4 + 1], o[4 * g4 + 2] * o[4 * g4 + 2], o[4 * g4 + 3] * o[4 * g4 + 3], p1, p2);
            const float q0 = rsqrtf(dppf<0x00>(zo) * (1.f / 64.f) + 1e-6f), q1 = rsqrtf(dppf<0x55>(zo) * (1.f / 64.f) + 1e-6f), q2 = rsqrtf(dppf<0xAA>(zo) * (1.f / 64.f) + 1e-6f), q3 = rsqrtf(dppf<0xFF>(zo) * (1.f / 64.f) + 1e-6f);
            const float qq[4] = {q0, q1, q2, q3};
#pragma unroll
            for (int q = 0; q < 4; ++q) { const int j = 4 * g4 + q, c = j * 64 + lane; const float g = b2f(prow[3328 + c]);
                res[8 + j] = o[j] * qq[q] * rw[j] * g / (1.f + __expf(-g)); }
        }
#pragma unroll
        for (int j = 0; j < 8; ++j) { row[j * 64 + lane] = f2b(res[j]); row[512 + j * 64 + lane] = f2b(res[8 + j]); }
    }
}
#define MIX_U(w_, e_) b2f(((e_) & 1) ? ((w_)[(e_) >> 1] >> 16) : ((w_)[(e_) >> 1] & 0xffffu))
__device__ __forceinline__ void post_phase_v(int gw, int NGW, int lane, const bf16* PROJ, bf16* YR, const bf16* GG, const float* BONUS, const float* mu_v_, const float* ln_w, const float* ln_b, const float* ret_ln_w) {
    constexpr int HYBW = 3840;
    typedef unsigned v4u_ __attribute__((ext_vector_type(4)));
    typedef float v4f_ __attribute__((ext_vector_type(4)));
    const int tk = lane >> 3, ch = lane & 7;
    for (int tg = gw; tg < 32768 / 8; tg += NGW) {
        const int m = tg * 8 + tk; const bool has_prev = (m & 4095) != 0;
        bf16* row = YR + (size_t)m * 1024 + 8 * ch; const bf16* prow = PROJ + (size_t)m * HYBW + 8 * ch; const bf16* grow = GG + (size_t)m * 512 + 8 * ch;
#pragma unroll 2
        for (int j = 0; j < 8; ++j) {
            const int c = j * 64 + 8 * ch;
            {
                const v4u_ yw = *(const v4u_*)(row + j * 64), vcw = *(const v4u_*)(prow + 1024 + j * 64), gw4 = *(const v4u_*)(grow + j * 64);
                v4u_ vpw = {0u, 0u, 0u, 0u}; if (has_prev) vpw = *(const v4u_*)(prow + 1024 + j * 64 - HYBW);
                const float bon = BONUS[(size_t)m * 8 + j];
                const v4f_ lw0 = *(const v4f_*)(ln_w + c), lw1 = *(const v4f_*)(ln_w + c + 4), lb0 = *(const v4f_*)(ln_b + c), lb1 = *(const v4f_*)(ln_b + c + 4), mv0 = *(const v4f_*)(mu_v_ + c), mv1 = *(const v4f_*)(mu_v_ + c + 4);
                float y[8], s = 0.f;
#pragma unroll
                for (int e = 0; e < 8; ++e) { y[e] = MIX_U(yw, e); s += y[e]; }
                const float mean = sum8(s) * (1.f / 64.f); float q = 0.f;
#pragma unroll
                for (int e = 0; e < 8; ++e) { y[e] -= mean; q += y[e] * y[e]; }
                const float r = rsqrtf(sum8(q) * (1.f / 64.f) + 64e-5f);
                float res[8];
#pragma unroll
                for (int e = 0; e < 8; ++e) { const float vc = MIX_U(vcw, e), vp = MIX_U(vpw, e); const float lw_ = e < 4 ? lw0[e & 3] : lw1[e & 3], lb_ = e < 4 ? lb0[e & 3] : lb1[e & 3], mv_ = e < 4 ? mv0[e & 3] : mv1[e & 3];
                    const float v = vc + (vp - vc) * mv_; res[e] = (y[e] * r * lw_ + lb_ + bon * v) * MIX_U(gw4, e); }
                v4u_ ow;
#pragma unroll
                for (int e = 0; e < 4; ++e) ow[e] = mixpk(res[2 * e], res[2 * e + 1]);
                *(v4u_*)(row + j * 64) = ow; }
            {
                const v4u_ ow_ = *(const v4u_*)(row + 512 + j * 64), gt = *(const v4u_*)(prow + 3328 + j * 64);
                const v4f_ rw0 = *(const v4f_*)(ret_ln_w + c), rw1 = *(const v4f_*)(ret_ln_w + c + 4);
                float o[8], s = 0.f;
#pragma unroll
                for (int e = 0; e < 8; ++e) { o[e] = MIX_U(ow_, e); s += o[e] * o[e]; }
                const float qn = rsqrtf(sum8(s) * (1.f / 64.f) + 1e-6f);
                float res[8];
#pragma unroll
                for (int e = 0; e < 8; ++e) { const float g = MIX_U(gt, e), rw_ = e < 4 ? rw0[e & 3] : rw1[e & 3]; res[e] = o[e] * qn * rw_ * g * __builtin_amdgcn_rcpf(1.f + __expf(-g)); }
                v4u_ ow;
#pragma unroll
                for (int e = 0; e < 4; ++e) ow[e] = mixpk(res[2 * e], res[2 * e + 1]);
                *(v4u_*)(row + 512 + j * 64) = ow; }
        }
    }
}
#undef MIX_U
__device__ __forceinline__ void xl_phase(int gtid, int NT_, const bf16* PROJ, const float* mu, bf16* XL, int row0 = 0, int nrows = 32768) {
    constexpr int HYBW = 3840;
    typedef unsigned v4u_ __attribute__((ext_vector_type(4)));
    for (int it0 = gtid; it0 < nrows * 32; it0 += 4 * NT_) {
        v4u_ cw[4], pw_[4];
#pragma unroll
        for (int u = 0; u < 4; ++u) { const int it = it0 + u * NT_; const bool ok = it < nrows * 32; const int m = row0 + ((ok ? it : it0) >> 5), col = 1536 + ((ok ? it : it0) & 31) * 8;
            cw[u] = *(const v4u_*)(PROJ + (size_t)m * HYBW + col);
            pw_[u] = (v4u_){0u, 0u, 0u, 0u}; if ((m & 4095) != 0) pw_[u] = *(const v4u_*)(PROJ + (size_t)(m - 1) * HYBW + col); }
#pragma unroll
        for (int u = 0; u < 4; ++u) { const int it = it0 + u * NT_; if (it < nrows * 32) {
            const int m = row0 + (it >> 5), ch = it & 31, col = 1536 + ch * 8;
            float x[8];
#pragma unroll
            for (int e = 0; e < 4; ++e) { const float c0 = b2f(cw[u][e] & 0xffffu), c1 = b2f(cw[u][e] >> 16), q0 = b2f(pw_[u][e] & 0xffffu), q1 = b2f(pw_[u][e] >> 16);
                x[2 * e] = c0 + (q0 - c0) * mu[col + 2 * e]; x[2 * e + 1] = c1 + (q1 - c1) * mu[col + 2 * e + 1]; }
            if (ch < 8) {
#pragma unroll
                for (int e = 0; e < 8; ++e) { const float t = __expf(2.f * x[e]); x[e] = 1.f - 2.f * __builtin_amdgcn_rcpf(t + 1.f); } }
            else if (ch >= 16) {
#pragma unroll
                for (int e = 0; e < 8; ++e) x[e] = __builtin_amdgcn_rcpf(1.f + __expf(-x[e])); }
            v4u_ ow;
#pragma unroll
            for (int e = 0; e < 4; ++e) ow[e] = mixpk(x[2 * e], x[2 * e + 1]);
            *(v4u_*)(XL + (size_t)m * 256 + ch * 8) = ow; } }
    }
}
#undef MLAS
}
#ifndef THREE_ROLE
#define THREE_ROLE 0
#endif
namespace ck {
typedef unsigned short bf16;
typedef float f32x2 __attribute__((ext_vector_type(2)));
typedef float f32x4 __attribute__((ext_vector_type(4)));
typedef short bf16x8 __attribute__((ext_vector_type(8)));
typedef short s16x4 __attribute__((ext_vector_type(4)));
typedef unsigned u32x4 __attribute__((ext_vector_type(4)));
typedef unsigned u32x2 __attribute__((ext_vector_type(2)));
typedef short v4i16_t __attribute__((ext_vector_type(4)));
#define CLAS __attribute__((address_space(3)))
constexpr int NBLK = 256, RING = 10, REC = 12800, NPREP = 6;
constexpr int O_AT = 0, O_RT = 2048, O_BT = 4096, O_KT = 6144, O_IE = 8192, O_CC = 9216, O_P15 = 10240, O_VT = 10496;
constexpr int O_RING = 0, O_SCR = 0, SCR = 0, O_CST = RING * REC  , O_FLAG = O_CST + 1536  ;
constexpr int GRING = 16;
#define CK_MFMA(a, b, c) __builtin_amdgcn_mfma_f32_16x16x32_bf16(a, b, c, 0, 0, 0)
__device__ __forceinline__ float b2f(unsigned v) { return __builtin_bit_cast(float, v << 16); }
__device__ __forceinline__ unsigned f2b(float f) { unsigned u = __builtin_bit_cast(unsigned, f); return (u + 0x7fffu + ((u >> 16) & 1u)) >> 16; }
typedef float f32x2_t __attribute__((ext_vector_type(2))); typedef __bf16 bf16x2_t __attribute__((ext_vector_type(2)));
__device__ __forceinline__ unsigned pk(float lo, float hi) { f32x2_t v = {lo, hi}; bf16x2_t b = __builtin_convertvector(v, bf16x2_t); return __builtin_bit_cast(unsigned, b); }
template <int CTRL> __device__ __forceinline__ float dppf(float v) { return __builtin_bit_cast(float, __builtin_amdgcn_update_dpp(0, __builtin_bit_cast(int, v), CTRL, 0xF, 0xF, true)); }
__device__ __forceinline__ float sum8(float x) { x += dppf<0xB1>(x); x += dppf<0x4E>(x); x += dppf<0x141>(x); return x; }
__device__ __forceinline__ s16x4 vtr(const CLAS unsigned char* p) { return __builtin_bit_cast(s16x4, __builtin_amdgcn_ds_read_tr16_b64_v4i16((CLAS v4i16_t*)p)); }
__device__ __forceinline__ unsigned ldw(volatile CLAS unsigned* p) { return *p; }
#define CK_U(w_, e_) b2f(((e_) & 1) ? ((w_)[(e_) >> 1] >> 16) : ((w_)[(e_) >> 1] & 0xffffu))
#define CK_H(w_, e_) ((float)__builtin_bit_cast(_Float16, (unsigned short)(((e_) & 1) ? ((w_)[(e_) >> 1] >> 16) : ((w_)[(e_) >> 1] & 0xffffu))))
__device__ __forceinline__ float scan8(float x, int lane, float& total) {
    const float s1 = x + dppf<0x118>(x);
    const float rot = dppf<0x128>(s1);
    const float R = (lane & 8) ? s1 : rot;
    auto r16 = __builtin_amdgcn_permlane16_swap(__float_as_uint(R), __float_as_uint(R), false, false); const unsigned e16 = r16[0], o16 = r16[1];
    const float Reven = __uint_as_float(e16), PT = Reven + __uint_as_float(o16);
    auto r32 = __builtin_amdgcn_permlane32_swap(__float_as_uint(PT), __float_as_uint(PT), false, false); const unsigned lo32 = r32[0], hi32 = r32[1];
    const float PTlo = __uint_as_float(lo32);
    total = PTlo + __uint_as_float(hi32);
    return s1 + ((lane & 32) ? PTlo : 0.f) + ((lane & 16) ? Reven : 0.f); }
__device__ __forceinline__ float xor4(float v) { return dppf<0x1B>(dppf<0x141>(v)); }

struct ScanOps { u32x2 r00, r01, r10, r11, a00, a01, a10, a11, vt, vt2; bf16x8 aie, acc_; s16x4 tb[4], tk[4]; f32x4 pp[4]; };
template <bool rw, bool TWO = false> __device__ __forceinline__ void scan_load(ScanOps& o, const CLAS unsigned char* rec, int n, int g, int n0) {
    const CLAS unsigned char* rr = rec + O_RT + n * 128 + g * 8;
    o.r00 = *(const CLAS u32x2*)(rr); o.r01 = *(const CLAS u32x2*)(rr + 32); o.r10 = *(const CLAS u32x2*)(rr + 64); o.r11 = *(const CLAS u32x2*)(rr + 96);
    o.vt = __builtin_bit_cast(u32x2, vtr(rec + O_VT + (4 * g + (n >> 2)) * 128 + (n0 + 4 * (n & 3)) * 2));
    if (TWO) o.vt2 = __builtin_bit_cast(u32x2, vtr(rec + O_VT + (4 * g + (n >> 2)) * 128 + (n0 + 16 + 4 * (n & 3)) * 2));
    if (rw) { const CLAS unsigned char* ra = rec + O_AT + n * 128 + g * 8;
        o.a00 = *(const CLAS u32x2*)(ra); o.a01 = *(const CLAS u32x2*)(ra + 32); o.a10 = *(const CLAS u32x2*)(ra + 64); o.a11 = *(const CLAS u32x2*)(ra + 96);
        o.aie = *(const CLAS bf16x8*)(rec + O_IE + n * 64 + g * 16); }
    o.acc_ = *(const CLAS bf16x8*)(rec + O_CC + n * 64 + g * 16);
    const CLAS unsigned char* tb = rec + O_BT + (4 * g + (n >> 2)) * 128 + (n & 3) * 8;
    const CLAS unsigned char* tk_ = rec + O_KT + (4 * g + (n >> 2)) * 128 + (n & 3) * 8;
#pragma unroll
    for (int m = 0; m < 4; ++m) { if (rw) o.tb[m] = vtr(tb + m * 32); o.tk[m] = vtr(tk_ + m * 32); if (rw) o.pp[m] = *(const CLAS f32x4*)(rec + O_P15 + (m * 16 + 4 * g) * 4); }
}
template <bool rw, int probe = 0> __device__ __forceinline__ void scan_wave(CLAS unsigned char* lds, volatile CLAS unsigned* flag, int wave, int lane, int n0, int hh, size_t mb, bf16* YR) {
    const int n = lane & 15, g = lane >> 4;
    f32x4 S0 = {0.f, 0.f, 0.f, 0.f}, S1 = S0, S2 = S0, S3 = S0;
    const float g16 = exp2f(16.f * log2f(1.f - exp2f(-5.f - (float)hh)));
    bf16* yo = YR + (mb + 4 * g) * 1024 + (rw ? 0 : 512) + hh * 64 + n0 + n;
    ScanOps A, B;
#define CK_WAITREADY(blk_) do { unsigned sp = 0; while (ldw(flag + ((blk_) % RING)) != (unsigned)((blk_) + 1)) { __builtin_amdgcn_s_sleep(1); if (++sp > (1u << 22)) break; } asm volatile("" ::: "memory"); } while (0)
#define CK_UPD(O, Sm, m) do { s16x4 tb_ = {0, 0, 0, 0}; if (rw) tb_ = O.tb[m]; const s16x4 tk2_ = O.tk[m]; \
        const bf16x8 abk = (bf16x8){tb_[0], tb_[1], tb_[2], tb_[3], tk2_[0], tk2_[1], tk2_[2], tk2_[3]}; Sm = CK_MFMA(abk, fu, Sm); \
        if (rw) { Sm = Sm * O.pp[m]; } else { Sm = Sm * g16; } } while (0)
#define CK_BLOCK(O, N, blk_) do { \
        asm volatile("s_waitcnt lgkmcnt(0)" ::: "memory"); \
        if (lane == 0) flag[12 + wave] = (unsigned)((blk_) + 1); \
        if ((blk_) + 1 < NBLK) { CK_WAITREADY((blk_) + 1); scan_load<rw>(N, lds + O_RING + (((blk_) + 1) % RING) * REC, n, g, n0); } \
        if (probe == 2) break; \
        const bf16x8 sb0 = __builtin_bit_cast(bf16x8, (u32x4){pk(S0[0], S0[1]), pk(S0[2], S0[3]), pk(S1[0], S1[1]), pk(S1[2], S1[3])}); \
        const bf16x8 sb1 = __builtin_bit_cast(bf16x8, (u32x4){pk(S2[0], S2[1]), pk(S2[2], S2[3]), pk(S3[0], S3[1]), pk(S3[2], S3[3])}); \
        f32x4 ZT = {0.f, 0.f, 0.f, 0.f}, YT = {0.f, 0.f, 0.f, 0.f}; \
        u32x4 fz; fz[0] = 0u; fz[1] = 0u; fz[2] = O.vt[0]; fz[3] = O.vt[1]; \
        if (rw) { \
            ZT = CK_MFMA(__builtin_bit_cast(bf16x8, (u32x4){O.a00[0], O.a00[1], O.a01[0], O.a01[1]}), sb0, ZT); \
            ZT = CK_MFMA(__builtin_bit_cast(bf16x8, (u32x4){O.a10[0], O.a10[1], O.a11[0], O.a11[1]}), sb1, ZT); } \
        YT = CK_MFMA(__builtin_bit_cast(bf16x8, (u32x4){O.r00[0], O.r00[1], O.r01[0], O.r01[1]}), sb0, YT); \
        YT = CK_MFMA(__builtin_bit_cast(bf16x8, (u32x4){O.r10[0], O.r10[1], O.r11[0], O.r11[1]}), sb1, YT); \
        if (rw) { fz[0] = pk(ZT[0], ZT[1]); fz[1] = pk(ZT[2], ZT[3]); \
            const f32x4 zero = {0.f, 0.f, 0.f, 0.f}; \
            const f32x4 UT = CK_MFMA(O.aie, __builtin_bit_cast(bf16x8, fz), zero); \
            fz[0] = pk(UT[0], UT[1]); fz[1] = pk(UT[2], UT[3]); } \
        const bf16x8 fu = __builtin_bit_cast(bf16x8, fz); \
        CK_UPD(O, S0, 0); CK_UPD(O, S1, 1); CK_UPD(O, S2, 2); CK_UPD(O, S3, 3); \
        YT = CK_MFMA(O.acc_, fu, YT); \
        bf16* yp = yo + (size_t)(blk_) * 16 * 1024; \
        { const unsigned y01 = pk(YT[0], YT[1]), y23 = pk(YT[2], YT[3]); yp[0] = (bf16)y01; yp[1024] = (bf16)(y01 >> 16); yp[2048] = (bf16)y23; yp[3072] = (bf16)(y23 >> 16); } \
    } while (0)
    CK_WAITREADY(0); scan_load<rw>(A, lds + O_RING, n, g, n0);
    for (int blk = 0; blk < NBLK; blk += 2) {
#ifdef PROBE_SCAN_DELAY
        if (rw) __builtin_amdgcn_s_sleep(PROBE_SCAN_DELAY);
#endif
        CK_BLOCK(A, B, blk);
        CK_BLOCK(B, A, blk + 1);
    }
#undef CK_BLOCK
#undef CK_UPD
#undef CK_WAITREADY
}
template <bool rw, int probe = 0> __device__ __forceinline__ void scan_wave2(CLAS unsigned char* lds, volatile CLAS unsigned* flag, int wave, int lane, int n0, int hh, size_t mb, bf16* YR) {
    const int n = lane & 15, g = lane >> 4;
    f32x4 S0 = {0.f, 0.f, 0.f, 0.f}, S1 = S0, S2 = S0, S3 = S0, T0 = S0, T1 = S0, T2 = S0, T3 = S0;
    const float g16 = exp2f(16.f * log2f(1.f - exp2f(-5.f - (float)hh)));
    bf16* yo = YR + (mb + 4 * g) * 1024 + (rw ? 0 : 512) + hh * 64 + n0 + n;
    ScanOps A, B;
#define CK_WAITREADY(blk_) do { unsigned sp = 0; while (ldw(flag + ((blk_) % RING)) != (unsigned)((blk_) + 1)) { __builtin_amdgcn_s_sleep(1); if (++sp > (1u << 22)) break; } asm volatile("" ::: "memory"); } while (0)
#define CK_UPD(O, Sm, m, FU) do { s16x4 tb_ = {0, 0, 0, 0}; if (rw) tb_ = O.tb[m]; const s16x4 tk2_ = O.tk[m]; \
        const bf16x8 abk = (bf16x8){tb_[0], tb_[1], tb_[2], tb_[3], tk2_[0], tk2_[1], tk2_[2], tk2_[3]}; Sm = CK_MFMA(abk, FU, Sm); \
        if (rw) { Sm = Sm * O.pp[m]; } else { Sm = Sm * g16; } } while (0)
#define CK_CHAIN(O, Q0, Q1, Q2, Q3, VT, YOFF, blk_) do { \
        const bf16x8 sb0 = __builtin_bit_cast(bf16x8, (u32x4){pk(Q0[0], Q0[1]), pk(Q0[2], Q0[3]), pk(Q1[0], Q1[1]), pk(Q1[2], Q1[3])}); \
        const bf16x8 sb1 = __builtin_bit_cast(bf16x8, (u32x4){pk(Q2[0], Q2[1]), pk(Q2[2], Q2[3]), pk(Q3[0], Q3[1]), pk(Q3[2], Q3[3])}); \
        f32x4 ZT = {0.f, 0.f, 0.f, 0.f}, YT = {0.f, 0.f, 0.f, 0.f}; \
        u32x4 fz; fz[0] = 0u; fz[1] = 0u; fz[2] = VT[0]; fz[3] = VT[1]; \
        if (rw) { \
            ZT = CK_MFMA(__builtin_bit_cast(bf16x8, (u32x4){O.a00[0], O.a00[1], O.a01[0], O.a01[1]}), sb0, ZT); \
            ZT = CK_MFMA(__builtin_bit_cast(bf16x8, (u32x4){O.a10[0], O.a10[1], O.a11[0], O.a11[1]}), sb1, ZT); } \
        YT = CK_MFMA(__builtin_bit_cast(bf16x8, (u32x4){O.r00[0], O.r00[1], O.r01[0], O.r01[1]}), sb0, YT); \
        YT = CK_MFMA(__builtin_bit_cast(bf16x8, (u32x4){O.r10[0], O.r10[1], O.r11[0], O.r11[1]}), sb1, YT); \
        if (rw) { fz[0] = pk(ZT[0], ZT[1]); fz[1] = pk(ZT[2], ZT[3]); \
            const f32x4 zero = {0.f, 0.f, 0.f, 0.f}; \
            const f32x4 UT = CK_MFMA(O.aie, __builtin_bit_cast(bf16x8, fz), zero); \
            fz[0] = pk(UT[0], UT[1]); fz[1] = pk(UT[2], UT[3]); } \
        const bf16x8 fu = __builtin_bit_cast(bf16x8, fz); \
        CK_UPD(O, Q0, 0, fu); CK_UPD(O, Q1, 1, fu); CK_UPD(O, Q2, 2, fu); CK_UPD(O, Q3, 3, fu); \
        YT = CK_MFMA(O.acc_, fu, YT); \
        bf16* yp = yo + (size_t)(blk_) * 16 * 1024 + (YOFF); \
        { const unsigned y01 = pk(YT[0], YT[1]), y23 = pk(YT[2], YT[3]); yp[0] = (bf16)y01; yp[1024] = (bf16)(y01 >> 16); yp[2048] = (bf16)y23; yp[3072] = (bf16)(y23 >> 16); } \
    } while (0)
#define CK_BLOCK2(O, N, blk_) do { \
        asm volatile("s_waitcnt lgkmcnt(0)" ::: "memory"); \
        if (lane == 0) flag[12 + wave] = (unsigned)((blk_) + 1); \
        if (probe == 2) { if ((blk_) + 1 < NBLK) { CK_WAITREADY((blk_) + 1); scan_load<rw, true>(N, lds + O_RING + (((blk_) + 1) % RING) * REC, n, g, n0); } break; } \
        CK_CHAIN(O, S0, S1, S2, S3, O.vt, 0, blk_); \
          \
        if ((blk_) + 1 < NBLK) { CK_WAITREADY((blk_) + 1); scan_load<rw, true>(N, lds + O_RING + (((blk_) + 1) % RING) * REC, n, g, n0); } \
        CK_CHAIN(O, T0, T1, T2, T3, O.vt2, 16, blk_); \
    } while (0)
    __builtin_amdgcn_s_setprio(2);
    CK_WAITREADY(0); scan_load<rw, true>(A, lds + O_RING, n, g, n0);
    for (int blk = 0; blk < NBLK; blk += 2) {
#ifdef PROBE_SCAN_DELAY
        if (rw) __builtin_amdgcn_s_sleep(PROBE_SCAN_DELAY);
#endif
        CK_BLOCK2(A, B, blk);
        CK_BLOCK2(B, A, blk + 1);
    }
    __builtin_amdgcn_s_setprio(0);
#undef CK_BLOCK2
#undef CK_CHAIN
#undef CK_UPD
#undef CK_WAITREADY
}
template <bool rw, int NP, bool GLOBAL, int probe = 0, int NSCAN = 2> __device__ __forceinline__ void prep_wave(CLAS unsigned char* lds, volatile CLAS unsigned* flag, int pwv, int first, int lane, int hh, size_t mb, bool bonus_on,
        const bf16* PROJ, const bf16* DECB, const bf16* ALPHA, float* BONUS, const f32x2* ROT, unsigned char* gring, unsigned* gflag, unsigned* gack, unsigned ep0) {
    constexpr int HYBW = 3840;
            const int tk = lane >> 3, ch = lane & 7, c0 = hh * 64 + 8 * ch;
            const CLAS float* cst = (const CLAS float*)(lds + O_CST);
            CLAS unsigned char* scr = lds + O_SCR + pwv * SCR;
            const bf16* pr = PROJ + mb * HYBW + c0;
            const float l2g = log2f(1.f - exp2f(-5.f - (float)hh));
            u32x4 LG[2][9];
#define CK_LOAD(rd_, blk_) do { int t_ = (blk_) * 16 + 8 * (rd_) + tk; asm volatile("" : "+v"(t_));     \
                const bf16* p_ = pr + (size_t)t_ * HYBW; \
                if (rw) { const bool hp_ = t_ > 0; const bf16* pp_ = hp_ ? p_ - HYBW : p_; \
                    LG[rd_][0] = *(const u32x4*)(p_); LG[rd_][1] = *(const u32x4*)(p_ + 512); LG[rd_][2] = *(const u32x4*)(p_ + 1024); \
                    LG[rd_][3] = *(const u32x4*)(pp_); LG[rd_][4] = *(const u32x4*)(pp_ + 512); LG[rd_][5] = *(const u32x4*)(pp_ + 1024); \
                    if (!hp_) { LG[rd_][3] = (u32x4){0u, 0u, 0u, 0u}; LG[rd_][4] = LG[rd_][3]; LG[rd_][5] = LG[rd_][3]; } \
                    LG[rd_][6] = *(const u32x4*)(ALPHA + (mb + t_) * 512 + c0); LG[rd_][7] = *(const u32x4*)(DECB + (mb + t_) * 512 + c0); \
                    LG[rd_][8] = (u32x4){0u, 0u, 0u, 0u}; if ((t_ & 15) != 0) LG[rd_][8] = *(const u32x4*)(DECB + (mb + t_ - 1) * 512 + c0); } \
                else { LG[rd_][0] = *(const u32x4*)(p_ + 1792); LG[rd_][1] = *(const u32x4*)(p_ + 2304); LG[rd_][2] = *(const u32x4*)(p_ + 2816); \
                    const u32x4* rp_ = (const u32x4*)(ROT + (size_t)t_ * 32 + 8 * (ch & 3)); LG[rd_][3] = rp_[0]; LG[rd_][4] = rp_[1]; LG[rd_][5] = rp_[2]; LG[rd_][6] = rp_[3]; } } while (0)
#define CK_NEXTBLK() ({ unsigned v_ = 0u; if (lane == 0) v_ = __hip_atomic_fetch_add((CLAS unsigned*)(flag + 16), 1u, __ATOMIC_RELAXED, __HIP_MEMORY_SCOPE_WORKGROUP); (int)__builtin_amdgcn_readfirstlane(v_); })
            int blk = GLOBAL ? first : CK_NEXTBLK();
            if (blk < NBLK) { CK_LOAD(0, blk); CK_LOAD(1, blk); }
            while (blk < NBLK) {
                const int nxt = GLOBAL ? blk + NP : CK_NEXTBLK();
                CLAS unsigned char* rec = lds + O_RING + (GLOBAL ? pwv : (blk % RING)) * REC;
                if (!GLOBAL && blk >= RING) { unsigned sp = 0; const unsigned need = (unsigned)(blk - RING + 1); while (ldw(flag + 12) < need || (NSCAN > 1 && ldw(flag + 13) < need) || (NSCAN > 2 && (ldw(flag + 14) < need || ldw(flag + 15) < need))) { __builtin_amdgcn_s_sleep(2); if (++sp > (1u << 22)) break; } }
                asm volatile("" ::: "memory");
                if (probe == 1) { if (lane == 0) flag[blk % RING] = (unsigned)(blk + 1); blk = nxt; continue; }
#ifdef PROBE_PREP_DELAY
                if (rw) __builtin_amdgcn_s_sleep(PROBE_PREP_DELAY);
#endif
#pragma unroll
                for (int rd = 0; rd < 2; ++rd) {
                    const int j = 8 * rd + tk, t = blk * 16 + j;
                    if (rw) {
                        const u32x4 Lr0 = LG[rd][0], Lk0 = LG[rd][1], Lv0 = LG[rd][2], Lr1 = LG[rd][3], Lk1 = LG[rd][4], Lv1 = LG[rd][5], La = LG[rd][6], Le = LG[rd][7], Lm = LG[rd][8];
                        float r[8], km[8], kkr[8], al[8], vv[8]; float n2 = 0.f, bon = 0.f;
#pragma unroll
                        for (int e = 0; e < 8; ++e) { const float rc = CK_U(Lr0, e), rq = CK_U(Lr1, e), kc = CK_U(Lk0, e), kq = CK_U(Lk1, e), vc = CK_U(Lv0, e), vq = CK_U(Lv1, e);
                            r[e] = rc + (rq - rc) * cst[8 * ch + e]; const float kraw = kc + (kq - kc) * cst[64 + 8 * ch + e]; vv[e] = vc + (vq - vc) * cst[128 + 8 * ch + e];
                            al[e] = CK_U(La, e);
                            kkr[e] = kraw * cst[192 + 8 * ch + e]; km[e] = kraw * (1.f + (al[e] - 1.f) * cst[256 + 8 * ch + e]);
                            n2 += kkr[e] * kkr[e]; bon += r[e] * km[e] * cst[320 + 8 * ch + e]; }
                        if (nxt < NBLK) CK_LOAD(rd, nxt);
                        n2 = sum8(n2); bon = sum8(bon);
                        const float inv = rsqrtf(fmaxf(n2, 1e-24f));
                        if (ch == 0 && bonus_on) BONUS[(mb + t) * 8 + hh] = bon;
                        u32x4 oa, ob, ok, orr; float lpl[8];
#pragma unroll
                        for (int e = 0; e < 8; ++e) {
                            const float lp = CK_H(Le, e), lpm = CK_H(Lm, e); lpl[e] = lp;
                            const float em = __builtin_amdgcn_exp2f(-lp), ep = __builtin_amdgcn_exp2f(lp), epm = __builtin_amdgcn_exp2f(lpm);
                            const float kk = kkr[e] * inv;
                            r[e] = r[e] * ep; km[e] = km[e] * em; kkr[e] = -kk * epm; al[e] = kk * al[e] * em; }
#pragma unroll
                        for (int e = 0; e < 4; ++e) { oa[e] = pk(kkr[2 * e], kkr[2 * e + 1]); ob[e] = pk(al[2 * e], al[2 * e + 1]); ok[e] = pk(km[2 * e], km[2 * e + 1]); orr[e] = pk(r[2 * e], r[2 * e + 1]); }
                        *(CLAS u32x4*)(rec + O_AT + j * 128 + ch * 16) = oa; *(CLAS u32x4*)(rec + O_BT + j * 128 + ch * 16) = ob;
                        *(CLAS u32x4*)(rec + O_KT + j * 128 + ch * 16) = ok; *(CLAS u32x4*)(rec + O_RT + j * 128 + ch * 16) = orr;
#pragma unroll
                        for (int e = 0; e < 8; ++e) { (void)0; }
                        { u32x4 ov; ov[0] = pk(vv[0], vv[1]); ov[1] = pk(vv[2], vv[3]); ov[2] = pk(vv[4], vv[5]); ov[3] = pk(vv[6], vv[7]); *(CLAS u32x4*)(rec + O_VT + j * 128 + ch * 16) = ov; }
                        if (rd == 1 && tk == 7) { *(CLAS f32x4*)(rec + O_P15 + ch * 32) = (f32x4){__builtin_amdgcn_exp2f(lpl[0]), __builtin_amdgcn_exp2f(lpl[1]), __builtin_amdgcn_exp2f(lpl[2]), __builtin_amdgcn_exp2f(lpl[3])};
                            *(CLAS f32x4*)(rec + O_P15 + ch * 32 + 16) = (f32x4){__builtin_amdgcn_exp2f(lpl[4]), __builtin_amdgcn_exp2f(lpl[5]), __builtin_amdgcn_exp2f(lpl[6]), __builtin_amdgcn_exp2f(lpl[7])}; }
                    } else {
                        const u32x4 Lq = LG[rd][0], Lk = LG[rd][1], Lv = LG[rd][2]; f32x4 rot_[4]; rot_[0] = __builtin_bit_cast(f32x4, LG[rd][3]); rot_[1] = __builtin_bit_cast(f32x4, LG[rd][4]); rot_[2] = __builtin_bit_cast(f32x4, LG[rd][5]); rot_[3] = __builtin_bit_cast(f32x4, LG[rd][6]);
                        if (nxt < NBLK) CK_LOAD(rd, nxt);
                        const float pw = __builtin_amdgcn_exp2f((float)(j + 1) * l2g), ipw = 0.125f * __builtin_amdgcn_exp2f(-(float)(j + 1) * l2g);
                        u32x4 oq, ok; float qo[8], ko[8];
#pragma unroll
                        for (int e = 0; e < 8; ++e) { const float cs = rot_[e >> 1][2 * (e & 1)], sn = rot_[e >> 1][2 * (e & 1) + 1]; const float qv = CK_U(Lq, e), kv = CK_U(Lk, e);
                            const float qp = xor4(qv), kp = xor4(kv);
                            qo[e] = (ch < 4 ? qv * cs - qp * sn : qp * sn + qv * cs) * pw; ko[e] = (ch < 4 ? kv * cs - kp * sn : kp * sn + kv * cs) * ipw;
                        }
                        *(CLAS u32x4*)(rec + O_VT + j * 128 + ch * 16) = Lv;
#pragma unroll
                        for (int e = 0; e < 4; ++e) { oq[e] = pk(qo[2 * e], qo[2 * e + 1]); ok[e] = pk(ko[2 * e], ko[2 * e + 1]); }
                        *(CLAS u32x4*)(rec + O_RT + j * 128 + ch * 16) = oq; *(CLAS u32x4*)(rec + O_KT + j * 128 + ch * 16) = ok;
                    }
                }
                asm volatile("s_waitcnt lgkmcnt(0)" ::: "memory");
                const int jc = lane & 15, gg = lane >> 4;
                const bf16x8 bR0 = *(const CLAS bf16x8*)(rec + O_RT + jc * 128 + gg * 16), bR1 = *(const CLAS bf16x8*)(rec + O_RT + jc * 128 + 64 + gg * 16);
                const bf16x8 aK0 = *(const CLAS bf16x8*)(rec + O_KT + jc * 128 + gg * 16), aK1 = *(const CLAS bf16x8*)(rec + O_KT + jc * 128 + 64 + gg * 16);
                const f32x4 zero = {0.f, 0.f, 0.f, 0.f};
                f32x4 crk = CK_MFMA(aK0, bR0, zero); crk = CK_MFMA(aK1, bR1, crk);
#pragma unroll
                for (int r = 0; r < 4; ++r) crk[r] = (4 * gg + r <= jc) ? crk[r] : 0.f;
                if (!rw) {
                    u32x4 w; w[0] = 0u; w[1] = 0u; w[2] = pk(crk[0], crk[1]); w[3] = pk(crk[2], crk[3]);
                    *(CLAS u32x4*)(rec + O_CC + jc * 64 + gg * 16) = w;
                } else {
                    const bf16x8 bA0 = *(const CLAS bf16x8*)(rec + O_AT + jc * 128 + gg * 16), bA1 = *(const CLAS bf16x8*)(rec + O_AT + jc * 128 + 64 + gg * 16);
                    const bf16x8 aB0 = *(const CLAS bf16x8*)(rec + O_BT + jc * 128 + gg * 16), aB1 = *(const CLAS bf16x8*)(rec + O_BT + jc * 128 + 64 + gg * 16);
                    f32x4 crb = CK_MFMA(aB0, bR0, zero); crb = CK_MFMA(aB1, bR1, crb);
                    f32x4 cab = CK_MFMA(aB0, bA0, zero); cab = CK_MFMA(aB1, bA1, cab);
                    f32x4 cba = CK_MFMA(bA0, aB0, zero); cba = CK_MFMA(bA1, aB1, cba);
                    f32x4 cka = CK_MFMA(bA0, aK0, zero); cka = CK_MFMA(bA1, aK1, cka);
                    f32x4 idn;
#pragma unroll
                    for (int r = 0; r < 4; ++r) { crb[r] = (4 * gg + r <= jc) ? crb[r] : 0.f; cab[r] = (4 * gg + r < jc) ? cab[r] : 0.f;
                        cba[r] = (jc < 4 * gg + r) ? cba[r] : 0.f; cka[r] = (jc < 4 * gg + r) ? cka[r] : 0.f; idn[r] = (4 * gg + r == jc) ? 1.f : 0.f; }
                    { u32x4 w; w[0] = pk(crb[0], crb[1]); w[1] = pk(crb[2], crb[3]); w[2] = pk(crk[0], crk[1]); w[3] = pk(crk[2], crk[3]); *(CLAS u32x4*)(rec + O_CC + jc * 64 + gg * 16) = w; }
#define CK_PROD(X, Y, ACC) ({ f32x4 p_ = (ACC); _Pragma("unroll") for (int r_ = 0; r_ < 4; ++r_) p_ = __builtin_amdgcn_mfma_f32_16x16x4f32((X)[r_], (Y)[r_], p_, 0, 0, 0); p_; })
                    const f32x4 d2 = CK_PROD(cab, cba, zero), c2 = CK_PROD(cba, cab, zero);
                    const f32x4 d4 = CK_PROD(c2, d2, zero), c4 = CK_PROD(d2, c2, zero);
                    const f32x4 d8 = CK_PROD(c4, d4, zero);
                    const f32x4 s1 = cba + idn, t1 = cab + idn;
                    const f32x4 s2 = CK_PROD(t1, d2, s1), t2 = CK_PROD(d2, t1, t1);
                    const f32x4 s3 = CK_PROD(t2, d4, s2), t3 = CK_PROD(d4, t2, t2);
                    const f32x4 s4 = CK_PROD(t3, d8, s3), t4 = CK_PROD(d8, t3, t3);
                    const f32x4 et = CK_PROD(t4, cka, zero);
#undef CK_PROD
#pragma unroll
                    for (int r = 0; r < 4; ++r) { const int i = 4 * gg + r;
                        *(CLAS bf16*)(rec + O_IE + i * 64 + ((jc >> 2) * 8 + (jc & 3)) * 2) = (bf16)pk(s4[r], 0.f);
                        *(CLAS bf16*)(rec + O_IE + i * 64 + ((jc >> 2) * 8 + 4 + (jc & 3)) * 2) = (bf16)pk(et[r], 0.f); }
                }
                asm volatile("s_waitcnt lgkmcnt(0)" ::: "memory");
                if (!GLOBAL) { if (lane == 0) flag[blk % RING] = (unsigned)(blk + 1); }
                else {
                    const int gs = blk & (GRING - 1);
                    if (blk >= GRING) { const unsigned need = ep0 + (unsigned)(blk - GRING + 1); unsigned sp = 0;
                        while (__hip_atomic_load(gack + gs * 64, __ATOMIC_RELAXED, __HIP_MEMORY_SCOPE_AGENT) != need) { __builtin_amdgcn_s_sleep(2); if (++sp > (1u << 20)) break; } }
                    unsigned char* gd = gring + (size_t)gs * REC + lane * 16;
#pragma unroll
                    for (int i = 0; i < 13; ++i) { if (i < 12 || lane < 32) { const u32x4 v = *(const CLAS u32x4*)(rec + i * 1024 + lane * 16);
                        asm volatile("global_store_dwordx4 %0, %1, off sc1" :: "v"(gd + i * 1024), "v"(v) : "memory"); } }
                    asm volatile("s_waitcnt vmcnt(0)" ::: "memory");
                    if (lane == 0) __hip_atomic_store(gflag + gs * 64, ep0 + (unsigned)(blk + 1), __ATOMIC_RELAXED, __HIP_MEMORY_SCOPE_AGENT);
                }
                blk = nxt;
            }
#undef CK_NEXTBLK
}

__device__ __forceinline__ void rwkv_consumer(CLAS unsigned char* lds, volatile CLAS unsigned* flag, int wave, int lane, int hh, size_t mb, bf16* YR, const unsigned char* gring, unsigned* gflag, unsigned* gack, unsigned ep0) {
    if (wave < 4) { scan_wave<true, 0>(lds, flag, wave, lane, wave * 16, hh, mb, YR); return; }
    if (wave == 4) {
        int avail = 0; unsigned sp = 0;
        while (avail < NBLK) {
            const int bi = avail + (lane & (GRING - 1));
            const unsigned v = __hip_atomic_load(gflag + (bi & (GRING - 1)) * 64, __ATOMIC_RELAXED, __HIP_MEMORY_SCOPE_AGENT);
            const bool ok = (lane < GRING) && (bi < NBLK) && (v == ep0 + (unsigned)(bi + 1));
            const unsigned long long m = __ballot(ok);
            const int n = __builtin_ctzll(~m);
            if (n > 0) { __builtin_amdgcn_fence(__ATOMIC_ACQUIRE, "agent"); asm volatile("s_waitcnt vmcnt(0)" ::: "memory"); avail += n; if (lane == 0) flag[16] = (unsigned)avail; sp = 0; }
            else { __builtin_amdgcn_s_sleep(1); if (++sp > (1u << 20)) break; }
        }
        if (lane == 0) flag[16] = (unsigned)NBLK;
        return;
    }
    int prev = -1;
    for (int blk = wave - 5; blk < NBLK; blk += 3) {
        const int slot = blk % RING, gs = blk & (GRING - 1);
        if (blk >= RING) { unsigned sp = 0; const unsigned need = (unsigned)(blk - RING + 1);
            while (ldw(flag + 12) < need || ldw(flag + 13) < need || ldw(flag + 14) < need || ldw(flag + 15) < need) { __builtin_amdgcn_s_sleep(1); if (++sp > (1u << 22)) break; } }
        { unsigned sp = 0; while (ldw(flag + 16) <= (unsigned)blk) { __builtin_amdgcn_s_sleep(1); if (++sp > (1u << 22)) break; } }
        asm volatile("" ::: "memory");
        const unsigned char* gsrc = gring + (size_t)gs * REC + lane * 16;
        CLAS unsigned char* dst = lds + O_RING + slot * REC;
#pragma unroll
        for (int i = 0; i < 13; ++i) { if (i < 12 || lane < 32) __builtin_amdgcn_global_load_lds((const unsigned*)(gsrc + i * 1024), (CLAS unsigned*)(dst + i * 1024), 16, 0, 0); }
        if (prev >= 0) { asm volatile("s_waitcnt vmcnt(13)" ::: "memory");
            if (lane == 0) { flag[prev % RING] = (unsigned)(prev + 1); __hip_atomic_store(gack + (prev & (GRING - 1)) * 64, ep0 + (unsigned)(prev + 1), __ATOMIC_RELAXED, __HIP_MEMORY_SCOPE_AGENT); } }
        prev = blk;
    }
    asm volatile("s_waitcnt vmcnt(0)" ::: "memory");
    if (prev >= 0 && lane == 0) { flag[prev % RING] = (unsigned)(prev + 1); __hip_atomic_store(gack + (prev & (GRING - 1)) * 64, ep0 + (unsigned)(prev + 1), __ATOMIC_RELAXED, __HIP_MEMORY_SCOPE_AGENT); }
}

template <int probe = 0> __device__ __forceinline__ void phase(CLAS unsigned char* lds, int bid, int G, int wave, int lane, const bf16* PROJ, const bf16* DECB, const bf16* ALPHA, bf16* YR, float* BONUS, const f32x2* ROT,
                                      const float* mu, const float* k_k, const float* k_a, const float* r_k, unsigned char* gring0, unsigned* gflag0, unsigned* gack0, unsigned ep0) {
    const int vcu = (G % 8 == 0) ? (bid % 8) * (G / 8) + bid / 8 : bid;
    volatile CLAS unsigned* flag = (volatile CLAS unsigned*)(lds + O_FLAG);
    const bool three = (G == 256) && (THREE_ROLE != 0);
    for (int cu = vcu; cu < 256; cu += G) {
        const bool rw = three ? ((cu & 3) < 3) : (cu < 128); const int cc = rw ? cu : cu - 128, role = cu & 3;
        const int bh = three ? (cu >> 2) : (cc >> 1), half = three ? 0 : (cc & 1), b = bh >> 3, hh = bh & 7;
        const size_t mb = (size_t)b * 4096;
        __syncthreads();
        if (wave == 0 && lane < 32) flag[lane] = 0u;
        if (wave == 1) { CLAS float* cst = (CLAS float*)(lds + O_CST); const int c = hh * 64 + lane;
            cst[lane] = mu[c]; cst[64 + lane] = mu[512 + c]; cst[128 + lane] = mu[1024 + c]; cst[192 + lane] = k_k[c]; cst[256 + lane] = k_a[c]; cst[320 + lane] = r_k[c]; }
        __syncthreads();
        if (three) {
            unsigned char* gring = gring0 + (size_t)bh * (GRING * REC); unsigned* gflag = gflag0 + bh * (GRING * 64); unsigned* gack = gack0 + bh * (GRING * 64);
            if (role < 2) prep_wave<true, 16, true, 0, 2>(lds, flag, wave, 2 * wave + role, lane, hh, mb, true, PROJ, DECB, ALPHA, BONUS, ROT, gring, gflag, gack, ep0);
            else if (role == 2) rwkv_consumer(lds, flag, wave, lane, hh, mb, YR, gring, gflag, gack, ep0);
            else { if (wave < 4) scan_wave<false, 0>(lds, flag, wave, lane, wave * 16, hh, mb, YR);
                   else prep_wave<false, 4, false, 0, 4>(lds, flag, wave - 4, wave - 4, lane, hh, mb, false, PROJ, DECB, ALPHA, BONUS, ROT, nullptr, nullptr, nullptr, 0u); }
        } else if (!rw) {
            if (wave < 2) scan_wave<false, probe>(lds, flag, wave, lane, half * 32 + wave * 16, hh, mb, YR);
            else prep_wave<false, 6, false, probe>(lds, flag, wave - 2, wave - 2, lane, hh, mb, false, PROJ, DECB, ALPHA, BONUS, ROT, nullptr, nullptr, nullptr, 0u);
        } else {
            if (wave < 1) scan_wave2<true, probe>(lds, flag, wave, lane, half * 32, hh, mb, YR);
            else prep_wave<true, 7, false, probe, 1>(lds, flag, wave - 1, wave - 1, lane, hh, mb, half == 0, PROJ, DECB, ALPHA, BONUS, ROT, nullptr, nullptr, nullptr, 0u);
        }
    }
    __syncthreads();
}
#undef CK_MFMA
#undef CK_LOAD
#undef CK_U
#undef CK_H
#undef CLAS
}
#ifndef REP_SCAN
#define REP_SCAN 1
#endif
#ifndef REP_DATTN
#define REP_DATTN 1
#endif
#ifndef REP_MLP1
#define REP_MLP1 1
#endif
#ifndef REP_W
#define REP_W 1
#endif
#ifndef REP_XL
#define REP_XL 1
#endif
#ifndef REP_P6
#define REP_P6 1
#endif
#ifndef REP_P9
#define REP_P9 1
#endif
#ifndef LORA_ALIGN
#define LORA_ALIGN false
#endif
#ifndef P1_REV_ODD
#define P1_REV_ODD 1
#endif
#ifndef P1_REV
#define P1_REV 1
#endif
#ifndef REP_P12
#define REP_P12 1
#endif
#ifndef PROBE_P9_MODE
#define PROBE_P9_MODE 0
#endif
#ifndef PROBE_MLP1_HOT
#define PROBE_MLP1_HOT 0
#endif
#ifndef PROBE_MLP1_ROWS
#define PROBE_MLP1_ROWS NTOK
#endif
#ifndef REP_P1
#define REP_P1 1
#endif
#ifndef REP_P3
#define REP_P3 1
#endif
#ifndef HOIST_L2
#define HOIST_L2 0
#endif
#ifndef GROUP_SEAMS
#define GROUP_SEAMS 0
#endif
#ifndef PROBE_CK
#define PROBE_CK 0
#endif
#ifndef PG8_ALIGN_BIG
#define PG8_ALIGN_BIG PG8_ALIGN
#endif
#ifndef PROBE_DATTN_NOBAR
#define PROBE_DATTN_NOBAR false
#endif
#ifndef HOIST_FOLDS
#define HOIST_FOLDS 1
#endif
#ifndef MLP2_REV
#define MLP2_REV 1
#endif
#ifndef REP_LOGITS
#define REP_LOGITS 1
#endif
#ifndef REP_NORM
#define REP_NORM 1
#endif
struct Args { const float* in[34]; float* out; unsigned char* ws; int ph_lo, ph_hi, li, pad; };
typedef const __attribute__((address_space(4))) Args* ArgsP;
__device__ __forceinline__ const float* ldarg(ArgsP p, int k) { asm volatile("" : "+s"(p)); return p->in[k]; }
#define INP(k) ldarg(ap0, k)
__device__ __forceinline__ bf16* wptr(unsigned char* ws, unsigned char* outb, int layer, int which) {
    const bool odd = layer & 1;
    unsigned char* ob = outb + 64 * MiB;
    unsigned char* eb = (layer == 0 || !HOIST_L2) ? ws + WS_W : outb + 92 * MiB;
    switch (which) {
        case 0: return (bf16*)(odd ? ob : eb + WO_IN * 2);
        case 1: return (bf16*)(odd ? ob + 6 * MiB : eb + WO_OUT * 2);
        case 2: return (bf16*)(odd ? ob + 8 * MiB : eb + WO_Q * 2);
        case 3: return (bf16*)(odd ? ob + 10 * MiB : eb + WO_O * 2);
        case 4: return (bf16*)(odd ? ob + 12 * MiB : eb + WO_1 * 2);
        case 5: return (bf16*)(odd ? ob + 20 * MiB : eb + WO_2 * 2);
        default: return (bf16*)(eb + WO_KV * 2);
    }
}
__device__ __forceinline__ void convert_layer(ArgsP ap0, unsigned char* ws, unsigned char* outb, int layer, int gwv, int ngw, int gt, int ngt, int lane, LAS float* scr) {
    const int li = layer >> 1; const bool even = (layer & 1) == 0;
    bf16* Win = wptr(ws, outb, layer, 0); bf16* Wout = wptr(ws, outb, layer, 1); bf16* Wq = wptr(ws, outb, layer, 2); bf16* Wo = wptr(ws, outb, layer, 3);
    bf16* W1 = wptr(ws, outb, layer, 4); bf16* W2 = wptr(ws, outb, layer, 5); bf16* Wkv = wptr(ws, outb, layer, 6);
            const int nin = even ? HYB : QKVW;
            const float* w_in = even ? INP(13) + (size_t)li * 1024 * HYB : INP(27) + (size_t)li * 1024 * QKVW;
            const float* w_out = even ? INP(26) + (size_t)li * 1024 * 1024 : INP(33) + (size_t)li * 1024 * 1024;
            const float* w_q = INP(8) + (size_t)layer * 1024 * 1024; const float* w_kv = INP(9) + (size_t)layer * 1024 * 2048; const float* w_o = INP(10) + (size_t)layer * 1024 * 1024;
            const float* w_1 = INP(11) + (size_t)layer * 1024 * 4096; const float* w_2 = INP(12) + (size_t)layer * 4096 * 1024;
            const int c_in = 16 * (nin / 32), c_sq = 16 * 32, c_kv = even ? 2 * 16 * 64 : 0, c_1 = 16 * 128, c_2 = 64 * 32;
            const int total = c_in + 2 * c_sq + c_kv + c_1 + c_2;
            for (int it = gwv; it < total; it += ngw) {
                int r = it;
                if (r < c_in) { transpose_item(w_in, 1024, nin, Win, scr, r, lane, INP(5) + layer * 1024); continue; } r -= c_in;
                if (r < c_sq) { transpose_item(w_out, 1024, 1024, Wout, scr, r, lane, nullptr); continue; } r -= c_sq;
                if (r < c_kv) { if (r < 16 * 64) transpose_item(w_kv, 1024, 2048, Wkv, scr, r, lane, nullptr); else transpose_item(w_kv + (size_t)1024 * 2048, 1024, 2048, (bf16*)(ws + WS_WKV2), scr, r - 16 * 64, lane, nullptr); continue; } r -= c_kv;
                if (r < c_sq) { transpose_item(w_o, 1024, 1024, Wo, scr, r, lane, nullptr); continue; } r -= c_sq;
                if (r < c_1) { transpose_item(w_1, 1024, 4096, W1, scr, r, lane, INP(7) + layer * 1024); continue; } r -= c_1;
                transpose_item(w_2, 4096, 1024, W2, scr, r, lane, nullptr);
            }
            for (int i = gt * 8; i < 1024 * 1024; i += ngt * 8) {
                const float g_ = INP(6)[layer * 1024 + (i >> 10)]; const f32x4 a = *(const f32x4*)(w_q + i) * g_, c = *(const f32x4*)(w_q + i + 4) * g_; v4u o; o.x = pk2(a.x, a.y); o.y = pk2(a.z, a.w); o.z = pk2(c.x, c.y); o.w = pk2(c.z, c.w); *(v4u*)(Wq + i) = o; }
            if (even) {
                const float* w2 = INP(16) + (size_t)li * 64 * 512; const float* a2 = INP(18) + (size_t)li * 64 * 512; const float* g2 = INP(19) + (size_t)li * 128 * 512;
                for (int i = gt; i < 1536 * 32; i += ngt) { const int n = i >> 5, k0 = (i & 31) * 8; float v[8];
#pragma unroll
                    for (int e = 0; e < 8; ++e) { const int k = k0 + e; v[e] = n < 512 ? (k < 64 ? w2[k * 512 + n] : 0.f) : n < 1024 ? ((k >= 64 && k < 128) ? a2[(k - 64) * 512 + n - 512] : 0.f) : (k >= 128 ? g2[(k - 128) * 512 + n - 1024] : 0.f); }
                    v4u o; o.x = pk2(v[0], v[1]); o.y = pk2(v[2], v[3]); o.z = pk2(v[4], v[5]); o.w = pk2(v[6], v[7]); *(v4u*)((bf16*)(ws + WS_LW) + (size_t)n * 256 + k0) = o; }
            }
}
__global__ void __launch_bounds__(NWAVES * 64, 2) fwd(Args args) {
    const ArgsP ap0 = (ArgsP)__builtin_amdgcn_kernarg_segment_ptr();
#define INP(k) ldarg(ap0, k)
    extern __shared__ __attribute__((aligned(16))) unsigned char lds_raw[];
    LAS unsigned char* lds = (LAS unsigned char*)lds_raw;
    const int tid0 = threadIdx.x; const int wave0 = __builtin_amdgcn_readfirstlane(tid0 >> 6);
    const int G = gridDim.x, bid = blockIdx.x, NGW = G * NWAVES;
    unsigned char* ws = args.ws;
    for (int u = tid0; u < (LDS_BYTES - LDSCTL_OFF) / 4; u += NWAVES * 64) ((LAS unsigned*)(lds + LDSCTL_OFF))[u] = 0u;
    __syncthreads();
    volatile LAS unsigned* MISC = (volatile LAS unsigned*)(lds + MISC_OFF);
    XcdBarrier bar = xcd_barrier_post((unsigned*)(ws + WS_CTL) + CW_BAR + args.li * XCD_BAR_WORDS, MISC + 8);
    const int lo = args.ph_lo, hi = args.ph_hi;
#define IN(k) (lo <= (k) && (k) < hi)
#define PHASE_IDS() int lane; asm volatile("v_mbcnt_lo_u32_b32 %0, -1, 0\n\tv_mbcnt_hi_u32_b32 %0, -1, %0" : "=v"(lane)); const int tid = wave0 * 64 + lane, wave = wave0, gw = bid * NWAVES + wave; (void)tid; (void)gw
#define SEAM2(k, nx) do { if (IN(k) && IN(nx)) xcd_barrier(bar, wave0); } while (0)
    unsigned* gcnt = (unsigned*)(ws + WS_CTL + 128 * 1024) + (bid & 7) * 64 + args.li * 1024; unsigned ggen = 0u; const bool grouped = (G % 8 == 0) && GROUP_SEAMS;
#define SEAMG(k, nx) do { if (IN(k) && IN(nx)) { if (grouped) grp_barrier(gcnt, (unsigned)(G / 8), ggen, (unsigned*)(ws + WS_CTL) + CW_BAR + args.li * XCD_BAR_WORDS + XB_TMO); else xcd_barrier(bar, wave0); } } while (0)
    const float* x = INP(0); float* out = args.out; bf16* U = (bf16*)args.out;
    bf16* MEMN = (bf16*)(ws + WS_MEMN); bf16* KVB = (bf16*)(ws + WS_KV); bf16* WB = (bf16*)(ws + WS_W); bf16* HN = (bf16*)(ws + WS_HN); bf16* BIG = (bf16*)(ws + WS_BIG);
    bf16* WQK = (bf16*)(ws + WS_WQK); bf16* VWO = (bf16*)(ws + WS_VWO); bf16* LW = (bf16*)(ws + WS_LW); bf16* XL = (bf16*)(ws + WS_XL);
    bf16* DECB = (bf16*)(ws + WS_DEC); bf16* ALPHA = (bf16*)(ws + WS_ALPHA); bf16* GGB = (bf16*)(ws + WS_G); float* BONUS = (float*)(ws + WS_BONUS); float* SSP = (float*)(ws + WS_SSP); mix::f32x2* ROT = (mix::f32x2*)(ws + WS_ROT);

    for (int layer = 0; layer < 4; ++layer) {
        const int pb = layer * PH_PER_LAYER, li = layer >> 1; const bool even = (layer & 1) == 0;
        unsigned char* outb = (unsigned char*)args.out;
        bf16* Win = wptr(ws, outb, layer, 0); bf16* Wout = wptr(ws, outb, layer, 1); bf16* Wq = wptr(ws, outb, layer, 2); bf16* Wo = wptr(ws, outb, layer, 3); bf16* W1 = wptr(ws, outb, layer, 4); bf16* W2 = wptr(ws, outb, layer, 5);
        const bool foldh = HOIST_FOLDS && even && (G == 256) && !THREE_ROLE && !HOIST_L2;
        bf16* WQKl = foldh ? (bf16*)(outb + 92 * MiB) : WQK; bf16* VWOl = foldh ? (bf16*)(outb + 108 * MiB) : VWO;
        bf16* Ua = U; bf16* Ub = U;
        if ((layer == 0 || (!HOIST_L2 && even)) && IN(pb + 0)) for (int rep_ = 0; rep_ < REP_W; ++rep_) { if (rep_) xcd_barrier(bar, wave0); PHASE_IDS();
            LAS float* scr = (LAS float*)(lds + wave * 16384);
            convert_layer(ap0, ws, (unsigned char*)args.out, layer, gw, NGW, bid * 512 + tid, G * 512, lane, scr);
            if (layer == 0) {
                for (int i = bid * 512 + tid; i < 4096 * 32; i += G * 512) { const int t = i >> 5, fi = i & 31; const float inv = exp2f(-(float)(2 * fi) * (1.f / 64.f) * 13.287712379549449f); const float ang = (float)t * inv;
                    float sn, cs; sincosf(ang, &sn, &cs); mix::f32x2 v; v.x = cs; v.y = sn; ROT[i] = v; }
                for (int m = gw; m < MROWS; m += NGW) rms_row_to_bf16(INP(1) + (size_t)m * 1024, INP(3), MEMN + (size_t)m * 1024, lane);
            }
            if (layer == 0) for (int m = gw; m < NTOK; m += 4 * NGW) rows4_to_bf16_ss(x, Ua, SSP, m, NGW, NTOK, lane);
        }
        if (layer == 0 || (!HOIST_L2 && even)) SEAM2(pb + 0, pb + 1);
        if (IN(pb + 1)) for (int rep_ = 0; rep_ < REP_P1; ++rep_) { if (rep_) xcd_barrier(bar, wave0); PHASE_IDS();
            if (even) { const pg8::Gemm g = pg8::gemm_plain(Ua, Win, NTOK, HYB, 1024); pg8::StaticOrder S; S.init(g, G, bid); S.rev = P1_REV;     pg8::EpiBf16<0, true> E{BIG, HYB, 1, 0, 0, 1.f, 0, SSP, (LAS float*)(lds + XCH_OFF + 8192)};
                pg8::gemm_phase<pg8::EpiBf16<0, true>, pg8::StaticOrder, PG8_ALIGN_BIG, PG8_SP2>(lds, g, S, E, tid); }
            else { const pg8::Gemm g = pg8::gemm_plain(Ua, Win, NTOK, QKVW, 1024); pg8::StaticOrder S; S.init(g, G, bid); S.rev = P1_REV_ODD; pg8::EpiBf16<0, true> E{BIG, QKVW, 1, 0, 0, dattn::C2, 1024, SSP, (LAS float*)(lds + XCH_OFF + 8192)};
                pg8::gemm_phase<pg8::EpiBf16<0, true>, pg8::StaticOrder, PG8_ALIGN_BIG, PG8_SP2>(lds, g, S, E, tid); }
            if (even) {
                { const pg8::Gemm g = pg8::gemm_plain(MEMN, wptr(ws, outb, layer, 6), MROWS, 2048, 1024); pg8::StaticOrder S; S.init(g, G, (bid + G / 2) % G); pg8::EpiBf16<0> E{KVB, 2048, 1, 0, 0, 1.f, 0, nullptr, nullptr};
                  pg8::gemm_phase<pg8::EpiBf16<0>, pg8::StaticOrder, PG8_ALIGN, PG8_SP2>(lds, g, S, E, tid); }
                { const pg8::Gemm g = pg8::gemm_plain(MEMN, (const bf16*)(ws + WS_WKV2), MROWS, 2048, 1024); pg8::StaticOrder S; S.init(g, G, (bid + G / 4) % G); pg8::EpiBf16<0> E{(bf16*)(ws + WS_KV2), 2048, 1, 0, 0, 1.f, 0, nullptr, nullptr};
                  pg8::gemm_phase<pg8::EpiBf16<0>, pg8::StaticOrder, PG8_ALIGN, PG8_SP2>(lds, g, S, E, tid); }
            }
        }
        if (even) {
            SEAM2(pb + 1, pb + 3);
            if (IN(pb + 3)) for (int rep_ = 0; rep_ < REP_P3; ++rep_) { if (rep_) xcd_barrier(bar, wave0); { PHASE_IDS(); const pg8::Gemm g = pg8::gemm_plain(XL, LW, NTOK, 1536, 256); pg8::PanelOrder S; S.init(g, G, bid);
                  pg8::Unit u_; int last = -1; for (int i = 0; S.next(i, u_); ++i) if (u_.pm != last) { last = u_.pm; mix::xl_phase(tid, 512, BIG, INP(14) + li * 1792, XL, u_.pm * 256, 256); } }
                asm volatile("s_waitcnt vmcnt(0)" ::: "memory"); __syncthreads();
                PHASE_IDS(); const pg8::Gemm g = pg8::gemm_plain(XL, LW, NTOK, 1536, 256); pg8::PanelOrder S; S.init(g, G, bid);
                pg8::EpiLora E{ws, WS_DEC, WS_ALPHA, WS_G, INP(15) + li * 512, INP(17) + li * 512};
                pg8::gemm_phase<pg8::EpiLora, pg8::PanelOrder, LORA_ALIGN, PG8_SP2>(lds, g, S, E, tid); }
            SEAM2(pb + 3, pb + 4);
            if (IN(pb + 4)) for (int rep_ = 0; rep_ < REP_SCAN; ++rep_) { if (rep_) xcd_barrier(bar, wave0); PHASE_IDS();
                if (rep_ + 1 < REP_SCAN) ck::phase<PROBE_CK>(lds, bid, G, wave, lane, BIG, DECB, ALPHA, HN, BONUS, (const ck::f32x2*)ROT, INP(14) + li * 1792, INP(20) + li * 512, INP(21) + li * 512, INP(22) + li * 512,
                    ws + WS_XL, (unsigned*)(ws + WS_CTL + 256 * 1024), (unsigned*)(ws + WS_CTL + 512 * 1024), (unsigned)(li * REP_SCAN + rep_) * 1024u);
                else ck::phase<0>(lds, bid, G, wave, lane, BIG, DECB, ALPHA, HN, BONUS, (const ck::f32x2*)ROT, INP(14) + li * 1792, INP(20) + li * 512, INP(21) + li * 512, INP(22) + li * 512,
                    ws + WS_XL, (unsigned*)(ws + WS_CTL + 256 * 1024), (unsigned*)(ws + WS_CTL + 512 * 1024), (unsigned)(li * REP_SCAN + rep_) * 1024u); }
            if (IN(pb + 4)) { PHASE_IDS();
                    LAS float* scr = (LAS float*)(lds + wave * 16384);
                    const int vcu_ = (G % 8 == 0) ? (bid % 8) * (G / 8) + bid / 8 : bid;
                    if (foldh && vcu_ >= 128) {
                        { const pg8::Gemm g{KVB, Wq, 256, 1024, 256, 2048, 1024, 32, 4, (size_t)256 * 2048, 256, 0, 256}; pg8::StaticOrder S; S.init(g, 128, vcu_ - 128);
                          pg8::EpiBf16<0> E{WQKl, 1024, 4, (size_t)1024 * 1024, (size_t)256 * 1024, 0.0625f * 1.4426950408889634f, 1 << 30, nullptr, nullptr};
                          pg8::gemm_phase<pg8::EpiBf16<0>, pg8::StaticOrder, PG8_ALIGN, PG8_SP2>(lds, g, S, E, tid); }
                        { const pg8::Gemm g{Wo, KVB + 1024, 1024, 256, 256, 1024, 2048, 32, 4, 0, 256, (size_t)256 * 2048, 256}; pg8::StaticOrder S; S.init(g, 128, vcu_ - 128);
                          pg8::EpiBf16<0> E{VWOl, 1024, 4, (size_t)1024 * 1024, 256, 1.f, 0, nullptr, nullptr};
                          pg8::gemm_phase<pg8::EpiBf16<0>, pg8::StaticOrder, PG8_ALIGN, PG8_SP2>(lds, g, S, E, tid); }
                        __syncthreads(); }
                    for (int nl = layer + 1; nl <= ((layer == 0 && HOIST_L2) ? 2 : layer + 1); ++nl) {
                        if (G == 256 && THREE_ROLE) { const int role_ = vcu_ & 3, hidx = (vcu_ >> 2) * 3 + (role_ == 3 ? 2 : role_);
                            if (role_ != 2) convert_layer(ap0, ws, (unsigned char*)args.out, nl, hidx * NWAVES + wave, 192 * NWAVES, hidx * 512 + tid, 192 * 512, lane, scr); }
                        else if (G == 256) { if (vcu_ >= 128) convert_layer(ap0, ws, (unsigned char*)args.out, nl, (vcu_ - 128) * NWAVES + wave, 128 * NWAVES, (vcu_ - 128) * 512 + tid, 128 * 512, lane, scr); }
                        else convert_layer(ap0, ws, (unsigned char*)args.out, nl, gw, NGW, bid * 512 + tid, G * 512, lane, scr); } }
            SEAM2(pb + 4, pb + 5);
            if (IN(pb + 5)) { PHASE_IDS(); mix::post_phase_v(gw, NGW, lane, BIG, HN, GGB, BONUS, INP(14) + li * 1792 + 1024, INP(23) + li * 512, INP(24) + li * 512, INP(25) + li * 512); }
            SEAM2(pb + 5, pb + 6);
        } else {
            SEAM2(pb + 1, pb + 4);
            if (IN(pb + 4)) for (int rep_ = 0; rep_ < REP_DATTN; ++rep_) { if (rep_) xcd_barrier(bar, wave0); PHASE_IDS();
                const float lam_init = layer == 1 ? 0.35550906f : 0.55605818f;
                const float d1 = wave_sum(INP(28)[li * 64 + lane] * INP(29)[li * 64 + lane]), d2 = wave_sum(INP(30)[li * 64 + lane] * INP(31)[li * 64 + lane]);
                const float lam = expf(d1) - expf(d2) + lam_init;
                if (rep_ + 1 < REP_DATTN) dattn::phase<PROBE_DATTN_NOBAR>(lds, bid, G, tid, BIG, HN, INP(2), INP(32) + li * 128, lam, lam_init);
                else dattn::phase<false>(lds, bid, G, tid, BIG, HN, INP(2), INP(32) + li * 128, lam, lam_init); }
            SEAM2(pb + 4, pb + 6);
        }
        if (IN(pb + 6)) for (int rep_ = 0; rep_ < REP_P6; ++rep_) { if (rep_) xcd_barrier(bar, wave0); PHASE_IDS();
            { const pg8::Gemm g = pg8::gemm_plain(HN, Wout, NTOK, 1024, 1024); pg8::StaticOrder S; S.init(g, G, bid); pg8::EpiResid E{Ua, rep_ + 1 < REP_P6 ? BIG : Ub, 1024, 0, SSP, (LAS float*)(lds + XCH_OFF), NTOK};
              pg8::gemm_phase<pg8::EpiResid, pg8::StaticOrder, PG8_ALIGN, PG8_SP2>(lds, g, S, E, tid); }
            const bf16* KVc = (const bf16*)(ws + WS_KV + (size_t)(layer & 1) * (WS_KV2 - WS_KV));
            if (!foldh) { const pg8::Gemm g{KVc, Wq, 256, 1024, 256, 2048, 1024, 32, 4, (size_t)256 * 2048, 256, 0, 256}; pg8::StaticOrder S; S.init(g, G, bid);
              pg8::EpiBf16<0> E{WQKl, 1024, 4, (size_t)1024 * 1024, (size_t)256 * 1024, 0.0625f * 1.4426950408889634f, 1 << 30, nullptr, nullptr};
              pg8::gemm_phase<pg8::EpiBf16<0>, pg8::StaticOrder, PG8_ALIGN, PG8_SP2>(lds, g, S, E, tid); }
            if (!foldh) { const pg8::Gemm g{Wo, KVc + 1024, 1024, 256, 256, 1024, 2048, 32, 4, 0, 256, (size_t)256 * 2048, 256}; pg8::StaticOrder S; S.init(g, G, (bid + G / 2) % G);
              pg8::EpiBf16<0> E{VWOl, 1024, 4, (size_t)1024 * 1024, 256, 1.f, 0, nullptr, nullptr};
              pg8::gemm_phase<pg8::EpiBf16<0>, pg8::StaticOrder, PG8_ALIGN, PG8_SP2>(lds, g, S, E, tid); }
        }
        SEAMG(pb + 6, pb + 8);
        if (IN(pb + 8)) for (int rep_ = 0; rep_ < REP_LOGITS; ++rep_) { if (rep_) xcd_barrier(bar, wave0); PHASE_IDS(); const pg8::Gemm g{Ub, WQKl, SEQ, 1024, 1024, 1024, 1024, 8, 1, (size_t)SEQ * 1024, 0, (size_t)1024 * 1024, 0}; pg8::StaticOrder S; S.init(g, G, bid);
            pg8::EpiSoftmax E{BIG, 1024, (size_t)SEQ * 1024, (LAS float*)(lds + XCH_OFF), SSP, SEQ, (LAS float*)(lds + XCH_OFF + 8192)};
            pg8::gemm_phase<pg8::EpiSoftmax, pg8::StaticOrder, true, PG8_SP2>(lds, g, S, E, tid); }
        SEAMG(pb + 8, pb + 9);
        if (IN(pb + 9)) for (int rep_ = 0; rep_ < REP_P9; ++rep_) { if (rep_) xcd_barrier(bar, wave0); PHASE_IDS(); const pg8::Gemm g{BIG, VWOl, (rep_ + 1 < REP_P9 && PROBE_P9_MODE == 9) ? 0 : SEQ, 1024, 1024, 1024, 1024, 8, 1, (size_t)SEQ * 1024, 0, (size_t)1024 * 1024, 0}; pg8::StaticOrder S; S.init(g, G, bid); pg8::EpiResid E{Ub, rep_ + 1 < REP_P9 ? HN : Ua, 1024, (size_t)SEQ * 1024, SSP, (LAS float*)(lds + XCH_OFF), SEQ, (rep_ + 1 < REP_P9) ? PROBE_P9_MODE : 0};
            pg8::gemm_phase<pg8::EpiResid, pg8::StaticOrder, PG8_ALIGN, PG8_SP2>(lds, g, S, E, tid); }
        SEAMG(pb + 9, pb + 11);
        if (IN(pb + 11)) for (int rep_ = 0; rep_ < REP_MLP1; ++rep_) { if (rep_) xcd_barrier(bar, wave0); PHASE_IDS(); pg8::Gemm g = pg8::gemm_plain(Ua, W1, (rep_ + 1 < REP_MLP1) ? PROBE_MLP1_ROWS : NTOK, DFF, 1024); if (PROBE_MLP1_HOT == 1 && rep_ + 1 < REP_MLP1) { g.lda = 0; g.ldb = 0; } if (PROBE_MLP1_HOT == 2 && rep_ + 1 < REP_MLP1) { g.M = 256; g.N = 256; g.nz = 2048; g.zdiv = 1; g.sA1 = 0; g.sA2 = 0; g.sB1 = 0; g.sB2 = 0; }     pg8::StaticOrder S; S.init(g, G, bid); pg8::EpiBf16<1, true> E{BIG, DFF, 1, 0, 0, 1.f, 0, SSP, (LAS float*)(lds + XCH_OFF + 8192)};
            pg8::gemm_phase<pg8::EpiBf16<1, true>, pg8::StaticOrder, PG8_ALIGN_BIG, PG8_SP2>(lds, g, S, E, tid); }
        SEAMG(pb + 11, pb + 12);
        if (IN(pb + 12)) for (int rep_ = 0; rep_ < REP_P12; ++rep_) { if (rep_) xcd_barrier(bar, wave0); PHASE_IDS(); pg8::Gemm g = pg8::gemm_plain(BIG, W2, NTOK, 1024, DFF); g.krev = MLP2_REV ? 2 : 0; pg8::StaticOrder S; S.init(g, G, bid); S.rev = MLP2_REV;     pg8::EpiResid E{Ua, (layer == 3 || rep_ + 1 < REP_P12) ? HN : Ub, 1024, 0, SSP, (LAS float*)(lds + XCH_OFF), NTOK};
            pg8::gemm_phase<pg8::EpiResid, pg8::StaticOrder, PG8_ALIGN, PG8_SP2>(lds, g, S, E, tid); }
        if (layer < 3) SEAMG(pb + 12, pb + 13); else SEAM2(pb + 12, pb + 13);
    }
    if (IN(PH_FINAL)) { PHASE_IDS(); for (int m = gw; m < NTOK; m += 4 * NGW) rows4_bf16_to_f32_norm(HN, INP(4), out, m, NGW, NTOK, lane); }
#undef IN
#undef SEAM2
#undef SEAMG
}

extern "C" void kernel_launch(void* const* d_in, const int* in_sizes, int n_in, void* d_out, int out_size, void* d_ws, size_t ws_size, hipStream_t stream) {
    static int grid = 0;
    if (grid == 0) {
        if (n_in != 34 || out_size != NTOK * DM || ws_size < WS_END) { fprintf(stderr, "kernel_launch: unexpected shapes (n_in %d out %d ws %zu)\n", n_in, out_size, ws_size); grid = -1; return; }
        int dev = 0, cus = 0;
        if (hipGetDevice(&dev) != hipSuccess || hipDeviceGetAttribute(&cus, hipDeviceAttributeMultiprocessorCount, dev) != hipSuccess) { grid = -1; return; }
        if (hipFuncSetAttribute((const void*)fwd, hipFuncAttributeMaxDynamicSharedMemorySize, LDS_BYTES) != hipSuccess) { grid = -1; return; }
        int per_cu = 0;
        (void)hipOccupancyMaxActiveBlocksPerMultiprocessor(&per_cu, (const void*)fwd, NWAVES * 64, LDS_BYTES);
        (void)hipGetLastError();
        grid = cus;
    }
    if (grid < 0) return;
    (void)hipMemsetAsync((char*)d_ws + WS_CTL, 0, CTL_ZERO_BYTES, stream);
    Args a{};
    for (int i = 0; i < 34; ++i) a.in[i] = (const float*)d_in[i];
    a.out = (float*)d_out; a.ws = (unsigned char*)d_ws;
    a.ph_lo = 0; a.ph_hi = PH_TOTAL; a.li = 0;
    hipLaunchKernelGGL(fwd, dim3(grid), dim3(NWAVES * 64), LDS_BYTES, stream, a);
}
```

```cpp
#include <hip/hip_runtime.h>
#include <cstdio>
#include <cstdint>
#ifndef PG8_KREV
#define PG8_KREV 0
#endif
namespace pg8 {
#define PG8_LAS __attribute__((address_space(3)))
typedef unsigned short bf16_t;
typedef short bf16x8 __attribute__((ext_vector_type(8)));
typedef float f32x4 __attribute__((ext_vector_type(4)));
typedef unsigned u32x4 __attribute__((ext_vector_type(4)));
constexpr int BM = 256, BK = 64, HALF = 128, HTB = HALF * BK * 2  , STAGE_BYTES = 8 * HTB, NXCD = 8, WGM = 8;

__host__ __device__ __forceinline__ int lds_byte(int r, int c) { const int st = (r >> 4) * 2 + (c >> 5), rr = r & 15, cc = c & 31, ob = rr * 64 + cc * 2; return st * 1024 + (ob ^ (((ob >> 9) & 1) << 5)); }
__host__ __device__ __forceinline__ void stage_rc(int b, int& R, int& C) { const int st = b / 1024, sb = b % 1024, swz = sb ^ (((sb >> 9) & 1) << 5); R = (st >> 1) * 16 + swz / 64; C = (st & 1) * 32 + (swz % 64) / 2; }
__host__ __device__ __forceinline__ int perm32(int rho) { const int n = rho >> 4, i = rho & 15; return 8 * (i >> 2) + 4 * n + (i & 3); }

struct Unit { int pm, pn, z; };
struct Gemm { const bf16_t* A; const bf16_t* Bt; int M, N, K, lda, ldb, nz, zdiv; size_t sA1, sA2, sB1, sB2; int krev = 0; };
__host__ __device__ __forceinline__ Gemm gemm_plain(const bf16_t* A, const bf16_t* Bt, int M, int N, int K) { return Gemm{A, Bt, M, N, K, K, K, 1, 1, 0, 0, 0, 0, 0}; }

struct StaticOrder {
    int nM, nN, per_z, nwg, G, c; int rev = 0;
    __host__ __device__ void init(const Gemm& g, int G_, int c_) { nM = g.M / BM; nN = g.N / BM; per_z = nM * nN; nwg = per_z * g.nz; G = G_; c = c_; }
    __host__ __device__ bool next(int i, Unit& u) const {
        const int nr = c < nwg ? (nwg - c + G - 1) / G : 0; if (i >= nr) return false;
        const long L = (long)(rev ? nr - 1 - i : i) * G + c;
        int wgid = (int)L; { const int q = nwg / NXCD, r = nwg % NXCD, xcd = wgid % NXCD, off = wgid / NXCD; wgid = (xcd < r ? xcd * (q + 1) : r * (q + 1) + (xcd - r) * q) + off; }
        u.z = wgid / per_z; wgid -= u.z * per_z;
        const int nig = WGM * nN, gid = wgid / nig, fm = gid * WGM, gsz = (nM - fm) < WGM ? (nM - fm) : WGM;
        u.pm = fm + ((wgid % nig) % gsz); u.pn = (wgid % nig) / gsz; return true;
    }
    __device__ __forceinline__ void a_ready(const Unit&) const {}
    __device__ __forceinline__ void done(const Unit&) const {}
};

struct PanelOrder {
    int nM, nN, G, c;
    __host__ __device__ void init(const Gemm& g, int G_, int c_) { nM = g.M / BM; nN = g.N / BM; G = G_; c = c_; }
    __host__ __device__ __forceinline__ bool next(int i, Unit& u) const {
        const unsigned L = (unsigned)(i * G + c), CP = 2u * (unsigned)nM; const int lap = (int)(L / CP), w = (int)(L - (unsigned)lap * CP);
        if (lap >= nN / 2) return false;
        u.z = 0; u.pm = w >> 1; u.pn = (w & 1) * (nN / 2) + lap; return true;
    }
    __device__ __forceinline__ void a_ready(const Unit&) const {}
    __device__ __forceinline__ void done(const Unit&) const {}
};

__device__ __forceinline__ unsigned cvt_pk_bf16(float lo, float hi) { unsigned r; asm volatile("v_cvt_pk_bf16_f32 %0, %1, %2" : "=v"(r) : "v"(lo), "v"(hi)); return r; }
#ifndef NT_STORES
#define NT_STORES 0
#endif
#ifndef WT_STORES
#define WT_STORES 0
#endif
template <int ACT  , bool NORM = false> struct EpiBf16 {
    static constexpr bool PERM = true, AFTER_DRAIN = false, PRE = NORM, PF = false;
    bf16_t* O; int ldc, zdiv; size_t sO1, sO2; float scale; int scale_cols; const float* ssp; PG8_LAS float* rsl;
    __device__ __forceinline__ void pre_issue(const Unit& u, int tid, int ui) const {
        if (tid < 256) __builtin_amdgcn_global_load_lds((const unsigned*)(ssp + ((size_t)u.pm * BM + tid) * 4), (PG8_LAS unsigned*)(rsl + (ui & 1) * 1024 + (tid >> 6) * 256), 16, 0, 0); }
    __device__ __forceinline__ void operator()(const f32x4 (&acc)[2][2][4][2], const Unit& u, int wr, int wc, int fr, int fq, int ui) const {
        const int row0 = u.pm * BM + wr * 64 + fr, col0 = u.pn * BM + wc * 32 + 8 * fq;
        bf16_t* base = O + (size_t)(u.z / zdiv) * sO1 + (size_t)(u.z % zdiv) * sO2;
        const float sc0 = (u.pn * BM < scale_cols) ? scale : 1.f;
#pragma unroll
        for (int ai = 0; ai < 2; ++ai)
#pragma unroll
            for (int m = 0; m < 4; ++m) { bf16_t* rowp = base + (size_t)(row0 + ai * HALF + m * 16) * ldc + col0;
                float sc = sc0; if constexpr (NORM) { const f32x4 s4 = *(const PG8_LAS f32x4*)(rsl + (ui & 1) * 1024 + (ai * HALF + wr * 64 + m * 16 + fr) * 4); sc *= rsqrtf(((s4[0] + s4[1]) + (s4[2] + s4[3])) * (1.f / 1024.f) + 1e-6f); }
#pragma unroll
                for (int bj = 0; bj < 2; ++bj) { f32x4 v0 = acc[ai][bj][m][0] * sc, v1 = acc[ai][bj][m][1] * sc;
                    if (ACT == 1) {
#pragma unroll
                        for (int e = 0; e < 4; ++e) { const float a = v0[e] > 0.f ? v0[e] : 0.f, b = v1[e] > 0.f ? v1[e] : 0.f; v0[e] = a * a; v1[e] = b * b; } }
                    u32x4 w; w.x = cvt_pk_bf16(v0[0], v0[1]); w.y = cvt_pk_bf16(v0[2], v0[3]); w.z = cvt_pk_bf16(v1[0], v1[1]); w.w = cvt_pk_bf16(v1[2], v1[3]);
                    if (WT_STORES) asm volatile("global_store_dwordx4 %0, %1, off sc1\n\ts_nop 1" :: "v"(rowp + bj * HALF), "v"(w) : "memory");
                    else if (NT_STORES) __builtin_nontemporal_store(w, (u32x4*)(rowp + bj * HALF));
                    else *(u32x4*)(rowp + bj * HALF) = w; } }
    }
};
struct EpiResid {
    static constexpr bool PERM = true, AFTER_DRAIN = false, PRE = false, PF = false; static constexpr int PF_LEAD = 8;
    const bf16_t* base; bf16_t* hb; int ldc; size_t sO1; float* ssp; PG8_LAS float* xch; int rows_per_z; int mode = 0;
    __device__ __forceinline__ void prefetch(const Unit& u, int tid_) const {
        int tid = tid_; asm volatile("" : "+v"(tid));
        const bf16_t* p = base + (size_t)u.z * sO1 + (size_t)(u.pm * BM + (tid >> 1)) * ldc + u.pn * BM + (tid & 1) * 128;
        PG8_LAS unsigned* d = (PG8_LAS unsigned*)(xch + 2048) + (tid >> 6) * 128;
        __builtin_amdgcn_global_load_lds((const unsigned*)p, d, 4, 0, 0); __builtin_amdgcn_global_load_lds((const unsigned*)(p + 64), d + 64, 4, 0, 0); }
    __device__ __forceinline__ void operator()(const f32x4 (&acc)[2][2][4][2], const Unit& u, int wr, int wc, int fr, int fq, int ui) const {
        if (mode == 1) return;
        const int row0 = u.pm * BM + wr * 64 + fr, col0 = u.pn * BM + wc * 32 + 8 * fq;
        const size_t zo = (size_t)u.z * sO1;
        u32x4 bw[4][2];
#define PG8_RLOAD(q) do { _Pragma("unroll") for (int bj = 0; bj < 2; ++bj) bw[(q) & 3][bj] = *(const u32x4*)(base + zo + (size_t)(row0 + ((q) >> 2) * HALF + ((q) & 3) * 16) * ldc + col0 + bj * HALF); } while (0)
        PG8_RLOAD(0); PG8_RLOAD(1); PG8_RLOAD(2); PG8_RLOAD(3);
#pragma unroll
        for (int q = 0; q < 8; ++q) { const int ai = q >> 2, m = q & 3;
            const size_t off = zo + (size_t)(row0 + ai * HALF + m * 16) * ldc + col0; float ss = 0.f;
#pragma unroll
            for (int bj = 0; bj < 2; ++bj) { const u32x4 b = bw[q & 3][bj]; f32x4 v0 = acc[ai][bj][m][0], v1 = acc[ai][bj][m][1];
                v0[0] += __uint_as_float(b.x << 16); v0[1] += __uint_as_float(b.x & 0xffff0000u); v0[2] += __uint_as_float(b.y << 16); v0[3] += __uint_as_float(b.y & 0xffff0000u);
                v1[0] += __uint_as_float(b.z << 16); v1[1] += __uint_as_float(b.z & 0xffff0000u); v1[2] += __uint_as_float(b.w << 16); v1[3] += __uint_as_float(b.w & 0xffff0000u);
                ss += ((v0[0] * v0[0] + v0[1] * v0[1]) + (v0[2] * v0[2] + v0[3] * v0[3])) + ((v1[0] * v1[0] + v1[1] * v1[1]) + (v1[2] * v1[2] + v1[3] * v1[3]));
                u32x4 w; w.x = cvt_pk_bf16(v0[0], v0[1]); w.y = cvt_pk_bf16(v0[2], v0[3]); w.z = cvt_pk_bf16(v1[0], v1[1]); w.w = cvt_pk_bf16(v1[2], v1[3]);
                *(u32x4*)(hb + off + bj * HALF) = w; }
            if (q + 4 < 8) PG8_RLOAD(q + 4);
            { auto r16 = __builtin_amdgcn_permlane16_swap(__float_as_uint(ss), __float_as_uint(ss), false, false); const unsigned a_ = r16[0], b_ = r16[1]; ss = __uint_as_float(a_) + __uint_as_float(b_); }
            { auto r32 = __builtin_amdgcn_permlane32_swap(__float_as_uint(ss), __float_as_uint(ss), false, false); const unsigned a_ = r32[0], b_ = r32[1]; ss = __uint_as_float(a_) + __uint_as_float(b_); }
            if (fq == 0) xch[(ai * HALF + wr * 64 + m * 16 + fr) * 4 + wc] = ss; }
#undef PG8_RLOAD
        asm volatile("s_waitcnt lgkmcnt(0)" ::: "memory"); __builtin_amdgcn_s_barrier(); asm volatile("" ::: "memory");
        { const int t = (wr * 4 + wc) * 64 + fq * 16 + fr;
          if (t < 256) { const f32x4 p = *(const PG8_LAS f32x4*)(xch + t * 4); ssp[((size_t)u.z * rows_per_z + (size_t)u.pm * BM + t) * 4 + u.pn] = (p[0] + p[1]) + (p[2] + p[3]); } }
    }
};
struct EpiSoftmax {
    static constexpr bool PERM = true, AFTER_DRAIN = false, PRE = true, PF = false;
    bf16_t* O; int ldc; size_t sO1; PG8_LAS float* xch; const float* ssp;
    int rows_per_z; PG8_LAS float* rsl;
    __device__ __forceinline__ void pre_issue(const Unit& u, int tid, int ui) const {
        if (tid < 256) __builtin_amdgcn_global_load_lds((const unsigned*)(ssp + ((size_t)u.z * rows_per_z + (size_t)u.pm * BM + tid) * 4), (PG8_LAS unsigned*)(rsl + (ui & 1) * 1024 + (tid >> 6) * 256), 16, 0, 0); }
    __device__ __forceinline__ void operator()(const f32x4 (&acc_)[2][2][4][2], const Unit& u, int wr, int wc, int fr, int fq, int ui) const {
        f32x4 (&acc)[2][2][4][2] = const_cast<f32x4 (&)[2][2][4][2]>(acc_);
#define PG8_XSWAP16(v) ({ auto r_ = __builtin_amdgcn_permlane16_swap(__float_as_uint(v), __float_as_uint(v), false, false); const unsigned a_ = r_[0], b_ = r_[1]; (a_ == __float_as_uint(v)) ? __uint_as_float(b_) : __uint_as_float(a_); })
#pragma unroll
        for (int ai = 0; ai < 2; ++ai)
#pragma unroll
            for (int m = 0; m < 4; ++m) {
                const f32x4 s4 = *(const PG8_LAS f32x4*)(rsl + (ui & 1) * 1024 + (ai * HALF + wr * 64 + m * 16 + fr) * 4);
                const float rsc = rsqrtf(((s4[0] + s4[1]) + (s4[2] + s4[3])) * (1.f / 1024.f) + 1e-6f);
                float c = -3.0e38f;
#pragma unroll
                for (int bj = 0; bj < 2; ++bj)
#pragma unroll
                    for (int n = 0; n < 2; ++n)
#pragma unroll
                        for (int e = 0; e < 4; ++e) { acc[ai][bj][m][n][e] *= rsc; c = fmaxf(c, acc[ai][bj][m][n][e]); }
                { auto r16 = __builtin_amdgcn_permlane16_swap(__float_as_uint(c), __float_as_uint(c), false, false); const unsigned a_ = r16[0], b_ = r16[1]; c = fmaxf(__uint_as_float(a_), __uint_as_float(b_)); }
                { auto r32 = __builtin_amdgcn_permlane32_swap(__float_as_uint(c), __float_as_uint(c), false, false); const unsigned a_ = r32[0], b_ = r32[1]; c = fmaxf(__uint_as_float(a_), __uint_as_float(b_)); }
                float s = 0.f;
#pragma unroll
                for (int bj = 0; bj < 2; ++bj)
#pragma unroll
                    for (int n = 0; n < 2; ++n)
#pragma unroll
                        for (int e = 0; e < 4; ++e) { const float p = __builtin_amdgcn_exp2f(acc[ai][bj][m][n][e] - c); acc[ai][bj][m][n][e] = p; s += p; }
                { auto r16 = __builtin_amdgcn_permlane16_swap(__float_as_uint(s), __float_as_uint(s), false, false); const unsigned a_ = r16[0], b_ = r16[1]; s = __uint_as_float(a_) + __uint_as_float(b_); }
                { auto r32 = __builtin_amdgcn_permlane32_swap(__float_as_uint(s), __float_as_uint(s), false, false); const unsigned a_ = r32[0], b_ = r32[1]; s = __uint_as_float(a_) + __uint_as_float(b_); }
                const int row = ai * HALF + wr * 64 + m * 16 + fr;
                if (fq == 0) { xch[(row * 4 + wc) * 2] = c; xch[(row * 4 + wc) * 2 + 1] = s; }
            }
#undef PG8_XSWAP16
        asm volatile("s_waitcnt lgkmcnt(0)" ::: "memory"); __builtin_amdgcn_s_barrier(); asm volatile("" ::: "memory");
        const int col0 = u.pn * BM + wc * 32 + 8 * fq;
        bf16_t* base = O + (size_t)u.z * sO1;
#pragma unroll
        for (int ai = 0; ai < 2; ++ai)
#pragma unroll
            for (int m = 0; m < 4; ++m) {
                const int row = ai * HALF + wr * 64 + m * 16 + fr;
                const f32x4 x0 = *(const PG8_LAS f32x4*)(xch + row * 8), x1 = *(const PG8_LAS f32x4*)(xch + row * 8 + 4);
                const float mx = fmaxf(fmaxf(x0[0], x0[2]), fmaxf(x1[0], x1[2]));
                const float tot = x0[1] * __builtin_amdgcn_exp2f(x0[0] - mx) + x0[3] * __builtin_amdgcn_exp2f(x0[2] - mx) + x1[1] * __builtin_amdgcn_exp2f(x1[0] - mx) + x1[3] * __builtin_amdgcn_exp2f(x1[2] - mx);
                const float cl = wc == 0 ? x0[0] : wc == 1 ? x0[2] : wc == 2 ? x1[0] : x1[2];
                const float f = __builtin_amdgcn_exp2f(cl - mx) * __builtin_amdgcn_rcpf(tot);
                bf16_t* rowp = base + (size_t)(u.pm * BM + row) * ldc + col0;
#pragma unroll
                for (int bj = 0; bj < 2; ++bj) { const f32x4 v0 = acc[ai][bj][m][0] * f, v1 = acc[ai][bj][m][1] * f;
                    u32x4 w; w.x = cvt_pk_bf16(v0[0], v0[1]); w.y = cvt_pk_bf16(v0[2], v0[3]); w.z = cvt_pk_bf16(v1[0], v1[1]); w.w = cvt_pk_bf16(v1[2], v1[3]);
                    *(u32x4*)(rowp + bj * HALF) = w; }
            }
    }
};
struct EpiLora {
    static constexpr bool PERM = true, AFTER_DRAIN = false, PRE = false, PF = false;
    unsigned char* ws; size_t off_dec, off_alpha, off_g; const float* w0; const float* a0;
    __device__ __forceinline__ void operator()(const f32x4 (&acc)[2][2][4][2], const Unit& u, int wr, int wc, int fr, int fq, int ui) const {
        const int kind = u.pn >> 1;
        const size_t off = off_dec + (size_t)(kind >= 1) * (off_alpha - off_dec) + (size_t)(kind >= 2) * (off_g - off_alpha);
        bf16_t* O = (bf16_t*)(ws + off);
        const float* bias = kind == 0 ? w0 : a0;
        const int row0 = u.pm * BM + wr * 64 + fr, col0 = (u.pn & 1) * BM + wc * 32 + 8 * fq;
        f32x4 bv[2][2];
#pragma unroll
        for (int bj = 0; bj < 2; ++bj)
#pragma unroll
            for (int n = 0; n < 2; ++n) bv[bj][n] = kind < 2 ? *(const f32x4*)(bias + col0 + bj * HALF + 4 * n) : (f32x4){0.f, 0.f, 0.f, 0.f};
        const float osc = kind == 0 ? 0.60653066f : 1.f;
#pragma unroll
        for (int ai = 0; ai < 2; ++ai)
#pragma unroll
            for (int m = 0; m < 4; ++m) { bf16_t* rowp = O + (size_t)(row0 + ai * HALF + m * 16) * 512 + col0;
#pragma unroll
                for (int bj = 0; bj < 2; ++bj) { f32x4 v0 = acc[ai][bj][m][0] + bv[bj][0], v1 = acc[ai][bj][m][1] + bv[bj][1];
                    if (kind < 2) {
#pragma unroll
                        for (int e = 0; e < 4; ++e) { v0[e] = osc * __builtin_amdgcn_rcpf(1.f + __builtin_amdgcn_exp2f(-1.4426950408889634f * v0[e])); v1[e] = osc * __builtin_amdgcn_rcpf(1.f + __builtin_amdgcn_exp2f(-1.4426950408889634f * v1[e])); } }
                    if (kind == 0) {
#pragma unroll
                        for (int e = 0; e < 4; ++e) { float a = -1.4426950408889634f * v0[e], b = -1.4426950408889634f * v1[e];
#define PG8_SHR(x, C) __builtin_bit_cast(float, __builtin_amdgcn_update_dpp(0, __builtin_bit_cast(int, x), C, 0xF, 0xF, true))
                            a += PG8_SHR(a, 0x111); a += PG8_SHR(a, 0x112); a += PG8_SHR(a, 0x114); a += PG8_SHR(a, 0x118);
                            b += PG8_SHR(b, 0x111); b += PG8_SHR(b, 0x112); b += PG8_SHR(b, 0x114); b += PG8_SHR(b, 0x118);
#undef PG8_SHR
                            v0[e] = a; v1[e] = b; }
                        typedef _Float16 h2_t __attribute__((ext_vector_type(2))); typedef float f2_t __attribute__((ext_vector_type(2)));
                        u32x4 w;
                        w.x = __builtin_bit_cast(unsigned, __builtin_convertvector((f2_t){v0[0], v0[1]}, h2_t)); w.y = __builtin_bit_cast(unsigned, __builtin_convertvector((f2_t){v0[2], v0[3]}, h2_t));
                        w.z = __builtin_bit_cast(unsigned, __builtin_convertvector((f2_t){v1[0], v1[1]}, h2_t)); w.w = __builtin_bit_cast(unsigned, __builtin_convertvector((f2_t){v1[2], v1[3]}, h2_t));
                        *(u32x4*)(rowp + bj * HALF) = w; continue; }
                    u32x4 w; w.x = cvt_pk_bf16(v0[0], v0[1]); w.y = cvt_pk_bf16(v0[2], v0[3]); w.z = cvt_pk_bf16(v1[0], v1[1]); w.w = cvt_pk_bf16(v1[2], v1[3]);
                    *(u32x4*)(rowp + bj * HALF) = w; } }
    }
};
template <class Epi, class Sched, bool ALIGN_EPI = false, bool SP2 = false>
__device__ __forceinline__ void gemm_phase(PG8_LAS unsigned char* lds, const Gemm g, const Sched& S, const Epi& E, const int tid) {
    const int wid = __builtin_amdgcn_readfirstlane(tid >> 6), lane = tid & 63, wr = wid >> 2, wc = wid & 3, fr = lane & 15, fq = lane >> 4;
    const int K = g.K, nt = K / BK;
    unsigned voffA[2], voffB[2];
#pragma unroll
    for (int i = 0; i < 2; ++i) { int R, C; stage_rc(tid * 16 + i * 8192, R, C); const int Rb = Epi::PERM ? ((R & ~31) + perm32(R & 31)) : R;
        voffA[i] = (unsigned)(R * g.lda + C) * 2u; voffB[i] = (unsigned)(Rb * g.ldb + C) * 2u; }
    const size_t kstep = (size_t)(BK * 2);
#define PG8_KR(ui_) (g.krev == 2 || ((PG8_KREV || g.krev == 1) && ((ui_) & 1)))
#define PG8_KS(ui_) (PG8_KR(ui_) ? -(int)(BK * 2) : (int)(BK * 2))
#define PG8_K0(ui_) (PG8_KR(ui_) ? (nt - 1) * (BK * 2) : 0)
    const size_t hstepA = (size_t)HALF * g.lda * 2, hstepB = (size_t)HALF * g.ldb * 2;
#define PG8_BASEA(u) ((const char*)g.A + ((size_t)((u).z / g.zdiv) * g.sA1 + (size_t)((u).z % g.zdiv) * g.sA2) * 2 + (size_t)(u).pm * 2 * hstepA)
#define PG8_BASEB(u) ((const char*)g.Bt + ((size_t)((u).z / g.zdiv) * g.sB1 + (size_t)((u).z % g.zdiv) * g.sB2) * 2 + (size_t)(u).pn * 2 * hstepB)
    const unsigned ldsw = (unsigned)wid * 1024u;
    const int aoff = lds_byte(wr * 64 + fr, fq * 8), boff = lds_byte(wc * 32 + fr, fq * 8);
#define PG8_SA(b, h) (((b) * 2 + (h)) * HTB)
#define PG8_SB(b, h) ((4 + (b) * 2 + (h)) * HTB)
#define PG8_STAGE(bufoff, gbase, voff) do { _Pragma("unroll") for (int _i = 0; _i < 2; ++_i) \
        __builtin_amdgcn_global_load_lds((const unsigned*)((const char*)(gbase) + (voff)[_i]), (PG8_LAS unsigned*)(lds + (bufoff) + ldsw + _i * 8192), 16, 0, 0); } while (0)
#define PG8_LDA(dst, b, h) do { _Pragma("unroll") for (int m = 0; m < 4; ++m) _Pragma("unroll") for (int k = 0; k < 2; ++k) dst[m][k] = *(const PG8_LAS bf16x8*)(lds + PG8_SA(b, h) + aoff + m * 2048 + k * 1024); } while (0)
#define PG8_LDB(dst, b, h) do { _Pragma("unroll") for (int n = 0; n < 2; ++n) _Pragma("unroll") for (int k = 0; k < 2; ++k) dst[n][k] = *(const PG8_LAS bf16x8*)(lds + PG8_SB(b, h) + boff + n * 2048 + k * 1024); } while (0)
#define PG8_MMA(ai, bj, At, Bt) do { __builtin_amdgcn_s_setprio(1); _Pragma("unroll") for (int m = 0; m < 4; ++m) _Pragma("unroll") for (int n = 0; n < 2; ++n) _Pragma("unroll") for (int k = 0; k < 2; ++k) \
        acc[ai][bj][m][n] = __builtin_amdgcn_mfma_f32_16x16x32_bf16(Bt[n][k], At[m][k], acc[ai][bj][m][n], 0, 0, 0); __builtin_amdgcn_s_setprio(0); } while (0)
#define PG8_WAIT_V(n) asm volatile("s_waitcnt vmcnt(" #n ")" ::: "memory")
#define PG8_WAIT_L(n) asm volatile("s_waitcnt lgkmcnt(" #n ")" ::: "memory")
#define PG8_BAR __builtin_amdgcn_s_barrier()
#define PG8_SCHED __builtin_amdgcn_sched_barrier(0)
    Unit cur, nxt; int ui = 0;
    if (!S.next(0, cur)) return;
    f32x4 acc[2][2][4][2];
#pragma unroll
    for (int a = 0; a < 2; ++a)
#pragma unroll
        for (int b = 0; b < 2; ++b)
#pragma unroll
            for (int m = 0; m < 4; ++m)
#pragma unroll
                for (int n = 0; n < 2; ++n) acc[a][b][m][n] = (f32x4){0.f, 0.f, 0.f, 0.f};
    bf16x8 At[4][2], B0[2][2], B1[2][2];
    const char* cA = PG8_BASEA(cur) + PG8_K0(0); const char* cB = PG8_BASEB(cur) + PG8_K0(0); int ksc = PG8_KS(0);
    S.a_ready(cur);
    if constexpr (SP2) {
        PG8_STAGE(PG8_SB(0, 0), cB, voffB); PG8_STAGE(PG8_SB(0, 1), cB + hstepB, voffB); PG8_STAGE(PG8_SA(0, 0), cA, voffA); PG8_STAGE(PG8_SA(0, 1), cA + hstepA, voffA);
        if (wr == 1) PG8_BAR;
        PG8_WAIT_V(2); PG8_BAR;
        PG8_STAGE(PG8_SB(1, 0), cB + ksc, voffB); PG8_STAGE(PG8_SA(1, 0), cA + ksc, voffA); PG8_STAGE(PG8_SB(1, 1), cB + hstepB + ksc, voffB);
        PG8_WAIT_V(6); PG8_BAR;
    } else {
        PG8_STAGE(PG8_SB(0, 0), cB, voffB); PG8_STAGE(PG8_SA(0, 0), cA, voffA); PG8_STAGE(PG8_SB(0, 1), cB + hstepB, voffB); PG8_STAGE(PG8_SA(0, 1), cA + hstepA, voffA);
        if (wr == 1) PG8_BAR;
        PG8_WAIT_V(4); PG8_BAR;
        PG8_STAGE(PG8_SB(1, 0), cB + ksc, voffB); PG8_STAGE(PG8_SA(1, 0), cA + ksc, voffA); PG8_STAGE(PG8_SB(1, 1), cB + hstepB + ksc, voffB);
        PG8_WAIT_V(6); PG8_BAR;
    }
    for (;;) {
        const bool has_next = S.next(ui + 1, nxt);
        const char* nA = has_next ? PG8_BASEA(nxt) + PG8_K0(ui + 1) : cA; const char* nB = has_next ? PG8_BASEB(nxt) + PG8_K0(ui + 1) : cB; const int ksn = has_next ? PG8_KS(ui + 1) : ksc;
        if constexpr (Epi::PRE) { static_assert(SP2, "PRE epilogues ride on the SP2 wait pattern"); E.pre_issue(cur, tid, ui); }
        for (int t = 0; t < nt; t += 2) {
            const bool last = (t == nt - 2);
            if constexpr (Epi::PF) { if (t == nt - Epi::PF_LEAD) E.prefetch(cur, tid); }
            const char* a1 = cA + (t + 1) * ksc;
            const char* a2 = last ? nA : cA + (t + 2) * ksc; const char* b2 = last ? nB : cB + (t + 2) * ksc;
            const int ks3 = last ? ksn : ksc; const char* a3 = a2 + ks3; const char* b3 = b2 + ks3;
            if (last && has_next) S.a_ready(nxt);
            if constexpr (SP2) {
            PG8_LDB(B0, 0, 0); PG8_LDB(B1, 0, 1); PG8_SCHED; PG8_LDA(At, 0, 0); PG8_STAGE(PG8_SA(1, 1), a1 + hstepA, voffA);
            PG8_WAIT_V(8); PG8_WAIT_L(0); PG8_BAR; PG8_MMA(0, 0, At, B0); PG8_MMA(0, 1, At, B1); PG8_BAR; PG8_SCHED;
            PG8_LDA(At, 0, 1); PG8_STAGE(PG8_SB(0, 0), b2, voffB); PG8_STAGE(PG8_SB(0, 1), b2 + hstepB, voffB); PG8_STAGE(PG8_SA(0, 0), a2, voffA);
            PG8_WAIT_V(8); PG8_WAIT_L(0); PG8_BAR; PG8_MMA(1, 0, At, B0); PG8_MMA(1, 1, At, B1); PG8_BAR; PG8_SCHED;
            PG8_LDB(B0, 1, 0); PG8_LDB(B1, 1, 1); PG8_SCHED; PG8_LDA(At, 1, 0); PG8_STAGE(PG8_SA(0, 1), a2 + hstepA, voffA);
            PG8_WAIT_V(8); PG8_WAIT_L(0); PG8_BAR; PG8_MMA(0, 0, At, B0); PG8_MMA(0, 1, At, B1); PG8_BAR; PG8_SCHED;
            PG8_LDA(At, 1, 1); PG8_STAGE(PG8_SB(1, 0), b3, voffB); PG8_STAGE(PG8_SB(1, 1), b3 + hstepB, voffB); PG8_STAGE(PG8_SA(1, 0), a3, voffA);
            PG8_WAIT_V(8); PG8_WAIT_L(0); PG8_BAR; PG8_MMA(1, 0, At, B0); PG8_MMA(1, 1, At, B1); PG8_BAR; PG8_SCHED;
            } else {
            PG8_LDB(B0, 0, 0); PG8_SCHED; PG8_LDA(At, 0, 0); PG8_STAGE(PG8_SA(1, 1), a1 + hstepA, voffA);
            PG8_WAIT_L(8); PG8_BAR; PG8_WAIT_L(0); PG8_MMA(0, 0, At, B0); PG8_BAR; PG8_SCHED;
            PG8_LDB(B1, 0, 1); PG8_STAGE(PG8_SB(0, 0), b2, voffB);
            PG8_BAR; PG8_WAIT_L(0); PG8_MMA(0, 1, At, B1); PG8_BAR;
            PG8_LDA(At, 0, 1); PG8_STAGE(PG8_SA(0, 0), a2, voffA);
            PG8_BAR; PG8_WAIT_L(0); PG8_MMA(1, 0, At, B0); PG8_BAR; PG8_SCHED;
            PG8_STAGE(PG8_SB(0, 1), b2 + hstepB, voffB);
            PG8_WAIT_V(6); PG8_BAR; PG8_MMA(1, 1, At, B1); PG8_BAR;
            PG8_LDB(B0, 1, 0); PG8_SCHED; PG8_LDA(At, 1, 0); PG8_STAGE(PG8_SA(0, 1), a2 + hstepA, voffA);
            PG8_WAIT_L(8); PG8_BAR; PG8_WAIT_L(0); PG8_MMA(0, 0, At, B0); PG8_BAR; PG8_SCHED;
            PG8_LDB(B1, 1, 1); PG8_STAGE(PG8_SB(1, 0), b3, voffB);
            PG8_BAR; PG8_WAIT_L(0); PG8_MMA(0, 1, At, B1); PG8_BAR;
            PG8_LDA(At, 1, 1); PG8_STAGE(PG8_SA(1, 0), a3, voffA);
            PG8_BAR; PG8_WAIT_L(0); PG8_MMA(1, 0, At, B0); PG8_BAR; PG8_SCHED;
            PG8_STAGE(PG8_SB(1, 1), b3 + hstepB, voffB);
            PG8_WAIT_V(6); PG8_BAR; PG8_MMA(1, 1, At, B1); PG8_BAR;
            }
        }
        if constexpr (ALIGN_EPI) { if (wr == 0) PG8_BAR; }
        if constexpr (!Epi::AFTER_DRAIN) { E(acc, cur, wr, wc, fr, fq, ui); S.done(cur); }
        if (!has_next) break;
#pragma unroll
        for (int a = 0; a < 2; ++a)
#pragma unroll
            for (int b = 0; b < 2; ++b)
#pragma unroll
                for (int m = 0; m < 4; ++m)
#pragma unroll
                    for (int n = 0; n < 2; ++n) acc[a][b][m][n] = (f32x4){0.f, 0.f, 0.f, 0.f};
        cur = nxt; cA = nA; cB = nB; ksc = ksn; ++ui;
        if constexpr (ALIGN_EPI) { if (wr == 1) PG8_BAR; }
    }
    PG8_WAIT_V(0);
    if constexpr (!ALIGN_EPI) { if (wr == 0) PG8_BAR; }
    PG8_BAR;
    if constexpr (Epi::AFTER_DRAIN) { E.fused(acc, cur, wr, wc, fr, fq, lds, wid, lane); S.done(cur); }
#undef PG8_KS
#undef PG8_KR
#undef PG8_K0
#undef PG8_BASEA
#undef PG8_BASEB
#undef PG8_SA
#undef PG8_SB
#undef PG8_STAGE
#undef PG8_LDA
#undef PG8_LDB
#undef PG8_MMA
#undef PG8_WAIT_V
#undef PG8_WAIT_L
#undef PG8_BAR
#undef PG8_SCHED
}
}
#ifndef PG8_SP2
#define PG8_SP2 true
#endif
#ifndef PG8_ALIGN
#define PG8_ALIGN true
#endif

constexpr int BATCH = 8, SEQ = 4096, DM = 1024, NTOK = BATCH * SEQ, NMEM = 256, MROWS = BATCH * NMEM, DFF = 4096;
constexpr int HYB = 3840, QKVW = 3072;
constexpr int NWAVES = 8;
constexpr int PH_PER_LAYER = 13, PH_FINAL = 52, PH_TOTAL = 53;
#ifndef MK_ONE_LAUNCH
#define MK_ONE_LAUNCH 1
#endif

constexpr size_t MiB = 1u << 20;
constexpr size_t WS_CTL = 0, CTL_ZERO_BYTES = 1 * MiB;
constexpr size_t WS_MEMN = 1 * MiB;
constexpr size_t WS_KV = 8 * MiB;
constexpr size_t WS_W = 16 * MiB;
constexpr size_t WS_HN = 50 * MiB;
constexpr size_t WS_BIG = 114 * MiB;
constexpr size_t WS_LW = 5 * MiB;
constexpr size_t WS_ROT = 6 * MiB;
constexpr size_t WS_BONUS = 7 * MiB;
constexpr size_t WS_XL = WS_BIG + 240 * MiB;
constexpr size_t WS_DEC = 370 * MiB;
constexpr size_t WS_ALPHA = 434 * MiB;
constexpr size_t WS_G = 466 * MiB;
constexpr size_t WS_WQK = WS_DEC;
constexpr size_t WS_VWO = WS_DEC + 16 * MiB;
constexpr size_t WS_SSP = 498 * MiB;
constexpr size_t WS_HB2 = WS_BIG + 64 * MiB;
constexpr size_t WS_WKV2 = WS_DEC + 32 * MiB;
constexpr size_t WS_KV2 = WS_DEC + 36 * MiB;
constexpr size_t WS_END = 500 * MiB;
constexpr size_t WO_IN = 0, WO_OUT = WO_IN + (size_t)3840 * 1024, WO_Q = WO_OUT + (size_t)1024 * 1024, WO_KV = WO_Q + (size_t)1024 * 1024, WO_O = WO_KV + (size_t)2048 * 1024,
                 WO_1 = WO_O + (size_t)1024 * 1024, WO_2 = WO_1 + (size_t)4096 * 1024, WO_END = WO_2 + (size_t)4096 * 1024;
static_assert(WS_W + WO_END * 2 <= WS_HN, "weights fit");
constexpr int CW_BAR = 4096;

constexpr int RING_BYTES = 131072, LDSCTL_OFF = RING_BYTES, MISC_OFF = LDSCTL_OFF + 320, XCH_OFF = 135168, LDS_BYTES = 151552;

#define GAS __attribute__((address_space(1)))
#define LAS __attribute__((address_space(3)))
typedef unsigned short bf16;
typedef unsigned v4u __attribute__((ext_vector_type(4)));
typedef unsigned v2u __attribute__((ext_vector_type(2)));
typedef float f32x4 __attribute__((ext_vector_type(4)));
#define LDS_WAIT() asm volatile("s_waitcnt lgkmcnt(0)" ::: "memory")
__device__ __forceinline__ unsigned f2bf(float f) { unsigned u = __builtin_bit_cast(unsigned, f); return (u + 0x7fffu + ((u >> 16) & 1u)) >> 16; }
typedef float cf32x2_t __attribute__((ext_vector_type(2))); typedef __bf16 cbf16x2_t __attribute__((ext_vector_type(2)));
__device__ __forceinline__ unsigned pk2(float lo, float hi) { cf32x2_t v = {lo, hi}; cbf16x2_t b = __builtin_convertvector(v, cbf16x2_t); return __builtin_bit_cast(unsigned, b); }
__device__ __forceinline__ float bf2f(unsigned v) { return __builtin_bit_cast(float, v << 16); }
template <int CTRL> __device__ __forceinline__ float cdpp0(float v) { return __builtin_bit_cast(float, __builtin_amdgcn_update_dpp(0, __builtin_bit_cast(int, v), CTRL, 0xF, 0xF, true)); }
__device__ __forceinline__ float wave_sum(float x) {
    x += cdpp0<0xB1>(x); x += cdpp0<0x4E>(x); x += cdpp0<0x141>(x); x += cdpp0<0x140>(x);
    { auto r = __builtin_amdgcn_permlane16_swap(__float_as_uint(x), __float_as_uint(x), false, false); const unsigned a_ = r[0], b_ = r[1]; x = __uint_as_float(a_) + __uint_as_float(b_); }
    { auto r = __builtin_amdgcn_permlane32_swap(__float_as_uint(x), __float_as_uint(x), false, false); const unsigned a_ = r[0], b_ = r[1]; x = __uint_as_float(a_) + __uint_as_float(b_); }
    return x; }
template <int CTRL> __device__ __forceinline__ float cdpp(float v) { return __builtin_bit_cast(float, __builtin_amdgcn_update_dpp(0, __builtin_bit_cast(int, v), CTRL, 0xF, 0xF, true)); }
__device__ __forceinline__ float wave_sum_dpp(float x) {
    x += cdpp<0xB1>(x); x += cdpp<0x4E>(x); x += cdpp<0x141>(x); x += cdpp<0x140>(x);
    { auto r = __builtin_amdgcn_permlane16_swap(__float_as_uint(x), __float_as_uint(x), false, false); const unsigned a_ = r[0], b_ = r[1]; x = __uint_as_float(a_) + __uint_as_float(b_); }
    { auto r = __builtin_amdgcn_permlane32_swap(__float_as_uint(x), __float_as_uint(x), false, false); const unsigned a_ = r[0], b_ = r[1]; x = __uint_as_float(a_) + __uint_as_float(b_); }
    return x; }
__device__ __forceinline__ float rl(float v, int l) { return __builtin_bit_cast(float, __builtin_amdgcn_readlane(__builtin_bit_cast(int, v), l)); }
__device__ __forceinline__ float wave_max(float v) {
#pragma unroll
    for (int o = 1; o < 64; o <<= 1) v = fmaxf(v, __shfl_xor(v, o));
    return v;
}

#define XB_TMO      128
#define XB_XCNT(j)  (256  + 64 * (j))
#define XB_XSUB(j)  (1280 + 64 * (j))
#define XB_XGEN(j)  (2304 + 64 * (j))
#define XB_TOP      3328
#define XB_TOPGEN   3392
#define XCD_BAR_WORDS 3456
#define XB_SPIN_CAP (1u << 18)
__device__ __forceinline__ unsigned xb_ld(unsigned* p)              { return __hip_atomic_load(p, __ATOMIC_RELAXED, __HIP_MEMORY_SCOPE_AGENT); }
__device__ __forceinline__ unsigned xb_add(unsigned* p, unsigned v) { return __hip_atomic_fetch_add(p, v, __ATOMIC_RELAXED, __HIP_MEMORY_SCOPE_AGENT); }
__device__ __forceinline__ unsigned xb_xcc_id() { return (unsigned)__builtin_amdgcn_s_getreg((3 << 11) | 20) & 0xFu; }
#define XB_SPIN(cond, bar) do { unsigned _sp = 0; while (cond) { __builtin_amdgcn_s_sleep(1); \
    if ((++_sp & 255u) == 0u) { if (xb_ld(&(bar)[XB_TMO])) break; if (_sp > XB_SPIN_CAP) { atomicAdd(&(bar)[XB_TMO], 1u); break; } } } } while (0)
struct XcdBarrier { unsigned* bar; unsigned x; volatile LAS unsigned* st; };
__device__ __forceinline__ XcdBarrier xcd_barrier_post(unsigned* bar, volatile LAS unsigned* st) {
    XcdBarrier b; b.bar = bar; b.x = xb_xcc_id(); b.st = st;
    if (threadIdx.x == 0) (void)xb_add(&bar[XB_XCNT(b.x)], 1u);
    return b;
}
__device__ __forceinline__ void xcd_barrier_complete(unsigned* bar, unsigned x, unsigned& nloc, unsigned& nx) {
    const unsigned G = gridDim.x * gridDim.y * gridDim.z;
    unsigned sum, cnt, mine, sp = 0u;
    for (;;) {
        sum = 0u; cnt = 0u; mine = 0u;
#pragma unroll
        for (unsigned j = 0; j < 16; ++j) { const unsigned c = xb_ld(&bar[XB_XCNT(j)]); sum += c; cnt += (c > 0u) ? 1u : 0u; mine = (j == x) ? c : mine; }
        if (sum == G) break;
        __builtin_amdgcn_s_sleep(1);
        if ((++sp & 255u) == 0u) { if (xb_ld(&bar[XB_TMO])) break; if (sp > XB_SPIN_CAP) { atomicAdd(&bar[XB_TMO], 1u); break; } }
    }
    nloc = mine > 0u ? mine : 1u; nx = cnt > 0u ? cnt : 1u;
}
__device__ __forceinline__ void xcd_barrier(const XcdBarrier& b, int wave0_ = -1) {
    asm volatile("s_waitcnt vmcnt(0)" ::: "memory");
    __syncthreads();
    bool leader_;
    if (wave0_ < 0) leader_ = threadIdx.x == 0;
    else { int l_; asm volatile("v_mbcnt_lo_u32_b32 %0, -1, 0\n\tv_mbcnt_hi_u32_b32 %0, -1, %0" : "=v"(l_)); leader_ = (wave0_ == 0) && (l_ == 0); }
    if (leader_) {
        unsigned* bar = b.bar;
        __builtin_amdgcn_s_waitcnt(0);
        unsigned nloc = b.st[0], nx = b.st[1];
        if (nloc == 0u) { xcd_barrier_complete(bar, b.x, nloc, nx); b.st[0] = nloc; b.st[1] = nx; }
        const unsigned old = xb_add(&bar[XB_XSUB(b.x)], 1u);
        const unsigned gen = old / nloc;
        if (old + 1u == (gen + 1u) * nloc) {
            __builtin_amdgcn_fence(__ATOMIC_RELEASE, "agent");
            asm volatile("s_waitcnt vmcnt(0)" ::: "memory");
            const unsigned og = xb_add(&bar[XB_TOP], 1u);
            const unsigned tg = og / nx;
            if (og + 1u == (tg + 1u) * nx) xb_add(&bar[XB_TOPGEN], 1u);
            else XB_SPIN(xb_ld(&bar[XB_TOPGEN]) == tg, bar);
            __builtin_amdgcn_fence(__ATOMIC_ACQUIRE, "agent");
            xb_add(&bar[XB_XGEN(b.x)], 1u);
            asm volatile("s_waitcnt vmcnt(0)" ::: "memory");
        } else {
            XB_SPIN(xb_ld(&bar[XB_XGEN(b.x)]) == gen, bar);
            __builtin_amdgcn_fence(__ATOMIC_ACQUIRE, "agent");
            asm volatile("s_waitcnt vmcnt(0)" ::: "memory");
        }
    }
    __syncthreads();
}

__device__ __forceinline__ void grp_barrier(unsigned* cnt, unsigned members, unsigned& gen, unsigned* tmo) {
    asm volatile("s_waitcnt vmcnt(0)" ::: "memory");
    __syncthreads();
    ++gen;
    if (threadIdx.x == 0) {
        __builtin_amdgcn_fence(__ATOMIC_RELEASE, "agent");
        asm volatile("s_waitcnt vmcnt(0)" ::: "memory");
        (void)xb_add(cnt, 1u);
        const unsigned target = gen * members; unsigned sp = 0u;
        while (xb_ld(cnt) < target) { __builtin_amdgcn_s_sleep(1); if ((++sp & 255u) == 0u) { if (xb_ld(tmo)) break; if (sp > XB_SPIN_CAP) { atomicAdd(tmo, 1u); break; } } }
        __builtin_amdgcn_fence(__ATOMIC_ACQUIRE, "agent");
        asm volatile("s_waitcnt vmcnt(0)" ::: "memory");
    }
    __syncthreads();
}

__device__ __forceinline__ void transpose_item(const float* W, int K, int N, bf16* WT, LAS float* scr, int item, int lane, const float* ks) {
    const int nblk = N / 32, kb = item / nblk, nb = item % nblk, k0 = 64 * kb, n0 = 32 * nb;
    f32x4 wv[8];
#pragma unroll
    for (int i = 0; i < 8; ++i) wv[i] = __builtin_nontemporal_load((const f32x4*)(W + (size_t)(k0 + 8 * i + (lane >> 3)) * N + n0 + 4 * (lane & 7)));
#pragma unroll
    for (int i = 0; i < 8; ++i) { const int kk = 8 * i + (lane >> 3); const float g_ = ks ? ks[k0 + kk] : 1.f; LAS float* d_ = scr + kk * 33 + 4 * (lane & 7);
        d_[0] = wv[i].x * g_; d_[1] = wv[i].y * g_; d_[2] = wv[i].z * g_; d_[3] = wv[i].w * g_; }
    LDS_WAIT(); asm volatile("" ::: "memory");
    const int c = lane & 7;
#pragma unroll
    for (int j = 0; j < 4; ++j) { const int n = (lane >> 3) + 8 * j; const LAS float* s = scr + (8 * c) * 33 + n;
        v4u o; o.x = pk2(s[0 * 33], s[1 * 33]); o.y = pk2(s[2 * 33], s[3 * 33]); o.z = pk2(s[4 * 33], s[5 * 33]); o.w = pk2(s[6 * 33], s[7 * 33]);
        *(GAS v4u*)(WT + (size_t)(n0 + n) * K + k0 + 8 * c) = o; }
    LDS_WAIT(); asm volatile("" ::: "memory");
}
__device__ __forceinline__ void rms_row_to_bf16(const float* xrow, const float* w, bf16* orow, int lane) {
    const f32x4* xr = (const f32x4*)xrow + lane; const f32x4* wr = (const f32x4*)w + lane;
    f32x4 v[4]; float s = 0.f;
#pragma unroll
    for (int j = 0; j < 4; ++j) { v[j] = xr[64 * j]; s += (v[j].x * v[j].x + v[j].y * v[j].y) + (v[j].z * v[j].z + v[j].w * v[j].w); }
    const float rstd = rsqrtf(wave_sum(s) * (1.f / 1024.f) + 1e-6f);
    unsigned long long* o8 = (unsigned long long*)orow + lane;
#pragma unroll
    for (int j = 0; j < 4; ++j) { const f32x4 wv = wr[64 * j]; const f32x4 o = v[j] * rstd * wv;
        o8[64 * j] = (unsigned long long)pk2(o.x, o.y) | ((unsigned long long)pk2(o.z, o.w) << 32); }
}
__device__ __forceinline__ void row_to_bf16_ss(const float* xrow, bf16* orow, float* ssp4, int lane) {
    const f32x4* xr = (const f32x4*)xrow + lane; float s = 0.f; unsigned long long* o8 = (unsigned long long*)orow + lane;
#pragma unroll
    for (int j = 0; j < 4; ++j) { const f32x4 v = xr[64 * j]; s += (v.x * v.x + v.y * v.y) + (v.z * v.z + v.w * v.w); o8[64 * j] = (unsigned long long)pk2(v.x, v.y) | ((unsigned long long)pk2(v.z, v.w) << 32); }
    s = wave_sum(s); if (lane < 4) ssp4[lane] = lane == 0 ? s : 0.f;
}
__device__ __forceinline__ void rows4_to_bf16_ss(const float* x, bf16* U, float* ssp, int m, int st, int nrows, int lane) {
    f32x4 v[4][4];
#pragma unroll
    for (int r = 0; r < 4; ++r) { const int row = m + r * st; const f32x4* xr = (const f32x4*)(x + (size_t)(row < nrows ? row : m) * 1024) + lane;
#pragma unroll
        for (int j = 0; j < 4; ++j) v[r][j] = xr[64 * j]; }
#pragma unroll
    for (int r = 0; r < 4; ++r) { const int row = m + r * st; if (row < nrows) { float s = 0.f; unsigned long long* o8 = (unsigned long long*)(U + (size_t)row * 1024) + lane;
#pragma unroll
        for (int j = 0; j < 4; ++j) { const f32x4 q = v[r][j]; s += (q.x * q.x + q.y * q.y) + (q.z * q.z + q.w * q.w); o8[64 * j] = (unsigned long long)pk2(q.x, q.y) | ((unsigned long long)pk2(q.z, q.w) << 32); }
        s = wave_sum_dpp(s); if (lane < 4) ssp[(size_t)row * 4 + lane] = lane == 0 ? s : 0.f; } }
}
__device__ __forceinline__ void rows4_bf16_to_f32_norm(const bf16* H, const float* w, float* out, int m, int st, int nrows, int lane) {
    v4u q[4][2];
#pragma unroll
    for (int r = 0; r < 4; ++r) { const int row = m + r * st; const bf16* hr = H + (size_t)(row < nrows ? row : m) * 1024;
#pragma unroll
        for (int j = 0; j < 2; ++j) q[r][j] = *(const v4u*)(hr + j * 512 + lane * 8); }
    f32x4 wv[2][2];
#pragma unroll
    for (int j = 0; j < 2; ++j) { wv[j][0] = *(const f32x4*)(w + j * 512 + lane * 8); wv[j][1] = *(const f32x4*)(w + j * 512 + lane * 8 + 4); }
#pragma unroll
    for (int r = 0; r < 4; ++r) { const int row = m + r * st; if (row < nrows) { float v[2][8]; float s = 0.f;
#pragma unroll
        for (int j = 0; j < 2; ++j) { const v4u t = q[r][j];
            v[j][0] = __uint_as_float(t.x << 16); v[j][1] = __uint_as_float(t.x & 0xffff0000u); v[j][2] = __uint_as_float(t.y << 16); v[j][3] = __uint_as_float(t.y & 0xffff0000u);
            v[j][4] = __uint_as_float(t.z << 16); v[j][5] = __uint_as_float(t.z & 0xffff0000u); v[j][6] = __uint_as_float(t.w << 16); v[j][7] = __uint_as_float(t.w & 0xffff0000u);
#pragma unroll
            for (int e = 0; e < 8; ++e) s += v[j][e] * v[j][e]; }
        const float rstd = rsqrtf(wave_sum_dpp(s) * (1.f / 1024.f) + 1e-6f); float* orow = out + (size_t)row * 1024;
#pragma unroll
        for (int j = 0; j < 2; ++j) { f32x4 o0, o1; o0.x = v[j][0] * rstd * wv[j][0].x; o0.y = v[j][1] * rstd * wv[j][0].y; o0.z = v[j][2] * rstd * wv[j][0].z; o0.w = v[j][3] * rstd * wv[j][0].w;
            o1.x = v[j][4] * rstd * wv[j][1].x; o1.y = v[j][5] * rstd * wv[j][1].y; o1.z = v[j][6] * rstd * wv[j][1].z; o1.w = v[j][7] * rstd * wv[j][1].w;
            *(f32x4*)(orow + j * 512 + lane * 8) = o0; *(f32x4*)(orow + j * 512 + lane * 8 + 4) = o1; } } }
}
__device__ __forceinline__ void rms_row_bf16_to_f32(const bf16* hrow, const float* w, float* orow, int lane) {
    float v[2][8]; float s = 0.f;
#pragma unroll
    for (int j = 0; j < 2; ++j) { const v4u q = *(const v4u*)(hrow + j * 512 + lane * 8);
        v[j][0] = __uint_as_float(q.x << 16); v[j][1] = __uint_as_float(q.x & 0xffff0000u); v[j][2] = __uint_as_float(q.y << 16); v[j][3] = __uint_as_float(q.y & 0xffff0000u);
        v[j][4] = __uint_as_float(q.z << 16); v[j][5] = __uint_as_float(q.z & 0xffff0000u); v[j][6] = __uint_as_float(q.w << 16); v[j][7] = __uint_as_float(q.w & 0xffff0000u);
#pragma unroll
        for (int e = 0; e < 8; ++e) s += v[j][e] * v[j][e]; }
    const float rstd = rsqrtf(wave_sum(s) * (1.f / 1024.f) + 1e-6f);
#pragma unroll
    for (int j = 0; j < 2; ++j) { const f32x4 w0 = *(const f32x4*)(w + j * 512 + lane * 8), w1 = *(const f32x4*)(w + j * 512 + lane * 8 + 4);
        f32x4 o0, o1; o0.x = v[j][0] * rstd * w0.x; o0.y = v[j][1] * rstd * w0.y; o0.z = v[j][2] * rstd * w0.z; o0.w = v[j][3] * rstd * w0.w;
        o1.x = v[j][4] * rstd * w1.x; o1.y = v[j][5] * rstd * w1.y; o1.z = v[j][6] * rstd * w1.z; o1.w = v[j][7] * rstd * w1.w;
        *(f32x4*)(orow + j * 512 + lane * 8) = o0; *(f32x4*)(orow + j * 512 + lane * 8 + 4) = o1; }
}
__device__ __forceinline__ void rms_row_inplace(float* xrow, const float* w, int lane) {
    f32x4* xr = (f32x4*)xrow + lane; const f32x4* wr = (const f32x4*)w + lane;
    f32x4 v[4]; float s = 0.f;
#pragma unroll
    for (int j = 0; j < 4; ++j) { v[j] = xr[64 * j]; s += (v[j].x * v[j].x + v[j].y * v[j].y) + (v[j].z * v[j].z + v[j].w * v[j].w); }
    const float rstd = rsqrtf(wave_sum(s) * (1.f / 1024.f) + 1e-6f);
#pragma unroll
    for (int j = 0; j < 4; ++j) { const f32x4 wv = wr[64 * j]; xr[64 * j] = v[j] * rstd * wv; }
}

namespace dattn {
typedef short bf16x8 __attribute__((ext_vector_type(8)));
typedef short s16x4 __attribute__((ext_vector_type(4)));
typedef float f32x16 __attribute__((ext_vector_type(16)));
typedef unsigned u32x4 __attribute__((ext_vector_type(4)));
typedef short v4i16_t __attribute__((ext_vector_type(4)));
typedef __attribute__((address_space(3))) const char* lds_cptr;
constexpr int PITCH = 3072, QB = 128, KVBLK = 64, SEQL = 4096;
constexpr int TBX = 392;
constexpr int SLOTB = 16384, LDS_K = 0, LDS_V = 3 * SLOTB, LDS_WS = 6 * SLOTB, LDS_TBL = LDS_WS + 8 * 256, LDS_END = LDS_TBL + 4 * TBX * 4;
constexpr int STG_F = 0, STG_B = 65536;
constexpr float C2 = 0.125f * 1.4426950408889634f;
constexpr int THRL = 8;
#define DA_SBAR() __builtin_amdgcn_sched_barrier(0)
#define DA_WAIT_BAR(N) asm volatile("s_waitcnt vmcnt(" #N ") lgkmcnt(0)\n\ts_barrier" ::: "memory")
#define DA_MFMA(a, b, c) __builtin_amdgcn_mfma_f32_32x32x16_bf16(a, b, c, 0, 0, 0)
__device__ __forceinline__ int crow(int r, int hi) { return (r & 3) + 8 * (r >> 2) + 4 * hi; }
__device__ __forceinline__ void glds16x2(const void* g0, const void* g1, unsigned d0, unsigned d1) {
    asm volatile("s_mov_b32 m0, %2\n\ts_nop 0\n\tglobal_load_lds_dwordx4 %0, off\n\ts_mov_b32 m0, %3\n\ts_nop 0\n\tglobal_load_lds_dwordx4 %1, off" :: "v"(g0), "v"(g1), "s"(d0), "s"(d1) : "memory", "m0"); }
__device__ __forceinline__ void glds16(const void* gsrc, unsigned lds_dst) { unsigned keep;
    asm volatile("s_mov_b32 %0, m0\n\ts_mov_b32 m0, %2\n\ts_nop 0\n\tglobal_load_lds_dwordx4 %1, off\n\ts_mov_b32 m0, %0" : "=&s"(keep) : "v"(gsrc), "s"(lds_dst) : "memory"); }
typedef float f32x2_t __attribute__((ext_vector_type(2))); typedef __bf16 bf16x2_t __attribute__((ext_vector_type(2)));
__device__ __forceinline__ unsigned cvtpk(float lo, float hi) { f32x2_t v = {lo, hi}; bf16x2_t b = __builtin_convertvector(v, bf16x2_t); return __builtin_bit_cast(unsigned, b); }
__device__ __forceinline__ void kload2(bf16x8* kf, lds_cptr kp, int j) { kf[2 * j] = *(const __attribute__((address_space(3))) bf16x8*)(kp + j * 2048); kf[2 * j + 1] = *(const __attribute__((address_space(3))) bf16x8*)(kp + j * 2048 + 512); }
__device__ __forceinline__ s16x4 vtr(lds_cptr p) { return __builtin_bit_cast(s16x4, __builtin_amdgcn_ds_read_tr16_b64_v4i16((__attribute__((address_space(3))) v4i16_t*)p)); }
#define DA_MX3(a, b, c) __builtin_fmaxf(__builtin_fmaxf((a), (b)), (c))
__device__ __forceinline__ float rowmax(const f32x16& p0, const f32x16& p1) {
    float a = DA_MX3(p0[0], p0[1], p1[0]), b = DA_MX3(p0[2], p0[3], p1[1]); a = DA_MX3(a, p1[2], p1[3]);
#pragma unroll
    for (int r = 4; r < 16; r += 4) { a = DA_MX3(a, p0[r], p0[r + 1]); b = DA_MX3(b, p0[r + 2], p0[r + 3]); a = DA_MX3(a, p1[r], p1[r + 1]); b = DA_MX3(b, p1[r + 2], p1[r + 3]); }
    float m = __builtin_fmaxf(a, b); auto rr = __builtin_amdgcn_permlane32_swap(__float_as_uint(m), __float_as_uint(m), false, false);
    return __builtin_fmaxf(__uint_as_float(rr[0]), __uint_as_float(rr[1])); }
__device__ __forceinline__ void band(f32x16& p0, f32x16& p1, int nrel, int hi, const __attribute__((address_space(3))) float* tbl, bool mask) {
    const int lim = mask ? 0 : -100000;
#pragma unroll
    for (int j = 0; j < 4; ++j) { int u0 = nrel - (8 * j + 4 * hi); asm volatile("" : "+v"(u0));
        { const int a0 = 256 - u0; const f32x4 b0 = *(const __attribute__((address_space(3))) f32x4*)(tbl + (a0 & 3) * TBX + (a0 & ~3));
#pragma unroll
          for (int k = 0; k < 4; ++k) { const int r = 4 * j + k; p0[r] = (u0 - k < lim) ? -INFINITY : p0[r] + b0[k]; } }
        { const int a1 = 288 - u0; const f32x4 b1 = *(const __attribute__((address_space(3))) f32x4*)(tbl + (a1 & 3) * TBX + (a1 & ~3));
#pragma unroll
          for (int k = 0; k < 4; ++k) { const int r = 4 * j + k; p1[r] = (u0 - 32 - k < lim) ? -INFINITY : p1[r] + b1[k]; } } } }

template <bool NOBAR> __device__ __forceinline__ void unit(int b, int h, int qb, const unsigned short* QKV, unsigned short* YC, __attribute__((address_space(3))) unsigned char* lds, const float* ln_w, float lam, float osc, int tid) {
    typedef unsigned short bf16;
    const int wid = __builtin_amdgcn_readfirstlane(tid >> 6); const int qs = wid & 3, c = wid >> 2;
    const long rowbase = (long)b * SEQL; const int q0 = qb * QB, NT = (q0 + QB) / KVBLK;
    const bf16* Qw = QKV + (rowbase + q0 + qs * 32) * PITCH + h * 128 + c * 64;
    f32x16 o[4]; float l_reg = 0.f;
    __attribute__((address_space(3))) float* wsf = (__attribute__((address_space(3))) float*)(lds + LDS_WS) + wid * 64;
    {
    const int lane = tid & 63, r32 = lane & 31, hi = lane >> 5;
    const bf16* Kh = QKV + rowbase * PITCH + 1024 + h * 128; const bf16* Vh = QKV + rowbase * PITCH + 2048 + h * 128;
    const unsigned lds0 = (unsigned)(uintptr_t)lds;
    const __attribute__((address_space(3))) float* tbl = (const __attribute__((address_space(3))) float*)(lds + LDS_TBL);
    const bf16* ksrc = Kh + (long)lane * PITCH + wid * 8;
    const bf16* vsrc = Vh + (long)(16 * (wid & 3) + (lane >> 2)) * PITCH + (wid >> 2) * 32 + (lane & 3) * 8;
    const unsigned kdst = lds0 + LDS_K + wid * 1024, vdst = lds0 + LDS_V + wid * 1024;
#define DA_DMA_K(t, slot) do { glds16x2(ksrc + (long)(t) * KVBLK * PITCH, ksrc + (long)(t) * KVBLK * PITCH + 64, (unsigned)__builtin_amdgcn_readfirstlane(kdst + (slot)), (unsigned)__builtin_amdgcn_readfirstlane(kdst + (slot) + 8192)); } while (0)
#define DA_DMA_V(t, slot) do { glds16x2(vsrc + (long)(t) * KVBLK * PITCH, vsrc + (long)(t) * KVBLK * PITCH + 64, (unsigned)__builtin_amdgcn_readfirstlane(vdst + (slot)), (unsigned)__builtin_amdgcn_readfirstlane(vdst + (slot) + 8192)); } while (0)
    const lds_cptr shm3 = (lds_cptr)lds;
    const lds_cptr kp0 = shm3 + LDS_K + c * 8192 + hi * 1024 + r32 * 16;
    const lds_cptr vp0 = shm3 + LDS_V + ((lane >> 4) & 1) * 32 + (lane & 3) * 8 + (4 * hi + ((lane & 15) >> 2)) * 64;
    DA_DMA_K(0, 0); DA_DMA_V(0, 0); DA_DMA_K(1, SLOTB);
    bf16x8 qr[4];
#pragma unroll
    for (int d0 = 0; d0 < 4; ++d0) qr[d0] = *reinterpret_cast<const bf16x8*>(&Qw[(long)r32 * PITCH + d0 * 16 + hi * 8]);
    float mhat = 0.f;
    const int qn = q0 + qs * 32 + r32;
    bool resc = false;
    int sl_prev = 2 * SLOTB, sl_cur = 0, sl_next = SLOTB;
#define DA_ROT() do { sl_prev = sl_cur; sl_cur = sl_next; sl_next = (sl_next == 2 * SLOTB) ? 0 : sl_next + SLOTB; } while (0)
#define DA_RESC() do { if (resc) { asm volatile("s_waitcnt lgkmcnt(0)" ::: "memory"); \
      _Pragma("unroll") for (int d_ = 0; d_ < 4; ++d_) _Pragma("unroll") for (int r = 0; r < 16; ++r) o[d_][r] *= wsf[crow(r, hi)]; } } while (0)
#define DA_BAND(P0, P1, t) do { if ((t) >= NT - 4) band(P0, P1, qn - (t) * KVBLK, hi, tbl, (t) >= NT - 2); } while (0)
    DA_DMA_K(2, 2 * SLOTB);
    if (wid >= 4) __builtin_amdgcn_s_setprio(1);
    DA_WAIT_BAR(2);
    float zf = 0.f; asm volatile("" : "+v"(zf));
    f32x16 negm;
#pragma unroll
    for (int r = 0; r < 16; ++r) { o[0][r] = zf; o[1][r] = zf; o[2][r] = zf; o[3][r] = zf; negm[r] = zf; }
    asm volatile("" : "+v"(negm));
    f32x16 C0, C1; bf16x8 kf[8]; s16x4 vlo[8], vhi[8];
    u32x4 pw0, pw1, pw2, pw3;
#pragma unroll
    for (int j = 0; j < 4; ++j) kload2(kf, kp0, j);
    C0 = DA_MFMA(kf[0], qr[0], negm); C1 = DA_MFMA(kf[1], qr[0], negm);
#pragma unroll
    for (int j = 1; j < 4; ++j) { C0 = DA_MFMA(kf[2 * j], qr[j], C0); C1 = DA_MFMA(kf[2 * j + 1], qr[j], C1); }
    DA_BAND(C0, C1, 0);
    { const float rm = rowmax(C0, C1); mhat = rm;
#pragma unroll
      for (int r = 0; r < 16; ++r) { C0[r] = __builtin_amdgcn_exp2f(C0[r] - rm); C1[r] = __builtin_amdgcn_exp2f(C1[r] - rm); negm[r] = -rm; }
      asm volatile("" : "+v"(negm));
      float sacc = 0.f;
#pragma unroll
      for (int r = 0; r < 16; ++r) sacc += C0[r] + C1[r];
      l_reg = sacc; }
#define DA_PK4(P, i) (u32x4){cvtpk(P[i], P[i + 1]), cvtpk(P[i + 2], P[i + 3]), cvtpk(P[i + 4], P[i + 5]), cvtpk(P[i + 6], P[i + 7])}
    pw0 = DA_PK4(C0, 0); pw1 = DA_PK4(C0, 8); pw2 = DA_PK4(C1, 0); pw3 = DA_PK4(C1, 8);
    DA_DMA_V(1, SLOTB);
    kload2(kf, kp0 + sl_next, 0); kload2(kf, kp0 + sl_next, 1);
    if (NT == 2) { DA_WAIT_BAR(0); } else { DA_WAIT_BAR(2); }
    DA_ROT();
#define DA_PAF(k) __builtin_bit_cast(bf16x8, pw##k)
#define DA_VFR(i) (bf16x8){vlo[i][0], vlo[i][1], vlo[i][2], vlo[i][3], vhi[i][0], vhi[i][1], vhi[i][2], vhi[i][3]}
#define DA_VRD(slot, db, ks) do { vlo[slot] = vtr(vp_ + ((db) * 4096 + (ks) * 1024)); vhi[slot] = vtr(vp_ + ((db) * 4096 + (ks) * 1024 + 512)); } while (0)
#define DA_PIN(x) asm volatile("" : "+v"(x))
#define DA_EX2(X, i) do { X[i] = __builtin_amdgcn_exp2f(X[i]); X[(i) + 1] = __builtin_amdgcn_exp2f(X[(i) + 1]); } while (0)
#define DA_STEP(t, GK, GV, GL, BANDON) do { DA_SBAR(); \
    if (GK) { DA_DMA_K((t) + 2, sl_prev); } \
    const lds_cptr vp_ = vp0 + sl_prev; const lds_cptr kp_ = kp0 + sl_cur; \
    kload2(kf, kp_, 2); DA_VRD(0, 0, 0); DA_SBAR(); \
    C0 = DA_MFMA(kf[0], qr[0], negm); kload2(kf, kp_, 3); DA_SBAR(); \
    C1 = DA_MFMA(kf[1], qr[0], negm); DA_VRD(1, 1, 0); DA_SBAR(); \
    C0 = DA_MFMA(kf[2], qr[1], C0);   DA_VRD(2, 2, 0); DA_SBAR(); \
    C1 = DA_MFMA(kf[3], qr[1], C1);   DA_VRD(3, 3, 0); DA_SBAR(); \
    C0 = DA_MFMA(kf[4], qr[2], C0);   DA_VRD(4, 0, 1); DA_SBAR(); \
    C1 = DA_MFMA(kf[5], qr[2], C1);   DA_VRD(5, 1, 1); DA_SBAR(); \
    C0 = DA_MFMA(kf[6], qr[3], C0);   DA_VRD(6, 2, 1); DA_SBAR(); \
    C1 = DA_MFMA(kf[7], qr[3], C1);   DA_VRD(7, 3, 1); DA_SBAR(); \
    if (GV) { DA_DMA_V((t) + 1, sl_next); } \
    if (BANDON) { DA_BAND(C0, C1, t); } \
    { float rm = rowmax(C0, C1); resc = false; \
      if (__builtin_expect(__any(rm > (float)THRL), 0)) { const float dl = __builtin_fmaxf(rm, 0.f); mhat += dl; \
        _Pragma("unroll") for (int r = 0; r < 16; ++r) { C0[r] -= dl; C1[r] -= dl; } \
        _Pragma("unroll") for (int r = 0; r < 16; ++r) negm[r] = -mhat; asm volatile("" : "+v"(negm)); \
        const float f = __builtin_amdgcn_exp2f(-dl); l_reg *= f; if (hi == 0) wsf[r32] = f; resc = true; } } \
    DA_SBAR(); float sacc = 0.f; \
    o[0] = DA_MFMA(DA_PAF(0), DA_VFR(0), o[0]); DA_EX2(C0, 0);  DA_PIN(C0); DA_VRD(0, 0, 2); DA_SBAR(); \
    o[1] = DA_MFMA(DA_PAF(0), DA_VFR(1), o[1]); DA_EX2(C0, 2);  DA_PIN(C0); DA_VRD(1, 1, 2); DA_SBAR(); \
    o[2] = DA_MFMA(DA_PAF(0), DA_VFR(2), o[2]); DA_EX2(C0, 4);  DA_PIN(C0); DA_VRD(2, 2, 2); DA_SBAR(); \
    o[3] = DA_MFMA(DA_PAF(0), DA_VFR(3), o[3]); DA_EX2(C0, 6);  DA_PIN(C0); DA_VRD(3, 3, 2); DA_SBAR(); \
    o[0] = DA_MFMA(DA_PAF(1), DA_VFR(4), o[0]); DA_EX2(C0, 8);  sacc += C0[0] + C0[1]; pw0[0] = cvtpk(C0[0], C0[1]); pw0[1] = cvtpk(C0[2], C0[3]); DA_PIN(C0); DA_PIN(pw0); DA_PIN(sacc); DA_VRD(4, 0, 3); DA_SBAR(); \
    o[1] = DA_MFMA(DA_PAF(1), DA_VFR(5), o[1]); DA_EX2(C0, 10); sacc += C0[2] + C0[3]; pw0[2] = cvtpk(C0[4], C0[5]); pw0[3] = cvtpk(C0[6], C0[7]); DA_PIN(C0); DA_PIN(pw0); DA_PIN(sacc); DA_VRD(5, 1, 3); DA_SBAR(); \
    o[2] = DA_MFMA(DA_PAF(1), DA_VFR(6), o[2]); DA_EX2(C0, 12); sacc += C0[4] + C0[5]; sacc += C0[6] + C0[7]; DA_PIN(C0); DA_PIN(sacc); DA_VRD(6, 2, 3); DA_SBAR(); \
    o[3] = DA_MFMA(DA_PAF(1), DA_VFR(7), o[3]); DA_EX2(C0, 14); sacc += C0[8] + C0[9]; sacc += C0[10] + C0[11]; DA_PIN(C0); DA_PIN(sacc); DA_VRD(7, 3, 3); DA_SBAR(); \
    o[0] = DA_MFMA(DA_PAF(2), DA_VFR(0), o[0]); DA_EX2(C1, 0);  pw1[0] = cvtpk(C0[8], C0[9]); pw1[1] = cvtpk(C0[10], C0[11]); sacc += C0[12] + C0[13]; DA_PIN(C1); DA_PIN(pw1); DA_PIN(sacc); DA_SBAR(); \
    o[1] = DA_MFMA(DA_PAF(2), DA_VFR(1), o[1]); DA_EX2(C1, 2);  pw1[2] = cvtpk(C0[12], C0[13]); pw1[3] = cvtpk(C0[14], C0[15]); sacc += C0[14] + C0[15]; DA_PIN(C1); DA_PIN(pw1); DA_PIN(sacc); DA_SBAR(); \
    o[2] = DA_MFMA(DA_PAF(2), DA_VFR(2), o[2]); DA_EX2(C1, 4);  sacc += C1[0] + C1[1]; sacc += C1[2] + C1[3]; DA_PIN(C1); DA_PIN(sacc); DA_SBAR(); \
    o[3] = DA_MFMA(DA_PAF(2), DA_VFR(3), o[3]); DA_EX2(C1, 6);  sacc += C1[4] + C1[5]; DA_PIN(C1); DA_PIN(sacc); DA_SBAR(); \
    o[0] = DA_MFMA(DA_PAF(3), DA_VFR(4), o[0]); DA_EX2(C1, 8);  pw2[0] = cvtpk(C1[0], C1[1]); pw2[1] = cvtpk(C1[2], C1[3]); sacc += C1[6] + C1[7]; DA_PIN(C1); DA_PIN(pw2); DA_PIN(sacc); if (GL) { kload2(kf, kp0 + sl_next, 0); } DA_SBAR(); \
    o[1] = DA_MFMA(DA_PAF(3), DA_VFR(5), o[1]); DA_EX2(C1, 10); pw2[2] = cvtpk(C1[4], C1[5]); pw2[3] = cvtpk(C1[6], C1[7]); DA_PIN(C1); DA_PIN(pw2); if (GL) { kload2(kf, kp0 + sl_next, 1); } DA_SBAR(); \
    o[2] = DA_MFMA(DA_PAF(3), DA_VFR(6), o[2]); DA_EX2(C1, 12); sacc += C1[8] + C1[9]; sacc += C1[10] + C1[11]; DA_PIN(C1); DA_PIN(sacc); DA_SBAR(); \
    o[3] = DA_MFMA(DA_PAF(3), DA_VFR(7), o[3]); DA_EX2(C1, 14); DA_PIN(C1); DA_SBAR(); \
    sacc += C1[12] + C1[13]; sacc += C1[14] + C1[15]; pw3 = DA_PK4(C1, 8); l_reg += sacc; \
    } while (0)
#define DA_ENDW(tt) do { if ((tt) + 2 < NT) { DA_WAIT_BAR(2); } else { DA_WAIT_BAR(0); } } while (0)
    int t = 1;
    for (; t + 5 < NT; t += 2) {
        DA_STEP(t, true, true, true, false);     if (NOBAR) asm volatile("s_waitcnt vmcnt(2) lgkmcnt(0)" ::: "memory"); else DA_WAIT_BAR(2); DA_RESC(); DA_ROT();
        DA_STEP(t + 1, true, true, true, false); if (NOBAR) asm volatile("s_waitcnt vmcnt(2) lgkmcnt(0)" ::: "memory"); else DA_WAIT_BAR(2); DA_RESC(); DA_ROT();
    }
    for (; t + 1 < NT; t += 2) {
        DA_STEP(t, (t + 2 < NT), (t + 1 < NT), (t + 1 < NT), true);         DA_ENDW(t);     DA_RESC(); DA_ROT();
        DA_STEP(t + 1, (t + 3 < NT), (t + 2 < NT), (t + 2 < NT), true);     DA_ENDW(t + 1); DA_RESC(); DA_ROT();
    }
    DA_STEP(NT - 1, false, false, false, true); DA_RESC();
    { const lds_cptr vp_ = vp0 + sl_cur;
#pragma unroll
      for (int ks = 0; ks < 4; ++ks) {
#pragma unroll
          for (int db = 0; db < 4; ++db) DA_VRD(db, db, ks);
          const bf16x8 pa = ks == 0 ? DA_PAF(0) : ks == 1 ? DA_PAF(1) : ks == 2 ? DA_PAF(2) : DA_PAF(3);
#pragma unroll
          for (int db = 0; db < 4; ++db) o[db] = DA_MFMA(pa, DA_VFR(db), o[db]); } }
    __builtin_amdgcn_s_setprio(0);
    }
    int te_ = tid; asm volatile("" : "+v"(te_)); const int lane_e = te_ & 63;
    const int r32 = lane_e & 31, hi = lane_e >> 5, lane = lane_e;
    float lnw[4];
#pragma unroll
    for (int db = 0; db < 4; ++db) lnw[db] = ln_w[db * 32 + r32];
    {
    { auto rr = __builtin_amdgcn_permlane32_swap(__float_as_uint(l_reg), __float_as_uint(l_reg), false, false); l_reg = __uint_as_float(rr[0]) + __uint_as_float(rr[1]); }
    if (hi == 0) wsf[32 + r32] = l_reg; asm volatile("s_waitcnt lgkmcnt(0)" ::: "memory");
    { const float cs = c == 0 ? 1.f : -lam;
#pragma unroll
      for (int r = 0; r < 16; ++r) { const float rl_ = __builtin_amdgcn_rcpf(wsf[32 + crow(r, hi)]) * cs;
#pragma unroll
          for (int db = 0; db < 4; ++db) o[db][r] *= rl_; } }
    asm volatile("s_waitcnt lgkmcnt(0)\n\ts_barrier" ::: "memory");
    __attribute__((address_space(3))) float* stf = (__attribute__((address_space(3))) float*)(lds + STG_F) + qs * 4096;
    if (c == 1) {
#pragma unroll
        for (int r = 0; r < 16; ++r)
#pragma unroll
            for (int db = 0; db < 4; ++db) stf[crow(r, hi) * 128 + db * 32 + r32] = o[db][r];
    }
    asm volatile("s_waitcnt lgkmcnt(0)\n\ts_barrier" ::: "memory");
    if (c == 0) {
        float ss[16];
#pragma unroll
        for (int r = 0; r < 16; ++r) { float s = 0.f;
#pragma unroll
            for (int db = 0; db < 4; ++db) { o[db][r] += stf[crow(r, hi) * 128 + db * 32 + r32]; s += o[db][r] * o[db][r]; }
            ss[r] = s; }
#pragma unroll
        for (int r = 0; r < 16; ++r) { float s = ss[r];
            s += cdpp<0xB1>(s); s += cdpp<0x4E>(s); s += cdpp<0x141>(s); s += cdpp<0x140>(s);
            { auto r16_ = __builtin_amdgcn_permlane16_swap(__float_as_uint(s), __float_as_uint(s), false, false); const unsigned a_ = r16_[0], b_ = r16_[1]; s = __uint_as_float(a_) + __uint_as_float(b_); }
            ss[r] = rsqrtf(s * (1.f / 128.f) + 1e-6f) * osc; }
        __attribute__((address_space(3))) bf16* stb = (__attribute__((address_space(3))) bf16*)(lds + STG_B) + qs * 4096;
#pragma unroll
        for (int r = 0; r < 16; ++r)
#pragma unroll
            for (int db = 0; db < 4; ++db) { const float v = o[db][r] * ss[r] * lnw[db]; stb[crow(r, hi) * 128 + db * 32 + r32] = (bf16)cvtpk(v, 0.f); }
        asm volatile("s_waitcnt lgkmcnt(0)" ::: "memory");
        bf16* Ow = YC + (rowbase + q0 + qs * 32) * 1024 + h * 128;
#pragma unroll
        for (int i = 0; i < 8; ++i) { const int row = i * 4 + (lane >> 4), ch = lane & 15; const u32x4 v = *(const __attribute__((address_space(3))) u32x4*)(stb + row * 128 + ch * 8); *(u32x4*)(Ow + (long)row * 1024 + ch * 8) = v; }
    }
    }
    asm volatile("s_waitcnt lgkmcnt(0)\n\ts_barrier" ::: "memory");
#undef DA_DMA_K
#undef DA_DMA_V
#undef DA_ROT
#undef DA_RESC
#undef DA_BAND
#undef DA_PK4
#undef DA_PAF
#undef DA_VFR
#undef DA_VRD
#undef DA_PIN
#undef DA_EX2
#undef DA_STEP
#undef DA_ENDW
}
template <bool NOBAR = false> __device__ __forceinline__ void phase(__attribute__((address_space(3))) unsigned char* lds, int bid, int G, int tid, const unsigned short* QKV, unsigned short* YC, const float* rel_bias, const float* ln_w, float lam, float lam_init) {
    const int vcu = (G % 8 == 0) ? (bid % 8) * (G / 8) + bid / 8 : bid;
    __attribute__((address_space(3))) float* tbl = (__attribute__((address_space(3))) float*)(lds + LDS_TBL);
    int hprev = -1;
    for (int v = vcu; v < 256; v += G) {
        const int bh = v >> 2, s = v & 3, b = bh >> 3, h = bh & 7;
        int tq = tid; asm volatile("" : "+v"(tq));
        if (h != hprev) {
            for (int idx = tq; idx < 4 * TBX; idx += 512) { const int s_ = idx / TBX, y_ = idx - s_ * TBX, dist = 256 - (y_ + s_); float v = 0.f;
                if (dist >= 0 && dist < 128) { int bk; if (dist < 16) bk = dist; else { bk = 16 + (int)(logf((float)dist * (1.f / 16.f)) * (16.f / 2.0794415416798357f)); bk = bk > 31 ? 31 : bk; }
                    v = (rel_bias[bk * 8 + h] - rel_bias[31 * 8 + h]) * 1.4426950408889634f; }
                tbl[idx] = v; }
            hprev = h; }
#pragma unroll 1
        for (int i = 0; i < 8; ++i) { const int qb = (i & 1) ? 31 - 4 * (i >> 1) - s : 4 * (i >> 1) + s;
            int tl = tid; asm volatile("" : "+v"(tl));
            unit<NOBAR>(b, h, qb, QKV, YC, lds, ln_w, lam, 1.f - lam_init, tl); }
    }
}
#undef DA_SBAR
#undef DA_WAIT_BAR
#undef DA_MFMA
#undef DA_MX3
}
namespace mix {
typedef unsigned short bf16;
typedef float f32x2 __attribute__((ext_vector_type(2)));
typedef float f32x4 __attribute__((ext_vector_type(4)));
#define MLAS __attribute__((address_space(3)))
constexpr int REC = 640, BLK = 16, NBLK = 4096 / BLK, RSLOTS = 3;
constexpr int R_A = 0, R_WR = 64, R_W = 128, R_B = 192, R_KM = 256, R_V = 320, R_Q2 = 384, R_K2 = 448, R_V2 = 512, R_SC = 576;
template <int CTRL> __device__ __forceinline__ float dppf(float v) { return __builtin_bit_cast(float, __builtin_amdgcn_update_dpp(0, __builtin_bit_cast(int, v), CTRL, 0xF, 0xF, true)); }
__device__ __forceinline__ float xsum16(float v) { auto r = __builtin_amdgcn_permlane16_swap(__float_as_uint(v), __float_as_uint(v), false, false); const unsigned r0 = r[0], r1 = r[1]; return __uint_as_float(r0) + __uint_as_float(r1); }
__device__ __forceinline__ float xsum32(float v) { auto r = __builtin_amdgcn_permlane32_swap(__float_as_uint(v), __float_as_uint(v), false, false); const unsigned r0 = r[0], r1 = r[1]; return __uint_as_float(r0) + __uint_as_float(r1); }
__device__ __forceinline__ float xother32(float v) { auto r = __builtin_amdgcn_permlane32_swap(__float_as_uint(v), __float_as_uint(v), false, false); const unsigned r0 = r[0], r1 = r[1]; const int l = (int)__builtin_amdgcn_mbcnt_hi(~0u, __builtin_amdgcn_mbcnt_lo(~0u, 0u)); return l < 32 ? __uint_as_float(r1) : __uint_as_float(r0); }
__device__ __forceinline__ float rowsum16(float x) { x += dppf<0xB1>(x); x += dppf<0x4E>(x); x += dppf<0x124>(x); x += dppf<0x128>(x); return x; }
__device__ __forceinline__ float sum8(float x) { x += dppf<0xB1>(x); x += dppf<0x4E>(x); x += dppf<0x141>(x); return x; }
__device__ __forceinline__ float treduce4(float x0, float x1, float x2, float x3, bool p1, bool p2) {
    const float k01 = p1 ? x1 : x0, s01 = p1 ? x0 : x1; const float y01 = k01 + dppf<0xB1>(s01);
    const float k23 = p1 ? x3 : x2, s23 = p1 ? x2 : x3; const float y23 = k23 + dppf<0xB1>(s23);
    const float kk = p2 ? y23 : y01, ss = p2 ? y01 : y23; float z = kk + dppf<0x4E>(ss);
    z += dppf<0x124>(z); z += dppf<0x128>(z);
    z = xsum16(z); z = xsum32(z); return z; }
__device__ __forceinline__ float b2f(unsigned v) { return __builtin_bit_cast(float, v << 16); }
typedef float mf32x2_t __attribute__((ext_vector_type(2))); typedef __bf16 mbf16x2_t __attribute__((ext_vector_type(2)));
__device__ __forceinline__ unsigned mixpk(float lo, float hi) { mf32x2_t v = {lo, hi}; mbf16x2_t b = __builtin_convertvector(v, mbf16x2_t); return __builtin_bit_cast(unsigned, b); }
__device__ __forceinline__ unsigned short f2b(float f) { unsigned u = __builtin_bit_cast(unsigned, f); return (unsigned short)((u + 0x7fffu + ((u >> 16) & 1u)) >> 16); }

__device__ __forceinline__ void scan_phase(MLAS float* ring, int bid, int G, int wave, int lane, const bf16* PROJ, const bf16* DECB, const bf16* ALPHA, bf16* YR, float* BONUS, const f32x2* ROT,
                                           const float* mu, const float* k_k, const float* k_a, const float* r_k) {
    constexpr int HYBW = 3840;
    const int vcu = (G % 8 == 0) ? (bid % 8) * (G / 8) + bid / 8 : bid;
    for (int cu = vcu; cu < 256; cu += G) {
        const int bh = cu >> 2, quarter = cu & 3, b = bh >> 3, hh = bh & 7;
        const size_t mb = (size_t)b * 4096;
        if (wave < 4) {
            const int rl = lane >> 4, kp = lane & 15, row = quarter * 16 + wave * 4 + rl;
            const float gamma = 1.f - exp2f(-5.f - (float)hh);
            f32x4 S = {0.f, 0.f, 0.f, 0.f}, T = {0.f, 0.f, 0.f, 0.f};
            bf16* yo = YR + mb * 1024 + hh * 64 + row;
            f32x4 A[2], WR[2], W[2], B[2], KM[2], Q2[2], K2[2]; float VS[2], V2S[2]; f32x2 SC[2];
#define MIX_RD(s, rec_) do { const MLAS float* r_ = (rec_); A[s] = *(const MLAS f32x4*)(r_ + R_A + 4 * kp); WR[s] = *(const MLAS f32x4*)(r_ + R_WR + 4 * kp); W[s] = *(const MLAS f32x4*)(r_ + R_W + 4 * kp); \
            B[s] = *(const MLAS f32x4*)(r_ + R_B + 4 * kp); KM[s] = *(const MLAS f32x4*)(r_ + R_KM + 4 * kp); Q2[s] = *(const MLAS f32x4*)(r_ + R_Q2 + 4 * kp); K2[s] = *(const MLAS f32x4*)(r_ + R_K2 + 4 * kp); \
            VS[s] = r_[R_V + row]; V2S[s] = r_[R_V2 + row]; SC[s] = *(const MLAS f32x2*)(r_ + R_SC); } while (0)
#define MIX_STEP(s, t_) do { \
            float z = (S[0] * A[s][0] + S[1] * A[s][1]) + (S[2] * A[s][2] + S[3] * A[s][3]); \
            float q = (S[0] * WR[s][0] + S[1] * WR[s][1]) + (S[2] * WR[s][2] + S[3] * WR[s][3]); \
            z = rowsum16(z); q = rowsum16(q); \
            const float y = q + z * SC[s][0] + VS[s] * SC[s][1]; \
            S = S * W[s] + (z * B[s] + VS[s] * KM[s]); \
            T = T * gamma + K2[s] * V2S[s]; \
            float o = (T[0] * Q2[s][0] + T[1] * Q2[s][1]) + (T[2] * Q2[s][2] + T[3] * Q2[s][3]); \
            o = rowsum16(o); \
            if (kp == 0) { bf16* yp = yo + (size_t)(t_) * 1024; yp[0] = f2b(y); yp[512] = f2b(o); } } while (0)
            asm volatile("s_waitcnt lgkmcnt(0)\n\ts_barrier" ::: "memory");
            for (int it = -2; it < NBLK; ++it) {
                if (it >= 0) {
                    const MLAS float* blk = ring + (it % RSLOTS) * (BLK * REC);
                    const MLAS float* nblk = ring + ((it + 1) % RSLOTS) * (BLK * REC);
                    if (it == 0) MIX_RD(0, blk);
#pragma unroll
                    for (int j = 0; j < BLK; j += 2) {
                        MIX_RD(1, blk + (j + 1) * REC);
                        MIX_STEP(0, it * BLK + j);
                        if (j + 2 < BLK) MIX_RD(0, blk + (j + 2) * REC); else if (it + 1 < NBLK) MIX_RD(0, nblk);
                        MIX_STEP(1, it * BLK + j + 1);
                    }
                }
                asm volatile("s_waitcnt lgkmcnt(0)\n\ts_barrier" ::: "memory");
            }
#undef MIX_RD
#undef MIX_STEP
        } else {
            const int pwv = wave - 4, par = pwv >> 1, sub = pwv & 1, tk = lane >> 3, ch = lane & 7, c0 = hh * 64 + 8 * ch;
            typedef unsigned v4u_ __attribute__((ext_vector_type(4)));
            const bf16* pr = PROJ + mb * HYBW + c0;
            v4u_ Lr[2][2], Lk[2][2], Lv[2][2], Lq[2], Lk2[2], Lv2[2], La[2], Le[2];
#define MIX_LOAD(s, blk_) do { const int t_ = (blk_) * BLK + 8 * sub + tk; const bf16* p_ = pr + (size_t)t_ * HYBW; const bool hp_ = t_ > 0; const bf16* pp_ = hp_ ? p_ - HYBW : p_; \
            Lr[s][0] = *(const v4u_*)(p_); Lk[s][0] = *(const v4u_*)(p_ + 512); Lv[s][0] = *(const v4u_*)(p_ + 1024); \
            Lr[s][1] = *(const v4u_*)(pp_); Lk[s][1] = *(const v4u_*)(pp_ + 512); Lv[s][1] = *(const v4u_*)(pp_ + 1024); \
            if (!hp_) { Lr[s][1] = (v4u_){0u, 0u, 0u, 0u}; Lk[s][1] = (v4u_){0u, 0u, 0u, 0u}; Lv[s][1] = (v4u_){0u, 0u, 0u, 0u}; } \
            Lq[s] = *(const v4u_*)(p_ + 1792); Lk2[s] = *(const v4u_*)(p_ + 2304); Lv2[s] = *(const v4u_*)(p_ + 2816); \
            La[s] = *(const v4u_*)(ALPHA + (mb + t_) * 512 + c0); Le[s] = *(const v4u_*)(DECB + (mb + t_) * 512 + c0); } while (0)
#define MIX_U(w_, e_) b2f(((e_) & 1) ? ((w_)[(e_) >> 1] >> 16) : ((w_)[(e_) >> 1] & 0xffffu))
#define MIX_PROC(s, blk_) do { const int t_ = (blk_) * BLK + 8 * sub + tk; \
            const f32x4* rp_ = (const f32x4*)(ROT + (size_t)t_ * 32 + 8 * (ch & 3)); f32x4 rot_[4]; rot_[0] = rp_[0]; rot_[1] = rp_[1]; rot_[2] = rp_[2]; rot_[3] = rp_[3];     \
            float p0 = 0.f, p1 = 0.f, p2 = 0.f, p3 = 0.f; \
            _Pragma("unroll") for (int e = 0; e < 8; ++e) { const float rc = MIX_U(Lr[s][0], e), rq = MIX_U(Lr[s][1], e), kc = MIX_U(Lk[s][0], e), kq = MIX_U(Lk[s][1], e); \
                const float r = rc + (rq - rc) * cst[0 * 64 + 8 * ch + e], kraw = kc + (kq - kc) * cst[1 * 64 + 8 * ch + e], al = MIX_U(La[s], e); \
                const float kkr = kraw * cst[3 * 64 + 8 * ch + e], km = kraw * (1.f + (al - 1.f) * cst[4 * 64 + 8 * ch + e]), x2 = km * r; \
                p0 += kkr * kkr; p1 += kkr * al * r; p2 += x2; p3 += x2 * cst[5 * 64 + 8 * ch + e]; } \
            p0 = sum8(p0); p1 = sum8(p1); p2 = sum8(p2); p3 = sum8(p3); \
            const float inv = rsqrtf(fmaxf(p0, 1e-24f)); \
            asm volatile("" : "+v"(Lr[s][0]), "+v"(Lr[s][1]), "+v"(Lk[s][0]), "+v"(Lk[s][1]), "+v"(La[s]));     \
            MLAS float* rec = ring + ((blk_) % RSLOTS) * (BLK * REC) + (8 * sub + tk) * REC + 8 * ch; \
            _Pragma("unroll") for (int h4 = 0; h4 < 2; ++h4) { f32x4 oa, owr, ow, ob, okm, ov, ov2, oq, ok; \
                _Pragma("unroll") for (int e4 = 0; e4 < 4; ++e4) { const int e = 4 * h4 + e4; \
                    const float rc = MIX_U(Lr[s][0], e), rq = MIX_U(Lr[s][1], e), kc = MIX_U(Lk[s][0], e), kq = MIX_U(Lk[s][1], e), vc = MIX_U(Lv[s][0], e), vq = MIX_U(Lv[s][1], e); \
                    const float r = rc + (rq - rc) * cst[0 * 64 + 8 * ch + e], kraw = kc + (kq - kc) * cst[1 * 64 + 8 * ch + e], v = vc + (vq - vc) * cst[2 * 64 + 8 * ch + e], al = MIX_U(La[s], e); \
                    const float dc = __builtin_amdgcn_exp2f(-1.4426950408889634f * MIX_U(Le[s], e)); \
                    const float kk = kraw * cst[3 * 64 + 8 * ch + e] * inv; \
                    oa[e4] = -kk; owr[e4] = dc * r; ow[e4] = dc; ob[e4] = kk * al; okm[e4] = kraw * (1.f + (al - 1.f) * cst[4 * 64 + 8 * ch + e]); ov[e4] = v; ov2[e4] = MIX_U(Lv2[s], e); \
                      \
                    const float cs = rot_[e >> 1][2 * (e & 1)], sn = rot_[e >> 1][2 * (e & 1) + 1]; const float qv = MIX_U(Lq[s], e), kv = MIX_U(Lk2[s], e); \
                    const float qp = __shfl_xor(qv, 4), kp = __shfl_xor(kv, 4); \
                    oq[e4] = ch < 4 ? qv * cs - qp * sn : qp * sn + qv * cs; ok[e4] = (ch < 4 ? kv * cs - kp * sn : kp * sn + kv * cs) * 0.125f; } \
                *(MLAS f32x4*)(rec + R_A + 4 * h4) = oa; *(MLAS f32x4*)(rec + R_WR + 4 * h4) = owr; *(MLAS f32x4*)(rec + R_W + 4 * h4) = ow; *(MLAS f32x4*)(rec + R_B + 4 * h4) = ob; \
                *(MLAS f32x4*)(rec + R_KM + 4 * h4) = okm; *(MLAS f32x4*)(rec + R_V + 4 * h4) = ov; *(MLAS f32x4*)(rec + R_V2 + 4 * h4) = ov2; *(MLAS f32x4*)(rec + R_Q2 + 4 * h4) = oq; *(MLAS f32x4*)(rec + R_K2 + 4 * h4) = ok; } \
            if (ch == 0) { rec[R_SC] = p1 * inv; rec[R_SC + 1] = p2; if (quarter == 0) BONUS[(mb + (size_t)t_) * 8 + hh] = p3; } \
            if ((blk_) + 4 < NBLK) MIX_LOAD(s, (blk_) + 4); } while (0)
#define MIX_BAR() asm volatile("s_waitcnt lgkmcnt(0)\n\ts_barrier" ::: "memory")
            MLAS float* cst = ring + RSLOTS * BLK * REC;
            if (wave == 4) { const int c = hh * 64 + lane; cst[lane] = mu[c]; cst[64 + lane] = mu[512 + c]; cst[128 + lane] = mu[1024 + c]; cst[192 + lane] = k_k[c]; cst[256 + lane] = k_a[c]; cst[320 + lane] = r_k[c]; }
            MIX_LOAD(0, par); MIX_LOAD(1, par + 2);
            MIX_BAR();
            if (par) MIX_BAR();
            for (int b2 = par; b2 < NBLK; b2 += 4) {
                MIX_PROC(0, b2); MIX_BAR(); MIX_BAR();
                MIX_PROC(1, b2 + 2); MIX_BAR(); MIX_BAR();
            }
            MIX_BAR(); if (!par) MIX_BAR();
#undef MIX_PROC
#undef MIX_BAR
#undef MIX_U
#undef MIX_LOAD
        }
    }
}

__device__ __forceinline__ void post_phase(int gw, int NGW, int lane, const bf16* PROJ, bf16* YR, const bf16* GG, const float* BONUS, const float* mu_v_, const float* ln_w, const float* ln_b, const float* ret_ln_w) {
    constexpr int HYBW = 3840;
    const bool p1 = (lane & 1) != 0, p2 = (lane & 2) != 0;
    float lw[8], lb[8], rw[8], muv[8];
#pragma unroll
    for (int j = 0; j < 8; ++j) { lw[j] = ln_w[j * 64 + lane]; lb[j] = ln_b[j * 64 + lane]; rw[j] = ret_ln_w[j * 64 + lane]; muv[j] = mu_v_[j * 64 + lane]; }
    for (int m = gw; m < 32768; m += NGW) {
        bf16* row = YR + (size_t)m * 1024; const bf16* prow = PROJ + (size_t)m * HYBW; const bool has_prev = (m & 4095) != 0;
        float y[8], o[8];
#pragma unroll
        for (int j = 0; j < 8; ++j) { y[j] = b2f(row[j * 64 + lane]); o[j] = b2f(row[512 + j * 64 + lane]); }
        float res[16];
#pragma unroll
        for (int g4 = 0; g4 < 2; ++g4) {
            const float zs = treduce4(y[4 * g4], y[4 * g4 + 1], y[4 * g4 + 2], y[4 * g4 + 3], p1, p2);
            const float m0 = dppf<0x00>(zs) * (1.f / 64.f), m1 = dppf<0x55>(zs) * (1.f / 64.f), m2 = dppf<0xAA>(zs) * (1.f / 64.f), m3 = dppf<0xFF>(zs) * (1.f / 64.f);
            const float d0 = y[4 * g4] - m0, d1 = y[4 * g4 + 1] - m1, d2 = y[4 * g4 + 2] - m2, d3 = y[4 * g4 + 3] - m3;
            const float zv = treduce4(d0 * d0, d1 * d1, d2 * d2, d3 * d3, p1, p2);
            const float r0 = rsqrtf(dppf<0x00>(zv) * (1.f / 64.f) + 64e-5f), r1 = rsqrtf(dppf<0x55>(zv) * (1.f / 64.f) + 64e-5f), r2 = rsqrtf(dppf<0xAA>(zv) * (1.f / 64.f) + 64e-5f), r3 = rsqrtf(dppf<0xFF>(zv) * (1.f / 64.f) + 64e-5f);
            const float dd[4] = {d0 * r0, d1 * r1, d2 * r2, d3 * r3};
#pragma unroll
            for (int q = 0; q < 4; ++q) { const int j = 4 * g4 + q, c = j * 64 + lane;
                const float vc = b2f(prow[1024 + c]), vp = has_prev ? b2f(prow[1024 + c - HYBW]) : 0.f; const float v = vc + (vp - vc) * muv[j];
                const float yn = dd[q] * lw[j] + lb[j];
                res[j] = (yn + BONUS[(size_t)m * 8 + j] * v) * b2f(GG[(size_t)m * 512 + c]); }
            const float zo = treduce4(o[4 * g4] * o[4 * g4], o[4 * g4 + 1] * o[4 * g4 + 1], o[4 * g4 + 2] * o[4 * g4 + 2], o[4 * g4 + 3] * o[4 * g4 + 3], p1, p2);
            const float q0 = rsqrtf(dppf<0x00>(zo) * (1.f / 64.f) + 1e-6f), q1 = rsqrtf(dppf<0x55>(zo) * (1.f / 64.f) + 1e-6f), q2 = rsqrtf(dppf<0xAA>(zo) * (1.f / 64.f) + 1e-6f), q3 = rsqrtf(dppf<0xFF>(zo) * (1.f / 64.f) + 1e-6f);
            const float qq[4] = {q0, q1, q2, q3};
#pragma unroll
            for (int q = 0; q < 4; ++q) { const int j = 4 * g4 + q, c = j * 64 + lane; const float g = b2f(prow[3328 + c]);
                res[8 + j] = o[j] * qq[q] * rw[j] * g / (1.f + __expf(-g)); }
        }
#pragma unroll
        for (int j = 0; j < 8; ++j) { row[j * 64 + lane] = f2b(res[j]); row[512 + j * 64 + lane] = f2b(res[8 + j]); }
    }
}
#define MIX_U(w_, e_) b2f(((e_) & 1) ? ((w_)[(e_) >> 1] >> 16) : ((w_)[(e_) >> 1] & 0xffffu))
__device__ __forceinline__ void post_phase_v(int gw, int NGW, int lane, const bf16* PROJ, bf16* YR, const bf16* GG, const float* BONUS, const float* mu_v_, const float* ln_w, const float* ln_b, const float* ret_ln_w) {
    constexpr int HYBW = 3840;
    typedef unsigned v4u_ __attribute__((ext_vector_type(4)));
    typedef float v4f_ __attribute__((ext_vector_type(4)));
    const int tk = lane >> 3, ch = lane & 7;
    for (int tg = gw; tg < 32768 / 8; tg += NGW) {
        const int m = tg * 8 + tk; const bool has_prev = (m & 4095) != 0;
        bf16* row = YR + (size_t)m * 1024 + 8 * ch; const bf16* prow = PROJ + (size_t)m * HYBW + 8 * ch; const bf16* grow = GG + (size_t)m * 512 + 8 * ch;
#pragma unroll 2
        for (int j = 0; j < 8; ++j) {
            const int c = j * 64 + 8 * ch;
            {
                const v4u_ yw = *(const v4u_*)(row + j * 64), vcw = *(const v4u_*)(prow + 1024 + j * 64), gw4 = *(const v4u_*)(grow + j * 64);
                v4u_ vpw = {0u, 0u, 0u, 0u}; if (has_prev) vpw = *(const v4u_*)(prow + 1024 + j * 64 - HYBW);
                const float bon = BONUS[(size_t)m * 8 + j];
                const v4f_ lw0 = *(const v4f_*)(ln_w + c), lw1 = *(const v4f_*)(ln_w + c + 4), lb0 = *(const v4f_*)(ln_b + c), lb1 = *(const v4f_*)(ln_b + c + 4), mv0 = *(const v4f_*)(mu_v_ + c), mv1 = *(const v4f_*)(mu_v_ + c + 4);
                float y[8], s = 0.f;
#pragma unroll
                for (int e = 0; e < 8; ++e) { y[e] = MIX_U(yw, e); s += y[e]; }
                const float mean = sum8(s) * (1.f / 64.f); float q = 0.f;
#pragma unroll
                for (int e = 0; e < 8; ++e) { y[e] -= mean; q += y[e] * y[e]; }
                const float r = rsqrtf(sum8(q) * (1.f / 64.f) + 64e-5f);
                float res[8];
#pragma unroll
                for (int e = 0; e < 8; ++e) { const float vc = MIX_U(vcw, e), vp = MIX_U(vpw, e); const float lw_ = e < 4 ? lw0[e & 3] : lw1[e & 3], lb_ = e < 4 ? lb0[e & 3] : lb1[e & 3], mv_ = e < 4 ? mv0[e & 3] : mv1[e & 3];
                    const float v = vc + (vp - vc) * mv_; res[e] = (y[e] * r * lw_ + lb_ + bon * v) * MIX_U(gw4, e); }
                v4u_ ow;
#pragma unroll
                for (int e = 0; e < 4; ++e) ow[e] = mixpk(res[2 * e], res[2 * e + 1]);
                *(v4u_*)(row + j * 64) = ow; }
            {
                const v4u_ ow_ = *(const v4u_*)(row + 512 + j * 64), gt = *(const v4u_*)(prow + 3328 + j * 64);
                const v4f_ rw0 = *(const v4f_*)(ret_ln_w + c), rw1 = *(const v4f_*)(ret_ln_w + c + 4);
                float o[8], s = 0.f;
#pragma unroll
                for (int e = 0; e < 8; ++e) { o[e] = MIX_U(ow_, e); s += o[e] * o[e]; }
                const float qn = rsqrtf(sum8(s) * (1.f / 64.f) + 1e-6f);
                float res[8];
#pragma unroll
                for (int e = 0; e < 8; ++e) { const float g = MIX_U(gt, e), rw_ = e < 4 ? rw0[e & 3] : rw1[e & 3]; res[e] = o[e] * qn * rw_ * g * __builtin_amdgcn_rcpf(1.f + __expf(-g)); }
                v4u_ ow;
#pragma unroll
                for (int e = 0; e < 4; ++e) ow[e] = mixpk(res[2 * e], res[2 * e + 1]);
                *(v4u_*)(row + 512 + j * 64) = ow; }
        }
    }
}
#undef MIX_U
__device__ __forceinline__ void xl_phase(int gtid, int NT_, const bf16* PROJ, const float* mu, bf16* XL, int row0 = 0, int nrows = 32768) {
    constexpr int HYBW = 3840;
    typedef unsigned v4u_ __attribute__((ext_vector_type(4)));
    for (int it0 = gtid; it0 < nrows * 32; it0 += 4 * NT_) {
        v4u_ cw[4], pw_[4];
#pragma unroll
        for (int u = 0; u < 4; ++u) { const int it = it0 + u * NT_; const bool ok = it < nrows * 32; const int m = row0 + ((ok ? it : it0) >> 5), col = 1536 + ((ok ? it : it0) & 31) * 8;
            cw[u] = *(const v4u_*)(PROJ + (size_t)m * HYBW + col);
            pw_[u] = (v4u_){0u, 0u, 0u, 0u}; if ((m & 4095) != 0) pw_[u] = *(const v4u_*)(PROJ + (size_t)(m - 1) * HYBW + col); }
#pragma unroll
        for (int u = 0; u < 4; ++u) { const int it = it0 + u * NT_; if (it < nrows * 32) {
            const int m = row0 + (it >> 5), ch = it & 31, col = 1536 + ch * 8;
            float x[8];
#pragma unroll
            for (int e = 0; e < 4; ++e) { const float c0 = b2f(cw[u][e] & 0xffffu), c1 = b2f(cw[u][e] >> 16), q0 = b2f(pw_[u][e] & 0xffffu), q1 = b2f(pw_[u][e] >> 16);
                x[2 * e] = c0 + (q0 - c0) * mu[col + 2 * e]; x[2 * e + 1] = c1 + (q1 - c1) * mu[col + 2 * e + 1]; }
            if (ch < 8) {
#pragma unroll
                for (int e = 0; e < 8; ++e) { const float t = __expf(2.f * x[e]); x[e] = 1.f - 2.f * __builtin_amdgcn_rcpf(t + 1.f); } }
            else if (ch >= 16) {
#pragma unroll
                for (int e = 0; e < 8; ++e) x[e] = __builtin_amdgcn_rcpf(1.f + __expf(-x[e])); }
            v4u_ ow;
#pragma unroll
            for (int e = 0; e < 4; ++e) ow[e] = mixpk(x[2 * e], x[2 * e + 1]);
            *(v4u_*)(XL + (size_t)m * 256 + ch * 8) = ow; } }
    }
}
#undef MLAS
}
#ifndef THREE_ROLE
#define THREE_ROLE 0
#endif
namespace ck {
typedef unsigned short bf16;
typedef float f32x2 __attribute__((ext_vector_type(2)));
typedef float f32x4 __attribute__((ext_vector_type(4)));
typedef short bf16x8 __attribute__((ext_vector_type(8)));
typedef short s16x4 __attribute__((ext_vector_type(4)));
typedef unsigned u32x4 __attribute__((ext_vector_type(4)));
typedef unsigned u32x2 __attribute__((ext_vector_type(2)));
typedef short v4i16_t __attribute__((ext_vector_type(4)));
#define CLAS __attribute__((address_space(3)))
constexpr int NBLK = 256, RING = 10, REC = 12800, NPREP = 6;
constexpr int O_AT = 0, O_RT = 2048, O_BT = 4096, O_KT = 6144, O_IE = 8192, O_CC = 9216, O_P15 = 10240, O_VT = 10496;
constexpr int O_RING = 0, O_SCR = 0, SCR = 0, O_CST = RING * REC  , O_FLAG = O_CST + 1536  ;
constexpr int GRING = 16;
#define CK_MFMA(a, b, c) __builtin_amdgcn_mfma_f32_16x16x32_bf16(a, b, c, 0, 0, 0)
__device__ __forceinline__ float b2f(unsigned v) { return __builtin_bit_cast(float, v << 16); }
__device__ __forceinline__ unsigned f2b(float f) { unsigned u = __builtin_bit_cast(unsigned, f); return (u + 0x7fffu + ((u >> 16) & 1u)) >> 16; }
typedef float f32x2_t __attribute__((ext_vector_type(2))); typedef __bf16 bf16x2_t __attribute__((ext_vector_type(2)));
__device__ __forceinline__ unsigned pk(float lo, float hi) { f32x2_t v = {lo, hi}; bf16x2_t b = __builtin_convertvector(v, bf16x2_t); return __builtin_bit_cast(unsigned, b); }
template <int CTRL> __device__ __forceinline__ float dppf(float v) { return __builtin_bit_cast(float, __builtin_amdgcn_update_dpp(0, __builtin_bit_cast(int, v), CTRL, 0xF, 0xF, true)); }
__device__ __forceinline__ float sum8(float x) { x += dppf<0xB1>(x); x += dppf<0x4E>(x); x += dppf<0x141>(x); return x; }
__device__ __forceinline__ s16x4 vtr(const CLAS unsigned char* p) { return __builtin_bit_cast(s16x4, __builtin_amdgcn_ds_read_tr16_b64_v4i16((CLAS v4i16_t*)p)); }
__device__ __forceinline__ unsigned ldw(volatile CLAS unsigned* p) { return *p; }
#define CK_U(w_, e_) b2f(((e_) & 1) ? ((w_)[(e_) >> 1] >> 16) : ((w_)[(e_) >> 1] & 0xffffu))
#define CK_H(w_, e_) ((float)__builtin_bit_cast(_Float16, (unsigned short)(((e_) & 1) ? ((w_)[(e_) >> 1] >> 16) : ((w_)[(e_) >> 1] & 0xffffu))))
__device__ __forceinline__ float scan8(float x, int lane, float& total) {
    const float s1 = x + dppf<0x118>(x);
    const float rot = dppf<0x128>(s1);
    const float R = (lane & 8) ? s1 : rot;
    auto r16 = __builtin_amdgcn_permlane16_swap(__float_as_uint(R), __float_as_uint(R), false, false); const unsigned e16 = r16[0], o16 = r16[1];
    const float Reven = __uint_as_float(e16), PT = Reven + __uint_as_float(o16);
    auto r32 = __builtin_amdgcn_permlane32_swap(__float_as_uint(PT), __float_as_uint(PT), false, false); const unsigned lo32 = r32[0], hi32 = r32[1];
    const float PTlo = __uint_as_float(lo32);
    total = PTlo + __uint_as_float(hi32);
    return s1 + ((lane & 32) ? PTlo : 0.f) + ((lane & 16) ? Reven : 0.f); }
__device__ __forceinline__ float xor4(float v) { return dppf<0x1B>(dppf<0x141>(v)); }

struct ScanOps { u32x2 r00, r01, r10, r11, a00, a01, a10, a11, vt, vt2; bf16x8 aie, acc_; s16x4 tb[4], tk[4]; f32x4 pp[4]; };
template <bool rw, bool TWO = false> __device__ __forceinline__ void scan_load(ScanOps& o, const CLAS unsigned char* rec, int n, int g, int n0) {
    const CLAS unsigned char* rr = rec + O_RT + n * 128 + g * 8;
    o.r00 = *(const CLAS u32x2*)(rr); o.r01 = *(const CLAS u32x2*)(rr + 32); o.r10 = *(const CLAS u32x2*)(rr + 64); o.r11 = *(const CLAS u32x2*)(rr + 96);
    o.vt = __builtin_bit_cast(u32x2, vtr(rec + O_VT + (4 * g + (n >> 2)) * 128 + (n0 + 4 * (n & 3)) * 2));
    if (TWO) o.vt2 = __builtin_bit_cast(u32x2, vtr(rec + O_VT + (4 * g + (n >> 2)) * 128 + (n0 + 16 + 4 * (n & 3)) * 2));
    if (rw) { const CLAS unsigned char* ra = rec + O_AT + n * 128 + g * 8;
        o.a00 = *(const CLAS u32x2*)(ra); o.a01 = *(const CLAS u32x2*)(ra + 32); o.a10 = *(const CLAS u32x2*)(ra + 64); o.a11 = *(const CLAS u32x2*)(ra + 96);
        o.aie = *(const CLAS bf16x8*)(rec + O_IE + n * 64 + g * 16); }
    o.acc_ = *(const CLAS bf16x8*)(rec + O_CC + n * 64 + g * 16);
    const CLAS unsigned char* tb = rec + O_BT + (4 * g + (n >> 2)) * 128 + (n & 3) * 8;
    const CLAS unsigned char* tk_ = rec + O_KT + (4 * g + (n >> 2)) * 128 + (n & 3) * 8;
#pragma unroll
    for (int m = 0; m < 4; ++m) { if (rw) o.tb[m] = vtr(tb + m * 32); o.tk[m] = vtr(tk_ + m * 32); if (rw) o.pp[m] = *(const CLAS f32x4*)(rec + O_P15 + (m * 16 + 4 * g) * 4); }
}
template <bool rw, int probe = 0> __device__ __forceinline__ void scan_wave(CLAS unsigned char* lds, volatile CLAS unsigned* flag, int wave, int lane, int n0, int hh, size_t mb, bf16* YR) {
    const int n = lane & 15, g = lane >> 4;
    f32x4 S0 = {0.f, 0.f, 0.f, 0.f}, S1 = S0, S2 = S0, S3 = S0;
    const float g16 = exp2f(16.f * log2f(1.f - exp2f(-5.f - (float)hh)));
    bf16* yo = YR + (mb + 4 * g) * 1024 + (rw ? 0 : 512) + hh * 64 + n0 + n;
    ScanOps A, B;
#define CK_WAITREADY(blk_) do { unsigned sp = 0; while (ldw(flag + ((blk_) % RING)) != (unsigned)((blk_) + 1)) { __builtin_amdgcn_s_sleep(1); if (++sp > (1u << 22)) break; } asm volatile("" ::: "memory"); } while (0)
#define CK_UPD(O, Sm, m) do { s16x4 tb_ = {0, 0, 0, 0}; if (rw) tb_ = O.tb[m]; const s16x4 tk2_ = O.tk[m]; \
        const bf16x8 abk = (bf16x8){tb_[0], tb_[1], tb_[2], tb_[3], tk2_[0], tk2_[1], tk2_[2], tk2_[3]}; Sm = CK_MFMA(abk, fu, Sm); \
        if (rw) { Sm = Sm * O.pp[m]; } else { Sm = Sm * g16; } } while (0)
#define CK_BLOCK(O, N, blk_) do { \
        asm volatile("s_waitcnt lgkmcnt(0)" ::: "memory"); \
        if (lane == 0) flag[12 + wave] = (unsigned)((blk_) + 1); \
        if ((blk_) + 1 < NBLK) { CK_WAITREADY((blk_) + 1); scan_load<rw>(N, lds + O_RING + (((blk_) + 1) % RING) * REC, n, g, n0); } \
        if (probe == 2) break; \
        const bf16x8 sb0 = __builtin_bit_cast(bf16x8, (u32x4){pk(S0[0], S0[1]), pk(S0[2], S0[3]), pk(S1[0], S1[1]), pk(S1[2], S1[3])}); \
        const bf16x8 sb1 = __builtin_bit_cast(bf16x8, (u32x4){pk(S2[0], S2[1]), pk(S2[2], S2[3]), pk(S3[0], S3[1]), pk(S3[2], S3[3])}); \
        f32x4 ZT = {0.f, 0.f, 0.f, 0.f}, YT = {0.f, 0.f, 0.f, 0.f}; \
        u32x4 fz; fz[0] = 0u; fz[1] = 0u; fz[2] = O.vt[0]; fz[3] = O.vt[1]; \
        if (rw) { \
            ZT = CK_MFMA(__builtin_bit_cast(bf16x8, (u32x4){O.a00[0], O.a00[1], O.a01[0], O.a01[1]}), sb0, ZT); \
            ZT = CK_MFMA(__builtin_bit_cast(bf16x8, (u32x4){O.a10[0], O.a10[1], O.a11[0], O.a11[1]}), sb1, ZT); } \
        YT = CK_MFMA(__builtin_bit_cast(bf16x8, (u32x4){O.r00[0], O.r00[1], O.r01[0], O.r01[1]}), sb0, YT); \
        YT = CK_MFMA(__builtin_bit_cast(bf16x8, (u32x4){O.r10[0], O.r10[1], O.r11[0], O.r11[1]}), sb1, YT); \
        if (rw) { fz[0] = pk(ZT[0], ZT[1]); fz[1] = pk(ZT[2], ZT[3]); \
            const f32x4 zero = {0.f, 0.f, 0.f, 0.f}; \
            const f32x4 UT = CK_MFMA(O.aie, __builtin_bit_cast(bf16x8, fz), zero); \
            fz[0] = pk(UT[0], UT[1]); fz[1] = pk(UT[2], UT[3]); } \
        const bf16x8 fu = __builtin_bit_cast(bf16x8, fz); \
        CK_UPD(O, S0, 0); CK_UPD(O, S1, 1); CK_UPD(O, S2, 2); CK_UPD(O, S3, 3); \
        YT = CK_MFMA(O.acc_, fu, YT); \
        bf16* yp = yo + (size_t)(blk_) * 16 * 1024; \
        { const unsigned y01 = pk(YT[0], YT[1]), y23 = pk(YT[2], YT[3]); yp[0] = (bf16)y01; yp[1024] = (bf16)(y01 >> 16); yp[2048] = (bf16)y23; yp[3072] = (bf16)(y23 >> 16); } \
    } while (0)
    CK_WAITREADY(0); scan_load<rw>(A, lds + O_RING, n, g, n0);
    for (int blk = 0; blk < NBLK; blk += 2) {
#ifdef PROBE_SCAN_DELAY
        if (rw) __builtin_amdgcn_s_sleep(PROBE_SCAN_DELAY);
#endif
        CK_BLOCK(A, B, blk);
        CK_BLOCK(B, A, blk + 1);
    }
#undef CK_BLOCK
#undef CK_UPD
#undef CK_WAITREADY
}
template <bool rw, int probe = 0> __device__ __forceinline__ void scan_wave2(CLAS unsigned char* lds, volatile CLAS unsigned* flag, int wave, int lane, int n0, int hh, size_t mb, bf16* YR) {
    const int n = lane & 15, g = lane >> 4;
    f32x4 S0 = {0.f, 0.f, 0.f, 0.f}, S1 = S0, S2 = S0, S3 = S0, T0 = S0, T1 = S0, T2 = S0, T3 = S0;
    const float g16 = exp2f(16.f * log2f(1.f - exp2f(-5.f - (float)hh)));
    bf16* yo = YR + (mb + 4 * g) * 1024 + (rw ? 0 : 512) + hh * 64 + n0 + n;
    ScanOps A, B;
#define CK_WAITREADY(blk_) do { unsigned sp = 0; while (ldw(flag + ((blk_) % RING)) != (unsigned)((blk_) + 1)) { __builtin_amdgcn_s_sleep(1); if (++sp > (1u << 22)) break; } asm volatile("" ::: "memory"); } while (0)
#define CK_UPD(O, Sm, m, FU) do { s16x4 tb_ = {0, 0, 0, 0}; if (rw) tb_ = O.tb[m]; const s16x4 tk2_ = O.tk[m]; \
        const bf16x8 abk = (bf16x8){tb_[0], tb_[1], tb_[2], tb_[3], tk2_[0], tk2_[1], tk2_[2], tk2_[3]}; Sm = CK_MFMA(abk, FU, Sm); \
        if (rw) { Sm = Sm * O.pp[m]; } else { Sm = Sm * g16; } } while (0)
#define CK_CHAIN(O, Q0, Q1, Q2, Q3, VT, YOFF, blk_) do { \
        const bf16x8 sb0 = __builtin_bit_cast(bf16x8, (u32x4){pk(Q0[0], Q0[1]), pk(Q0[2], Q0[3]), pk(Q1[0], Q1[1]), pk(Q1[2], Q1[3])}); \
        const bf16x8 sb1 = __builtin_bit_cast(bf16x8, (u32x4){pk(Q2[0], Q2[1]), pk(Q2[2], Q2[3]), pk(Q3[0], Q3[1]), pk(Q3[2], Q3[3])}); \
        f32x4 ZT = {0.f, 0.f, 0.f, 0.f}, YT = {0.f, 0.f, 0.f, 0.f}; \
        u32x4 fz; fz[0] = 0u; fz[1] = 0u; fz[2] = VT[0]; fz[3] = VT[1]; \
        if (rw) { \
            ZT = CK_MFMA(__builtin_bit_cast(bf16x8, (u32x4){O.a00[0], O.a00[1], O.a01[0], O.a01[1]}), sb0, ZT); \
            ZT = CK_MFMA(__builtin_bit_cast(bf16x8, (u32x4){O.a10[0], O.a10[1], O.a11[0], O.a11[1]}), sb1, ZT); } \
        YT = CK_MFMA(__builtin_bit_cast(bf16x8, (u32x4){O.r00[0], O.r00[1], O.r01[0], O.r01[1]}), sb0, YT); \
        YT = CK_MFMA(__builtin_bit_cast(bf16x8, (u32x4){O.r10[0], O.r10[1], O.r11[0], O.r11[1]}), sb1, YT); \
        if (rw) { fz[0] = pk(ZT[0], ZT[1]); fz[1] = pk(ZT[2], ZT[3]); \
            const f32x4 zero = {0.f, 0.f, 0.f, 0.f}; \
            const f32x4 UT = CK_MFMA(O.aie, __builtin_bit_cast(bf16x8, fz), zero); \
            fz[0] = pk(UT[0], UT[1]); fz[1] = pk(UT[2], UT[3]); } \
        const bf16x8 fu = __builtin_bit_cast(bf16x8, fz); \
        CK_UPD(O, Q0, 0, fu); CK_UPD(O, Q1, 1, fu); CK_UPD(O, Q2, 2, fu); CK_UPD(O, Q3, 3, fu); \
        YT = CK_MFMA(O.acc_, fu, YT); \
        bf16* yp = yo + (size_t)(blk_) * 16 * 1024 + (YOFF); \
        { const unsigned y01 = pk(YT[0], YT[1]), y23 = pk(YT[2], YT[3]); yp[0] = (bf16)y01; yp[1024] = (bf16)(y01 >> 16); yp[2048] = (bf16)y23; yp[3072] = (bf16)(y23 >> 16); } \
    } while (0)
#define CK_BLOCK2(O, N, blk_) do { \
        asm volatile("s_waitcnt lgkmcnt(0)" ::: "memory"); \
        if (lane == 0) flag[12 + wave] = (unsigned)((blk_) + 1); \
        if (probe == 2) { if ((blk_) + 1 < NBLK) { CK_WAITREADY((blk_) + 1); scan_load<rw, true>(N, lds + O_RING + (((blk_) + 1) % RING) * REC, n, g, n0); } break; } \
        CK_CHAIN(O, S0, S1, S2, S3, O.vt, 0, blk_); \
          \
        if ((blk_) + 1 < NBLK) { CK_WAITREADY((blk_) + 1); scan_load<rw, true>(N, lds + O_RING + (((blk_) + 1) % RING) * REC, n, g, n0); } \
        CK_CHAIN(O, T0, T1, T2, T3, O.vt2, 16, blk_); \
    } while (0)
    __builtin_amdgcn_s_setprio(2);
    CK_WAITREADY(0); scan_load<rw, true>(A, lds + O_RING, n, g, n0);
    for (int blk = 0; blk < NBLK; blk += 2) {
#ifdef PROBE_SCAN_DELAY
        if (rw) __builtin_amdgcn_s_sleep(PROBE_SCAN_DELAY);
#endif
        CK_BLOCK2(A, B, blk);
        CK_BLOCK2(B, A, blk + 1);
    }
    __builtin_amdgcn_s_setprio(0);
#undef CK_BLOCK2
#undef CK_CHAIN
#undef CK_UPD
#undef CK_WAITREADY
}
template <bool rw, int NP, bool GLOBAL, int probe = 0, int NSCAN = 2> __device__ __forceinline__ void prep_wave(CLAS unsigned char* lds, volatile CLAS unsigned* flag, int pwv, int first, int lane, int hh, size_t mb, bool bonus_on,
        const bf16* PROJ, const bf16* DECB, const bf16* ALPHA, float* BONUS, const f32x2* ROT, unsigned char* gring, unsigned* gflag, unsigned* gack, unsigned ep0) {
    constexpr int HYBW = 3840;
            const int tk = lane >> 3, ch = lane & 7, c0 = hh * 64 + 8 * ch;
            const CLAS float* cst = (const CLAS float*)(lds + O_CST);
            CLAS unsigned char* scr = lds + O_SCR + pwv * SCR;
            const bf16* pr = PROJ + mb * HYBW + c0;
            const float l2g = log2f(1.f - exp2f(-5.f - (float)hh));
            u32x4 LG[2][9];
#define CK_LOAD(rd_, blk_) do { int t_ = (blk_) * 16 + 8 * (rd_) + tk; asm volatile("" : "+v"(t_));     \
                const bf16* p_ = pr + (size_t)t_ * HYBW; \
                if (rw) { const bool hp_ = t_ > 0; const bf16* pp_ = hp_ ? p_ - HYBW : p_; \
                    LG[rd_][0] = *(const u32x4*)(p_); LG[rd_][1] = *(const u32x4*)(p_ + 512); LG[rd_][2] = *(const u32x4*)(p_ + 1024); \
                    LG[rd_][3] = *(const u32x4*)(pp_); LG[rd_][4] = *(const u32x4*)(pp_ + 512); LG[rd_][5] = *(const u32x4*)(pp_ + 1024); \
                    if (!hp_) { LG[rd_][3] = (u32x4){0u, 0u, 0u, 0u}; LG[rd_][4] = LG[rd_][3]; LG[rd_][5] = LG[rd_][3]; } \
                    LG[rd_][6] = *(const u32x4*)(ALPHA + (mb + t_) * 512 + c0); LG[rd_][7] = *(const u32x4*)(DECB + (mb + t_) * 512 + c0); \
                    LG[rd_][8] = (u32x4){0u, 0u, 0u, 0u}; if ((t_ & 15) != 0) LG[rd_][8] = *(const u32x4*)(DECB + (mb + t_ - 1) * 512 + c0); } \
                else { LG[rd_][0] = *(const u32x4*)(p_ + 1792); LG[rd_][1] = *(const u32x4*)(p_ + 2304); LG[rd_][2] = *(const u32x4*)(p_ + 2816); \
                    const u32x4* rp_ = (const u32x4*)(ROT + (size_t)t_ * 32 + 8 * (ch & 3)); LG[rd_][3] = rp_[0]; LG[rd_][4] = rp_[1]; LG[rd_][5] = rp_[2]; LG[rd_][6] = rp_[3]; } } while (0)
#define CK_NEXTBLK() ({ unsigned v_ = 0u; if (lane == 0) v_ = __hip_atomic_fetch_add((CLAS unsigned*)(flag + 16), 1u, __ATOMIC_RELAXED, __HIP_MEMORY_SCOPE_WORKGROUP); (int)__builtin_amdgcn_readfirstlane(v_); })
            int blk = GLOBAL ? first : CK_NEXTBLK();
            if (blk < NBLK) { CK_LOAD(0, blk); CK_LOAD(1, blk); }
            while (blk < NBLK) {
                const int nxt = GLOBAL ? blk + NP : CK_NEXTBLK();
                CLAS unsigned char* rec = lds + O_RING + (GLOBAL ? pwv : (blk % RING)) * REC;
                if (!GLOBAL && blk >= RING) { unsigned sp = 0; const unsigned need = (unsigned)(blk - RING + 1); while (ldw(flag + 12) < need || (NSCAN > 1 && ldw(flag + 13) < need) || (NSCAN > 2 && (ldw(flag + 14) < need || ldw(flag + 15) < need))) { __builtin_amdgcn_s_sleep(2); if (++sp > (1u << 22)) break; } }
                asm volatile("" ::: "memory");
                if (probe == 1) { if (lane == 0) flag[blk % RING] = (unsigned)(blk + 1); blk = nxt; continue; }
#ifdef PROBE_PREP_DELAY
                if (rw) __builtin_amdgcn_s_sleep(PROBE_PREP_DELAY);
#endif
#pragma unroll
                for (int rd = 0; rd < 2; ++rd) {
                    const int j = 8 * rd + tk, t = blk * 16 + j;
                    if (rw) {
                        const u32x4 Lr0 = LG[rd][0], Lk0 = LG[rd][1], Lv0 = LG[rd][2], Lr1 = LG[rd][3], Lk1 = LG[rd][4], Lv1 = LG[rd][5], La = LG[rd][6], Le = LG[rd][7], Lm = LG[rd][8];
                        float r[8], km[8], kkr[8], al[8], vv[8]; float n2 = 0.f, bon = 0.f;
#pragma unroll
                        for (int e = 0; e < 8; ++e) { const float rc = CK_U(Lr0, e), rq = CK_U(Lr1, e), kc = CK_U(Lk0, e), kq = CK_U(Lk1, e), vc = CK_U(Lv0, e), vq = CK_U(Lv1, e);
                            r[e] = rc + (rq - rc) * cst[8 * ch + e]; const float kraw = kc + (kq - kc) * cst[64 + 8 * ch + e]; vv[e] = vc + (vq - vc) * cst[128 + 8 * ch + e];
                            al[e] = CK_U(La, e);
                            kkr[e] = kraw * cst[192 + 8 * ch + e]; km[e] = kraw * (1.f + (al[e] - 1.f) * cst[256 + 8 * ch + e]);
                            n2 += kkr[e] * kkr[e]; bon += r[e] * km[e] * cst[320 + 8 * ch + e]; }
                        if (nxt < NBLK) CK_LOAD(rd, nxt);
                        n2 = sum8(n2); bon = sum8(bon);
                        const float inv = rsqrtf(fmaxf(n2, 1e-24f));
                        if (ch == 0 && bonus_on) BONUS[(mb + t) * 8 + hh] = bon;
                        u32x4 oa, ob, ok, orr; float lpl[8];
#pragma unroll
                        for (int e = 0; e < 8; ++e) {
                            const float lp = CK_H(Le, e), lpm = CK_H(Lm, e); lpl[e] = lp;
                            const float em = __builtin_amdgcn_exp2f(-lp), ep = __builtin_amdgcn_exp2f(lp), epm = __builtin_amdgcn_exp2f(lpm);
                            const float kk = kkr[e] * inv;
                            r[e] = r[e] * ep; km[e] = km[e] * em; kkr[e] = -kk * epm; al[e] = kk * al[e] * em; }
#pragma unroll
                        for (int e = 0; e < 4; ++e) { oa[e] = pk(kkr[2 * e], kkr[2 * e + 1]); ob[e] = pk(al[2 * e], al[2 * e + 1]); ok[e] = pk(km[2 * e], km[2 * e + 1]); orr[e] = pk(r[2 * e], r[2 * e + 1]); }
                        *(CLAS u32x4*)(rec + O_AT + j * 128 + ch * 16) = oa; *(CLAS u32x4*)(rec + O_BT + j * 128 + ch * 16) = ob;
                        *(CLAS u32x4*)(rec + O_KT + j * 128 + ch * 16) = ok; *(CLAS u32x4*)(rec + O_RT + j * 128 + ch * 16) = orr;
#pragma unroll
                        for (int e = 0; e < 8; ++e) { (void)0; }
                        { u32x4 ov; ov[0] = pk(vv[0], vv[1]); ov[1] = pk(vv[2], vv[3]); ov[2] = pk(vv[4], vv[5]); ov[3] = pk(vv[6], vv[7]); *(CLAS u32x4*)(rec + O_VT + j * 128 + ch * 16) = ov; }
                        if (rd == 1 && tk == 7) { *(CLAS f32x4*)(rec + O_P15 + ch * 32) = (f32x4){__builtin_amdgcn_exp2f(lpl[0]), __builtin_amdgcn_exp2f(lpl[1]), __builtin_amdgcn_exp2f(lpl[2]), __builtin_amdgcn_exp2f(lpl[3])};
                            *(CLAS f32x4*)(rec + O_P15 + ch * 32 + 16) = (f32x4){__builtin_amdgcn_exp2f(lpl[4]), __builtin_amdgcn_exp2f(lpl[5]), __builtin_amdgcn_exp2f(lpl[6]), __builtin_amdgcn_exp2f(lpl[7])}; }
                    } else {
                        const u32x4 Lq = LG[rd][0], Lk = LG[rd][1], Lv = LG[rd][2]; f32x4 rot_[4]; rot_[0] = __builtin_bit_cast(f32x4, LG[rd][3]); rot_[1] = __builtin_bit_cast(f32x4, LG[rd][4]); rot_[2] = __builtin_bit_cast(f32x4, LG[rd][5]); rot_[3] = __builtin_bit_cast(f32x4, LG[rd][6]);
                        if (nxt < NBLK) CK_LOAD(rd, nxt);
                        const float pw = __builtin_amdgcn_exp2f((float)(j + 1) * l2g), ipw = 0.125f * __builtin_amdgcn_exp2f(-(float)(j + 1) * l2g);
                        u32x4 oq, ok; float qo[8], ko[8];
#pragma unroll
                        for (int e = 0; e < 8; ++e) { const float cs = rot_[e >> 1][2 * (e & 1)], sn = rot_[e >> 1][2 * (e & 1) + 1]; const float qv = CK_U(Lq, e), kv = CK_U(Lk, e);
                            const float qp = xor4(qv), kp = xor4(kv);
                            qo[e] = (ch < 4 ? qv * cs - qp * sn : qp * sn + qv * cs) * pw; ko[e] = (ch < 4 ? kv * cs - kp * sn : kp * sn + kv * cs) * ipw;
                        }
                        *(CLAS u32x4*)(rec + O_VT + j * 128 + ch * 16) = Lv;
#pragma unroll
                        for (int e = 0; e < 4; ++e) { oq[e] = pk(qo[2 * e], qo[2 * e + 1]); ok[e] = pk(ko[2 * e], ko[2 * e + 1]); }
                        *(CLAS u32x4*)(rec + O_RT + j * 128 + ch * 16) = oq; *(CLAS u32x4*)(rec + O_KT + j * 128 + ch * 16) = ok;
                    }
                }
                asm volatile("s_waitcnt lgkmcnt(0)" ::: "memory");
                const int jc = lane & 15, gg = lane >> 4;
                const bf16x8 bR0 = *(const CLAS bf16x8*)(rec + O_RT + jc * 128 + gg * 16), bR1 = *(const CLAS bf16x8*)(rec + O_RT + jc * 128 + 64 + gg * 16);
                const bf16x8 aK0 = *(const CLAS bf16x8*)(rec + O_KT + jc * 128 + gg * 16), aK1 = *(const CLAS bf16x8*)(rec + O_KT + jc * 128 + 64 + gg * 16);
                const f32x4 zero = {0.f, 0.f, 0.f, 0.f};
                f32x4 crk = CK_MFMA(aK0, bR0, zero); crk = CK_MFMA(aK1, bR1, crk);
#pragma unroll
                for (int r = 0; r < 4; ++r) crk[r] = (4 * gg + r <= jc) ? crk[r] : 0.f;
                if (!rw) {
                    u32x4 w; w[0] = 0u; w[1] = 0u; w[2] = pk(crk[0], crk[1]); w[3] = pk(crk[2], crk[3]);
                    *(CLAS u32x4*)(rec + O_CC + jc * 64 + gg * 16) = w;
                } else {
                    const bf16x8 bA0 = *(const CLAS bf16x8*)(rec + O_AT + jc * 128 + gg * 16), bA1 = *(const CLAS bf16x8*)(rec + O_AT + jc * 128 + 64 + gg * 16);
                    const bf16x8 aB0 = *(const CLAS bf16x8*)(rec + O_BT + jc * 128 + gg * 16), aB1 = *(const CLAS bf16x8*)(rec + O_BT + jc * 128 + 64 + gg * 16);
                    f32x4 crb = CK_MFMA(aB0, bR0, zero); crb = CK_MFMA(aB1, bR1, crb);
                    f32x4 cab = CK_MFMA(aB0, bA0, zero); cab = CK_MFMA(aB1, bA1, cab);
                    f32x4 cba = CK_MFMA(bA0, aB0, zero); cba = CK_MFMA(bA1, aB1, cba);
                    f32x4 cka = CK_MFMA(bA0, aK0, zero); cka = CK_MFMA(bA1, aK1, cka);
                    f32x4 idn;
#pragma unroll
                    for (int r = 0; r < 4; ++r) { crb[r] = (4 * gg + r <= jc) ? crb[r] : 0.f; cab[r] = (4 * gg + r < jc) ? cab[r] : 0.f;
                        cba[r] = (jc < 4 * gg + r) ? cba[r] : 0.f; cka[r] = (jc < 4 * gg + r) ? cka[r] : 0.f; idn[r] = (4 * gg + r == jc) ? 1.f : 0.f; }
                    { u32x4 w; w[0] = pk(crb[0], crb[1]); w[1] = pk(crb[2], crb[3]); w[2] = pk(crk[0], crk[1]); w[3] = pk(crk[2], crk[3]); *(CLAS u32x4*)(rec + O_CC + jc * 64 + gg * 16) = w; }
#define CK_PROD(X, Y, ACC) ({ f32x4 p_ = (ACC); _Pragma("unroll") for (int r_ = 0; r_ < 4; ++r_) p_ = __builtin_amdgcn_mfma_f32_16x16x4f32((X)[r_], (Y)[r_], p_, 0, 0, 0); p_; })
                    const f32x4 d2 = CK_PROD(cab, cba, zero), c2 = CK_PROD(cba, cab, zero);
                    const f32x4 d4 = CK_PROD(c2, d2, zero), c4 = CK_PROD(d2, c2, zero);
                    const f32x4 d8 = CK_PROD(c4, d4, zero);
                    const f32x4 s1 = cba + idn, t1 = cab + idn;
                    const f32x4 s2 = CK_PROD(t1, d2, s1), t2 = CK_PROD(d2, t1, t1);
                    const f32x4 s3 = CK_PROD(t2, d4, s2), t3 = CK_PROD(d4, t2, t2);
                    const f32x4 s4 = CK_PROD(t3, d8, s3), t4 = CK_PROD(d8, t3, t3);
                    const f32x4 et = CK_PROD(t4, cka, zero);
#undef CK_PROD
#pragma unroll
                    for (int r = 0; r < 4; ++r) { const int i = 4 * gg + r;
                        *(CLAS bf16*)(rec + O_IE + i * 64 + ((jc >> 2) * 8 + (jc & 3)) * 2) = (bf16)pk(s4[r], 0.f);
                        *(CLAS bf16*)(rec + O_IE + i * 64 + ((jc >> 2) * 8 + 4 + (jc & 3)) * 2) = (bf16)pk(et[r], 0.f); }
                }
                asm volatile("s_waitcnt lgkmcnt(0)" ::: "memory");
                if (!GLOBAL) { if (lane == 0) flag[blk % RING] = (unsigned)(blk + 1); }
                else {
                    const int gs = blk & (GRING - 1);
                    if (blk >= GRING) { const unsigned need = ep0 + (unsigned)(blk - GRING + 1); unsigned sp = 0;
                        while (__hip_atomic_load(gack + gs * 64, __ATOMIC_RELAXED, __HIP_MEMORY_SCOPE_AGENT) != need) { __builtin_amdgcn_s_sleep(2); if (++sp > (1u << 20)) break; } }
                    unsigned char* gd = gring + (size_t)gs * REC + lane * 16;
#pragma unroll
                    for (int i = 0; i < 13; ++i) { if (i < 12 || lane < 32) { const u32x4 v = *(const CLAS u32x4*)(rec + i * 1024 + lane * 16);
                        asm volatile("global_store_dwordx4 %0, %1, off sc1" :: "v"(gd + i * 1024), "v"(v) : "memory"); } }
                    asm volatile("s_waitcnt vmcnt(0)" ::: "memory");
                    if (lane == 0) __hip_atomic_store(gflag + gs * 64, ep0 + (unsigned)(blk + 1), __ATOMIC_RELAXED, __HIP_MEMORY_SCOPE_AGENT);
                }
                blk = nxt;
            }
#undef CK_NEXTBLK
}

__device__ __forceinline__ void rwkv_consumer(CLAS unsigned char* lds, volatile CLAS unsigned* flag, int wave, int lane, int hh, size_t mb, bf16* YR, const unsigned char* gring, unsigned* gflag, unsigned* gack, unsigned ep0) {
    if (wave < 4) { scan_wave<true, 0>(lds, flag, wave, lane, wave * 16, hh, mb, YR); return; }
    if (wave == 4) {
        int avail = 0; unsigned sp = 0;
        while (avail < NBLK) {
            const int bi = avail + (lane & (GRING - 1));
            const unsigned v = __hip_atomic_load(gflag + (bi & (GRING - 1)) * 64, __ATOMIC_RELAXED, __HIP_MEMORY_SCOPE_AGENT);
            const bool ok = (lane < GRING) && (bi < NBLK) && (v == ep0 + (unsigned)(bi + 1));
            const unsigned long long m = __ballot(ok);
            const int n = __builtin_ctzll(~m);
            if (n > 0) { __builtin_amdgcn_fence(__ATOMIC_ACQUIRE, "agent"); asm volatile("s_waitcnt vmcnt(0)" ::: "memory"); avail += n; if (lane == 0) flag[16] = (unsigned)avail; sp = 0; }
            else { __builtin_amdgcn_s_sleep(1); if (++sp > (1u << 20)) break; }
        }
        if (lane == 0) flag[16] = (unsigned)NBLK;
        return;
    }
    int prev = -1;
    for (int blk = wave - 5; blk < NBLK; blk += 3) {
        const int slot = blk % RING, gs = blk & (GRING - 1);
        if (blk >= RING) { unsigned sp = 0; const unsigned need = (unsigned)(blk - RING + 1);
            while (ldw(flag + 12) < need || ldw(flag + 13) < need || ldw(flag + 14) < need || ldw(flag + 15) < need) { __builtin_amdgcn_s_sleep(1); if (++sp > (1u << 22)) break; } }
        { unsigned sp = 0; while (ldw(flag + 16) <= (unsigned)blk) { __builtin_amdgcn_s_sleep(1); if (++sp > (1u << 22)) break; } }
        asm volatile("" ::: "memory");
        const unsigned char* gsrc = gring + (size_t)gs * REC + lane * 16;
        CLAS unsigned char* dst = lds + O_RING + slot * REC;
#pragma unroll
        for (int i = 0; i < 13; ++i) { if (i < 12 || lane < 32) __builtin_amdgcn_global_load_lds((const unsigned*)(gsrc + i * 1024), (CLAS unsigned*)(dst + i * 1024), 16, 0, 0); }
        if (prev >= 0) { asm volatile("s_waitcnt vmcnt(13)" ::: "memory");
            if (lane == 0) { flag[prev % RING] = (unsigned)(prev + 1); __hip_atomic_store(gack + (prev & (GRING - 1)) * 64, ep0 + (unsigned)(prev + 1), __ATOMIC_RELAXED, __HIP_MEMORY_SCOPE_AGENT); } }
        prev = blk;
    }
    asm volatile("s_waitcnt vmcnt(0)" ::: "memory");
    if (prev >= 0 && lane == 0) { flag[prev % RING] = (unsigned)(prev + 1); __hip_atomic_store(gack + (prev & (GRING - 1)) * 64, ep0 + (unsigned)(prev + 1), __ATOMIC_RELAXED, __HIP_MEMORY_SCOPE_AGENT); }
}

template <int probe = 0> __device__ __forceinline__ void phase(CLAS unsigned char* lds, int bid, int G, int wave, int lane, const bf16* PROJ, const bf16* DECB, const bf16* ALPHA, bf16* YR, float* BONUS, const f32x2* ROT,
                                      const float* mu, const float* k_k, const float* k_a, const float* r_k, unsigned char* gring0, unsigned* gflag0, unsigned* gack0, unsigned ep0) {
    const int vcu = (G % 8 == 0) ? (bid % 8) * (G / 8) + bid / 8 : bid;
    volatile CLAS unsigned* flag = (volatile CLAS unsigned*)(lds + O_FLAG);
    const bool three = (G == 256) && (THREE_ROLE != 0);
    for (int cu = vcu; cu < 256; cu += G) {
        const bool rw = three ? ((cu & 3) < 3) : (cu < 128); const int cc = rw ? cu : cu - 128, role = cu & 3;
        const int bh = three ? (cu >> 2) : (cc >> 1), half = three ? 0 : (cc & 1), b = bh >> 3, hh = bh & 7;
        const size_t mb = (size_t)b * 4096;
        __syncthreads();
        if (wave == 0 && lane < 32) flag[lane] = 0u;
        if (wave == 1) { CLAS float* cst = (CLAS float*)(lds + O_CST); const int c = hh * 64 + lane;
            cst[lane] = mu[c]; cst[64 + lane] = mu[512 + c]; cst[128 + lane] = mu[1024 + c]; cst[192 + lane] = k_k[c]; cst[256 + lane] = k_a[c]; cst[320 + lane] = r_k[c]; }
        __syncthreads();
        if (three) {
            unsigned char* gring = gring0 + (size_t)bh * (GRING * REC); unsigned* gflag = gflag0 + bh * (GRING * 64); unsigned* gack = gack0 + bh * (GRING * 64);
            if (role < 2) prep_wave<true, 16, true, 0, 2>(lds, flag, wave, 2 * wave + role, lane, hh, mb, true, PROJ, DECB, ALPHA, BONUS, ROT, gring, gflag, gack, ep0);
            else if (role == 2) rwkv_consumer(lds, flag, wave, lane, hh, mb, YR, gring, gflag, gack, ep0);
            else { if (wave < 4) scan_wave<false, 0>(lds, flag, wave, lane, wave * 16, hh, mb, YR);
                   else prep_wave<false, 4, false, 0, 4>(lds, flag, wave - 4, wave - 4, lane, hh, mb, false, PROJ, DECB, ALPHA, BONUS, ROT, nullptr, nullptr, nullptr, 0u); }
        } else if (!rw) {
            if (wave < 2) scan_wave<false, probe>(lds, flag, wave, lane, half * 32 + wave * 16, hh, mb, YR);
            else prep_wave<false, 6, false, probe>(lds, flag, wave - 2, wave - 2, lane, hh, mb, false, PROJ, DECB, ALPHA, BONUS, ROT, nullptr, nullptr, nullptr, 0u);
        } else {
            if (wave < 1) scan_wave2<true, probe>(lds, flag, wave, lane, half * 32, hh, mb, YR);
            else prep_wave<true, 7, false, probe, 1>(lds, flag, wave - 1, wave - 1, lane, hh, mb, half == 0, PROJ, DECB, ALPHA, BONUS, ROT, nullptr, nullptr, nullptr, 0u);
        }
    }
    __syncthreads();
}
#undef CK_MFMA
#undef CK_LOAD
#undef CK_U
#undef CK_H
#undef CLAS
}
#ifndef REP_SCAN
#define REP_SCAN 1
#endif
#ifndef REP_DATTN
#define REP_DATTN 1
#endif
#ifndef REP_MLP1
#define REP_MLP1 1
#endif
#ifndef REP_W
#define REP_W 1
#endif
#ifndef REP_XL
#define REP_XL 1
#endif
#ifndef REP_P6
#define REP_P6 1
#endif
#ifndef REP_P9
#define REP_P9 1
#endif
#ifndef LORA_ALIGN
#define LORA_ALIGN false
#endif
#ifndef P1_REV_ODD
#define P1_REV_ODD 1
#endif
#ifndef P1_REV
#define P1_REV 1
#endif
#ifndef REP_P12
#define REP_P12 1
#endif
#ifndef PROBE_P9_MODE
#define PROBE_P9_MODE 0
#endif
#ifndef PROBE_MLP1_HOT
#define PROBE_MLP1_HOT 0
#endif
#ifndef PROBE_MLP1_ROWS
#define PROBE_MLP1_ROWS NTOK
#endif
#ifndef REP_P1
#define REP_P1 1
#endif
#ifndef REP_P3
#define REP_P3 1
#endif
#ifndef HOIST_L2
#define HOIST_L2 0
#endif
#ifndef GROUP_SEAMS
#define GROUP_SEAMS 0
#endif
#ifndef PROBE_CK
#define PROBE_CK 0
#endif
#ifndef PG8_ALIGN_BIG
#define PG8_ALIGN_BIG PG8_ALIGN
#endif
#ifndef PROBE_DATTN_NOBAR
#define PROBE_DATTN_NOBAR false
#endif
#ifndef HOIST_FOLDS
#define HOIST_FOLDS 1
#endif
#ifndef MLP2_REV
#define MLP2_REV 1
#endif
#ifndef REP_LOGITS
#define REP_LOGITS 1
#endif
#ifndef REP_NORM
#define REP_NORM 1
#endif
struct Args { const float* in[34]; float* out; unsigned char* ws; int ph_lo, ph_hi, li, pad; };
typedef const __attribute__((address_space(4))) Args* ArgsP;
__device__ __forceinline__ const float* ldarg(ArgsP p, int k) { asm volatile("" : "+s"(p)); return p->in[k]; }
#define INP(k) ldarg(ap0, k)
__device__ __forceinline__ bf16* wptr(unsigned char* ws, unsigned char* outb, int layer, int which) {
    const bool odd = layer & 1;
    unsigned char* ob = outb + 64 * MiB;
    unsigned char* eb = (layer == 0 || !HOIST_L2) ? ws + WS_W : outb + 92 * MiB;
    switch (which) {
        case 0: return (bf16*)(odd ? ob : eb + WO_IN * 2);
        case 1: return (bf16*)(odd ? ob + 6 * MiB : eb + WO_OUT * 2);
        case 2: return (bf16*)(odd ? ob + 8 * MiB : eb + WO_Q * 2);
        case 3: return (bf16*)(odd ? ob + 10 * MiB : eb + WO_O * 2);
        case 4: return (bf16*)(odd ? ob + 12 * MiB : eb + WO_1 * 2);
        case 5: return (bf16*)(odd ? ob + 20 * MiB : eb + WO_2 * 2);
        default: return (bf16*)(eb + WO_KV * 2);
    }
}
__device__ __forceinline__ void convert_layer(ArgsP ap0, unsigned char* ws, unsigned char* outb, int layer, int gwv, int ngw, int gt, int ngt, int lane, LAS float* scr) {
    const int li = layer >> 1; const bool even = (layer & 1) == 0;
    bf16* Win = wptr(ws, outb, layer, 0); bf16* Wout = wptr(ws, outb, layer, 1); bf16* Wq = wptr(ws, outb, layer, 2); bf16* Wo = wptr(ws, outb, layer, 3);
    bf16* W1 = wptr(ws, outb, layer, 4); bf16* W2 = wptr(ws, outb, layer, 5); bf16* Wkv = wptr(ws, outb, layer, 6);
            const int nin = even ? HYB : QKVW;
            const float* w_in = even ? INP(13) + (size_t)li * 1024 * HYB : INP(27) + (size_t)li * 1024 * QKVW;
            const float* w_out = even ? INP(26) + (size_t)li * 1024 * 1024 : INP(33) + (size_t)li * 1024 * 1024;
            const float* w_q = INP(8) + (size_t)layer * 1024 * 1024; const float* w_kv = INP(9) + (size_t)layer * 1024 * 2048; const float* w_o = INP(10) + (size_t)layer * 1024 * 1024;
            const float* w_1 = INP(11) + (size_t)layer * 1024 * 4096; const float* w_2 = INP(12) + (size_t)layer * 4096 * 1024;
            const int c_in = 16 * (nin / 32), c_sq = 16 * 32, c_kv = even ? 2 * 16 * 64 : 0, c_1 = 16 * 128, c_2 = 64 * 32;
            const int total = c_in + 2 * c_sq + c_kv + c_1 + c_2;
            for (int it = gwv; it < total; it += ngw) {
                int r = it;
                if (r < c_in) { transpose_item(w_in, 1024, nin, Win, scr, r, lane, INP(5) + layer * 1024); continue; } r -= c_in;
                if (r < c_sq) { transpose_item(w_out, 1024, 1024, Wout, scr, r, lane, nullptr); continue; } r -= c_sq;
                if (r < c_kv) { if (r < 16 * 64) transpose_item(w_kv, 1024, 2048, Wkv, scr, r, lane, nullptr); else transpose_item(w_kv + (size_t)1024 * 2048, 1024, 2048, (bf16*)(ws + WS_WKV2), scr, r - 16 * 64, lane, nullptr); continue; } r -= c_kv;
                if (r < c_sq) { transpose_item(w_o, 1024, 1024, Wo, scr, r, lane, nullptr); continue; } r -= c_sq;
                if (r < c_1) { transpose_item(w_1, 1024, 4096, W1, scr, r, lane, INP(7) + layer * 1024); continue; } r -= c_1;
                transpose_item(w_2, 4096, 1024, W2, scr, r, lane, nullptr);
            }
            for (int i = gt * 8; i < 1024 * 1024; i += ngt * 8) {
                const float g_ = INP(6)[layer * 1024 + (i >> 10)]; const f32x4 a = __builtin_nontemporal_load((const f32x4*)(w_q + i)) * g_, c = __builtin_nontemporal_load((const f32x4*)(w_q + i + 4)) * g_; v4u o; o.x = pk2(a.x, a.y); o.y = pk2(a.z, a.w); o.z = pk2(c.x, c.y); o.w = pk2(c.z, c.w); *(v4u*)(Wq + i) = o; }
            if (even) {
                const float* w2 = INP(16) + (size_t)li * 64 * 512; const float* a2 = INP(18) + (size_t)li * 64 * 512; const float* g2 = INP(19) + (size_t)li * 128 * 512;
                for (int i = gt; i < 1536 * 32; i += ngt) { const int n = i >> 5, k0 = (i & 31) * 8; float v[8];
#pragma unroll
                    for (int e = 0; e < 8; ++e) { const int k = k0 + e; v[e] = n < 512 ? (k < 64 ? w2[k * 512 + n] : 0.f) : n < 1024 ? ((k >= 64 && k < 128) ? a2[(k - 64) * 512 + n - 512] : 0.f) : (k >= 128 ? g2[(k - 128) * 512 + n - 1024] : 0.f); }
                    v4u o; o.x = pk2(v[0], v[1]); o.y = pk2(v[2], v[3]); o.z = pk2(v[4], v[5]); o.w = pk2(v[6], v[7]); *(v4u*)((bf16*)(ws + WS_LW) + (size_t)n * 256 + k0) = o; }
            }
}
__global__ void __launch_bounds__(NWAVES * 64, 2) fwd(Args args) {
    const ArgsP ap0 = (ArgsP)__builtin_amdgcn_kernarg_segment_ptr();
#define INP(k) ldarg(ap0, k)
    extern __shared__ __attribute__((aligned(16))) unsigned char lds_raw[];
    LAS unsigned char* lds = (LAS unsigned char*)lds_raw;
    const int tid0 = threadIdx.x; const int wave0 = __builtin_amdgcn_readfirstlane(tid0 >> 6);
    const int G = gridDim.x, bid = blockIdx.x, NGW = G * NWAVES;
    unsigned char* ws = args.ws;
    for (int u = tid0; u < (LDS_BYTES - LDSCTL_OFF) / 4; u += NWAVES * 64) ((LAS unsigned*)(lds + LDSCTL_OFF))[u] = 0u;
    __syncthreads();
    volatile LAS unsigned* MISC = (volatile LAS unsigned*)(lds + MISC_OFF);
    XcdBarrier bar = xcd_barrier_post((unsigned*)(ws + WS_CTL) + CW_BAR + args.li * XCD_BAR_WORDS, MISC + 8);
    const int lo = args.ph_lo, hi = args.ph_hi;
#define IN(k) (lo <= (k) && (k) < hi)
#define PHASE_IDS() int lane; asm volatile("v_mbcnt_lo_u32_b32 %0, -1, 0\n\tv_mbcnt_hi_u32_b32 %0, -1, %0" : "=v"(lane)); const int tid = wave0 * 64 + lane, wave = wave0, gw = bid * NWAVES + wave; (void)tid; (void)gw
#define SEAM2(k, nx) do { if (IN(k) && IN(nx)) xcd_barrier(bar, wave0); } while (0)
    unsigned* gcnt = (unsigned*)(ws + WS_CTL + 128 * 1024) + (bid & 7) * 64 + args.li * 1024; unsigned ggen = 0u; const bool grouped = (G % 8 == 0) && GROUP_SEAMS;
#define SEAMG(k, nx) do { if (IN(k) && IN(nx)) { if (grouped) grp_barrier(gcnt, (unsigned)(G / 8), ggen, (unsigned*)(ws + WS_CTL) + CW_BAR + args.li * XCD_BAR_WORDS + XB_TMO); else xcd_barrier(bar, wave0); } } while (0)
    const float* x = INP(0); float* out = args.out; bf16* U = (bf16*)args.out;
    bf16* MEMN = (bf16*)(ws + WS_MEMN); bf16* KVB = (bf16*)(ws + WS_KV); bf16* WB = (bf16*)(ws + WS_W); bf16* HN = (bf16*)(ws + WS_HN); bf16* BIG = (bf16*)(ws + WS_BIG);
    bf16* WQK = (bf16*)(ws + WS_WQK); bf16* VWO = (bf16*)(ws + WS_VWO); bf16* LW = (bf16*)(ws + WS_LW); bf16* XL = (bf16*)(ws + WS_XL);
    bf16* DECB = (bf16*)(ws + WS_DEC); bf16* ALPHA = (bf16*)(ws + WS_ALPHA); bf16* GGB = (bf16*)(ws + WS_G); float* BONUS = (float*)(ws + WS_BONUS); float* SSP = (float*)(ws + WS_SSP); mix::f32x2* ROT = (mix::f32x2*)(ws + WS_ROT);

    for (int layer = 0; layer < 4; ++layer) {
        const int pb = layer * PH_PER_LAYER, li = layer >> 1; const bool even = (layer & 1) == 0;
        unsigned char* outb = (unsigned char*)args.out;
        bf16* Win = wptr(ws, outb, layer, 0); bf16* Wout = wptr(ws, outb, layer, 1); bf16* Wq = wptr(ws, outb, layer, 2); bf16* Wo = wptr(ws, outb, layer, 3); bf16* W1 = wptr(ws, outb, layer, 4); bf16* W2 = wptr(ws, outb, layer, 5);
        const bool foldh = HOIST_FOLDS && even && (G == 256) && !THREE_ROLE && !HOIST_L2;
        bf16* WQKl = foldh ? (bf16*)(outb + 92 * MiB) : WQK; bf16* VWOl = foldh ? (bf16*)(outb + 108 * MiB) : VWO;
        bf16* Ua = U; bf16* Ub = U;
        if ((layer == 0 || (!HOIST_L2 && even)) && IN(pb + 0)) for (int rep_ = 0; rep_ < REP_W; ++rep_) { if (rep_) xcd_barrier(bar, wave0); PHASE_IDS();
            LAS float* scr = (LAS float*)(lds + wave * 16384);
            convert_layer(ap0, ws, (unsigned char*)args.out, layer, gw, NGW, bid * 512 + tid, G * 512, lane, scr);
            if (layer == 0) {
                for (int i = bid * 512 + tid; i < 4096 * 32; i += G * 512) { const int t = i >> 5, fi = i & 31; const float inv = exp2f(-(float)(2 * fi) * (1.f / 64.f) * 13.287712379549449f); const float ang = (float)t * inv;
                    float sn, cs; sincosf(ang, &sn, &cs); mix::f32x2 v; v.x = cs; v.y = sn; ROT[i] = v; }
                for (int m = gw; m < MROWS; m += NGW) rms_row_to_bf16(INP(1) + (size_t)m * 1024, INP(3), MEMN + (size_t)m * 1024, lane);
            }
            if (layer == 0) for (int m = gw; m < NTOK; m += 4 * NGW) rows4_to_bf16_ss(x, Ua, SSP, m, NGW, NTOK, lane);
        }
        if (layer == 0 || (!HOIST_L2 && even)) SEAM2(pb + 0, pb + 1);
        if (IN(pb + 1)) for (int rep_ = 0; rep_ < REP_P1; ++rep_) { if (rep_) xcd_barrier(bar, wave0); PHASE_IDS();
            if (even) { const pg8::Gemm g = pg8::gemm_plain(Ua, Win, NTOK, HYB, 1024); pg8::StaticOrder S; S.init(g, G, bid); S.rev = P1_REV;     pg8::EpiBf16<0, true> E{BIG, HYB, 1, 0, 0, 1.f, 0, SSP, (LAS float*)(lds + XCH_OFF + 8192)};
                pg8::gemm_phase<pg8::EpiBf16<0, true>, pg8::StaticOrder, PG8_ALIGN_BIG, PG8_SP2>(lds, g, S, E, tid); }
            else { const pg8::Gemm g = pg8::gemm_plain(Ua, Win, NTOK, QKVW, 1024); pg8::StaticOrder S; S.init(g, G, bid); S.rev = P1_REV_ODD; pg8::EpiBf16<0, true> E{BIG, QKVW, 1, 0, 0, dattn::C2, 1024, SSP, (LAS float*)(lds + XCH_OFF + 8192)};
                pg8::gemm_phase<pg8::EpiBf16<0, true>, pg8::StaticOrder, PG8_ALIGN_BIG, PG8_SP2>(lds, g, S, E, tid); }
            if (even) {
                { const pg8::Gemm g = pg8::gemm_plain(MEMN, wptr(ws, outb, layer, 6), MROWS, 2048, 1024); pg8::StaticOrder S; S.init(g, G, (bid + G / 2) % G); pg8::EpiBf16<0> E{KVB, 2048, 1, 0, 0, 1.f, 0, nullptr, nullptr};
                  pg8::gemm_phase<pg8::EpiBf16<0>, pg8::StaticOrder, PG8_ALIGN, PG8_SP2>(lds, g, S, E, tid); }
                { const pg8::Gemm g = pg8::gemm_plain(MEMN, (const bf16*)(ws + WS_WKV2), MROWS, 2048, 1024); pg8::StaticOrder S; S.init(g, G, (bid + G / 4) % G); pg8::EpiBf16<0> E{(bf16*)(ws + WS_KV2), 2048, 1, 0, 0, 1.f, 0, nullptr, nullptr};
                  pg8::gemm_phase<pg8::EpiBf16<0>, pg8::StaticOrder, PG8_ALIGN, PG8_SP2>(lds, g, S, E, tid); }
            }
        }
        if (even) {
            SEAM2(pb + 1, pb + 3);
            if (IN(pb + 3)) for (int rep_ = 0; rep_ < REP_P3; ++rep_) { if (rep_) xcd_barrier(bar, wave0); { PHASE_IDS(); const pg8::Gemm g = pg8::gemm_plain(XL, LW, NTOK, 1536, 256); pg8::PanelOrder S; S.init(g, G, bid);
                  pg8::Unit u_; int last = -1; for (int i = 0; S.next(i, u_); ++i) if (u_.pm != last) { last = u_.pm; mix::xl_phase(tid, 512, BIG, INP(14) + li * 1792, XL, u_.pm * 256, 256); } }
                asm volatile("s_waitcnt vmcnt(0)" ::: "memory"); __syncthreads();
                PHASE_IDS(); const pg8::Gemm g = pg8::gemm_plain(XL, LW, NTOK, 1536, 256); pg8::PanelOrder S; S.init(g, G, bid);
                pg8::EpiLora E{ws, WS_DEC, WS_ALPHA, WS_G, INP(15) + li * 512, INP(17) + li * 512};
                pg8::gemm_phase<pg8::EpiLora, pg8::PanelOrder, LORA_ALIGN, PG8_SP2>(lds, g, S, E, tid); }
            SEAM2(pb + 3, pb + 4);
            if (IN(pb + 4)) for (int rep_ = 0; rep_ < REP_SCAN; ++rep_) { if (rep_) xcd_barrier(bar, wave0); PHASE_IDS();
                if (rep_ + 1 < REP_SCAN) ck::phase<PROBE_CK>(lds, bid, G, wave, lane, BIG, DECB, ALPHA, HN, BONUS, (const ck::f32x2*)ROT, INP(14) + li * 1792, INP(20) + li * 512, INP(21) + li * 512, INP(22) + li * 512,
                    ws + WS_XL, (unsigned*)(ws + WS_CTL + 256 * 1024), (unsigned*)(ws + WS_CTL + 512 * 1024), (unsigned)(li * REP_SCAN + rep_) * 1024u);
                else ck::phase<0>(lds, bid, G, wave, lane, BIG, DECB, ALPHA, HN, BONUS, (const ck::f32x2*)ROT, INP(14) + li * 1792, INP(20) + li * 512, INP(21) + li * 512, INP(22) + li * 512,
                    ws + WS_XL, (unsigned*)(ws + WS_CTL + 256 * 1024), (unsigned*)(ws + WS_CTL + 512 * 1024), (unsigned)(li * REP_SCAN + rep_) * 1024u); }
            if (IN(pb + 4)) { PHASE_IDS();
                    LAS float* scr = (LAS float*)(lds + wave * 16384);
                    const int vcu_ = (G % 8 == 0) ? (bid % 8) * (G / 8) + bid / 8 : bid;
                    if (foldh && vcu_ >= 128) {
                        { const pg8::Gemm g{KVB, Wq, 256, 1024, 256, 2048, 1024, 32, 4, (size_t)256 * 2048, 256, 0, 256}; pg8::StaticOrder S; S.init(g, 128, vcu_ - 128);
                          pg8::EpiBf16<0> E{WQKl, 1024, 4, (size_t)1024 * 1024, (size_t)256 * 1024, 0.0625f * 1.4426950408889634f, 1 << 30, nullptr, nullptr};
                          pg8::gemm_phase<pg8::EpiBf16<0>, pg8::StaticOrder, PG8_ALIGN, PG8_SP2>(lds, g, S, E, tid); }
                        { const pg8::Gemm g{Wo, KVB + 1024, 1024, 256, 256, 1024, 2048, 32, 4, 0, 256, (size_t)256 * 2048, 256}; pg8::StaticOrder S; S.init(g, 128, vcu_ - 128);
                          pg8::EpiBf16<0> E{VWOl, 1024, 4, (size_t)1024 * 1024, 256, 1.f, 0, nullptr, nullptr};
                          pg8::gemm_phase<pg8::EpiBf16<0>, pg8::StaticOrder, PG8_ALIGN, PG8_SP2>(lds, g, S, E, tid); }
                        __syncthreads(); }
                    for (int nl = layer + 1; nl <= ((layer == 0 && HOIST_L2) ? 2 : layer + 1); ++nl) {
                        if (G == 256 && THREE_ROLE) { const int role_ = vcu_ & 3, hidx = (vcu_ >> 2) * 3 + (role_ == 3 ? 2 : role_);
                            if (role_ != 2) convert_layer(ap0, ws, (unsigned char*)args.out, nl, hidx * NWAVES + wave, 192 * NWAVES, hidx * 512 + tid, 192 * 512, lane, scr); }
                        else if (G == 256) { if (vcu_ >= 128) convert_layer(ap0, ws, (unsigned char*)args.out, nl, (vcu_ - 128) * NWAVES + wave, 128 * NWAVES, (vcu_ - 128) * 512 + tid, 128 * 512, lane, scr); }
                        else convert_layer(ap0, ws, (unsigned char*)args.out, nl, gw, NGW, bid * 512 + tid, G * 512, lane, scr); } }
            SEAM2(pb + 4, pb + 5);
            if (IN(pb + 5)) { PHASE_IDS(); mix::post_phase_v(gw, NGW, lane, BIG, HN, GGB, BONUS, INP(14) + li * 1792 + 1024, INP(23) + li * 512, INP(24) + li * 512, INP(25) + li * 512); }
            SEAM2(pb + 5, pb + 6);
        } else {
            SEAM2(pb + 1, pb + 4);
            if (IN(pb + 4)) for (int rep_ = 0; rep_ < REP_DATTN; ++rep_) { if (rep_) xcd_barrier(bar, wave0); PHASE_IDS();
                const float lam_init = layer == 1 ? 0.35550906f : 0.55605818f;
                const float d1 = wave_sum(INP(28)[li * 64 + lane] * INP(29)[li * 64 + lane]), d2 = wave_sum(INP(30)[li * 64 + lane] * INP(31)[li * 64 + lane]);
                const float lam = expf(d1) - expf(d2) + lam_init;
                if (rep_ + 1 < REP_DATTN) dattn::phase<PROBE_DATTN_NOBAR>(lds, bid, G, tid, BIG, HN, INP(2), INP(32) + li * 128, lam, lam_init);
                else dattn::phase<false>(lds, bid, G, tid, BIG, HN, INP(2), INP(32) + li * 128, lam, lam_init); }
            SEAM2(pb + 4, pb + 6);
        }
        if (IN(pb + 6)) for (int rep_ = 0; rep_ < REP_P6; ++rep_) { if (rep_) xcd_barrier(bar, wave0); PHASE_IDS();
            { const pg8::Gemm g = pg8::gemm_plain(HN, Wout, NTOK, 1024, 1024); pg8::StaticOrder S; S.init(g, G, bid); pg8::EpiResid E{Ua, rep_ + 1 < REP_P6 ? BIG : Ub, 1024, 0, SSP, (LAS float*)(lds + XCH_OFF), NTOK};
              pg8::gemm_phase<pg8::EpiResid, pg8::StaticOrder, PG8_ALIGN, PG8_SP2>(lds, g, S, E, tid); }
            const bf16* KVc = (const bf16*)(ws + WS_KV + (size_t)(layer & 1) * (WS_KV2 - WS_KV));
            if (!foldh) { const pg8::Gemm g{KVc, Wq, 256, 1024, 256, 2048, 1024, 32, 4, (size_t)256 * 2048, 256, 0, 256}; pg8::StaticOrder S; S.init(g, G, bid);
              pg8::EpiBf16<0> E{WQKl, 1024, 4, (size_t)1024 * 1024, (size_t)256 * 1024, 0.0625f * 1.4426950408889634f, 1 << 30, nullptr, nullptr};
              pg8::gemm_phase<pg8::EpiBf16<0>, pg8::StaticOrder, PG8_ALIGN, PG8_SP2>(lds, g, S, E, tid); }
            if (!foldh) { const pg8::Gemm g{Wo, KVc + 1024, 1024, 256, 256, 1024, 2048, 32, 4, 0, 256, (size_t)256 * 2048, 256}; pg8::StaticOrder S; S.init(g, G, (bid + G / 2) % G);
              pg8::EpiBf16<0> E{VWOl, 1024, 4, (size_t)1024 * 1024, 256, 1.f, 0, nullptr, nullptr};
              pg8::gemm_phase<pg8::EpiBf16<0>, pg8::StaticOrder, PG8_ALIGN, PG8_SP2>(lds, g, S, E, tid); }
        }
        SEAMG(pb + 6, pb + 8);
        if (IN(pb + 8)) for (int rep_ = 0; rep_ < REP_LOGITS; ++rep_) { if (rep_) xcd_barrier(bar, wave0); PHASE_IDS(); const pg8::Gemm g{Ub, WQKl, SEQ, 1024, 1024, 1024, 1024, 8, 1, (size_t)SEQ * 1024, 0, (size_t)1024 * 1024, 0}; pg8::StaticOrder S; S.init(g, G, bid);
            pg8::EpiSoftmax E{BIG, 1024, (size_t)SEQ * 1024, (LAS float*)(lds + XCH_OFF), SSP, SEQ, (LAS float*)(lds + XCH_OFF + 8192)};
            pg8::gemm_phase<pg8::EpiSoftmax, pg8::StaticOrder, true, PG8_SP2>(lds, g, S, E, tid); }
        SEAMG(pb + 8, pb + 9);
        if (IN(pb + 9)) for (int rep_ = 0; rep_ < REP_P9; ++rep_) { if (rep_) xcd_barrier(bar, wave0); PHASE_IDS(); const pg8::Gemm g{BIG, VWOl, (rep_ + 1 < REP_P9 && PROBE_P9_MODE == 9) ? 0 : SEQ, 1024, 1024, 1024, 1024, 8, 1, (size_t)SEQ * 1024, 0, (size_t)1024 * 1024, 0}; pg8::StaticOrder S; S.init(g, G, bid); pg8::EpiResid E{Ub, rep_ + 1 < REP_P9 ? HN : Ua, 1024, (size_t)SEQ * 1024, SSP, (LAS float*)(lds + XCH_OFF), SEQ, (rep_ + 1 < REP_P9) ? PROBE_P9_MODE : 0};
            pg8::gemm_phase<pg8::EpiResid, pg8::StaticOrder, PG8_ALIGN, PG8_SP2>(lds, g, S, E, tid); }
        SEAMG(pb + 9, pb + 11);
        if (IN(pb + 11)) for (int rep_ = 0; rep_ < REP_MLP1; ++rep_) { if (rep_) xcd_barrier(bar, wave0); PHASE_IDS(); pg8::Gemm g = pg8::gemm_plain(Ua, W1, (rep_ + 1 < REP_MLP1) ? PROBE_MLP1_ROWS : NTOK, DFF, 1024); if (PROBE_MLP1_HOT == 1 && rep_ + 1 < REP_MLP1) { g.lda = 0; g.ldb = 0; } if (PROBE_MLP1_HOT == 2 && rep_ + 1 < REP_MLP1) { g.M = 256; g.N = 256; g.nz = 2048; g.zdiv = 1; g.sA1 = 0; g.sA2 = 0; g.sB1 = 0; g.sB2 = 0; }     pg8::StaticOrder S; S.init(g, G, bid); pg8::EpiBf16<1, true> E{BIG, DFF, 1, 0, 0, 1.f, 0, SSP, (LAS float*)(lds + XCH_OFF + 8192)};
            pg8::gemm_phase<pg8::EpiBf16<1, true>, pg8::StaticOrder, PG8_ALIGN_BIG, PG8_SP2>(lds, g, S, E, tid); }
        SEAMG(pb + 11, pb + 12);
        if (IN(pb + 12)) for (int rep_ = 0; rep_ < REP_P12; ++rep_) { if (rep_) xcd_barrier(bar, wave0); PHASE_IDS(); pg8::Gemm g = pg8::gemm_plain(BIG, W2, NTOK, 1024, DFF); g.krev = MLP2_REV ? 2 : 0; pg8::StaticOrder S; S.init(g, G, bid); S.rev = MLP2_REV;     pg8::EpiResid E{Ua, (layer == 3 || rep_ + 1 < REP_P12) ? HN : Ub, 1024, 0, SSP, (LAS float*)(lds + XCH_OFF), NTOK};
            pg8::gemm_phase<pg8::EpiResid, pg8::StaticOrder, PG8_ALIGN, PG8_SP2>(lds, g, S, E, tid); }
        if (layer < 3) SEAMG(pb + 12, pb + 13); else SEAM2(pb + 12, pb + 13);
    }
    if (IN(PH_FINAL)) { PHASE_IDS(); for (int m = gw; m < NTOK; m += 4 * NGW) rows4_bf16_to_f32_norm(HN, INP(4), out, m, NGW, NTOK, lane); }
#undef IN
#undef SEAM2
#undef SEAMG
}

extern "C" void kernel_launch(void* const* d_in, const int* in_sizes, int n_in, void* d_out, int out_size, void* d_ws, size_t ws_size, hipStream_t stream) {
    static int grid = 0;
    if (grid == 0) {
        if (n_in != 34 || out_size != NTOK * DM || ws_size < WS_END) { fprintf(stderr, "kernel_launch: unexpected shapes (n_in %d out %d ws %zu)\n", n_in, out_size, ws_size); grid = -1; return; }
        int dev = 0, cus = 0;
        if (hipGetDevice(&dev) != hipSuccess || hipDeviceGetAttribute(&cus, hipDeviceAttributeMultiprocessorCount, dev) != hipSuccess) { grid = -1; return; }
        if (hipFuncSetAttribute((const void*)fwd, hipFuncAttributeMaxDynamicSharedMemorySize, LDS_BYTES) != hipSuccess) { grid = -1; return; }
        int per_cu = 0;
        (void)hipOccupancyMaxActiveBlocksPerMultiprocessor(&per_cu, (const void*)fwd, NWAVES * 64, LDS_BYTES);
        (void)hipGetLastError();
        grid = cus;
    }
    if (grid < 0) return;
    (void)hipMemsetAsync((char*)d_ws + WS_CTL, 0, CTL_ZERO_BYTES, stream);
    Args a{};
    for (int i = 0; i < 34; ++i) a.in[i] = (const float*)d_in[i];
    a.out = (float*)d_out; a.ws = (unsigned char*)d_ws;
    a.ph_lo = 0; a.ph_hi = PH_TOTAL; a.li = 0;
    hipLaunchKernelGGL(fwd, dim3(grid), dim3(NWAVES * 64), LDS_BYTES, stream, a);
}
```

```cpp
#include <hip/hip_runtime.h>
#include <cstdio>
#include <cstdint>
#ifndef PG8_KREV
#define PG8_KREV 0
#endif
namespace pg8 {
#define PG8_LAS __attribute__((address_space(3)))
typedef unsigned short bf16_t;
typedef short bf16x8 __attribute__((ext_vector_type(8)));
typedef float f32x4 __attribute__((ext_vector_type(4)));
typedef unsigned u32x4 __attribute__((ext_vector_type(4)));
constexpr int BM = 256, BK = 64, HALF = 128, HTB = HALF * BK * 2  , STAGE_BYTES = 8 * HTB, NXCD = 8, WGM = 8;

__host__ __device__ __forceinline__ int lds_byte(int r, int c) { const int st = (r >> 4) * 2 + (c >> 5), rr = r & 15, cc = c & 31, ob = rr * 64 + cc * 2; return st * 1024 + (ob ^ (((ob >> 9) & 1) << 5)); }
__host__ __device__ __forceinline__ void stage_rc(int b, int& R, int& C) { const int st = b / 1024, sb = b % 1024, swz = sb ^ (((sb >> 9) & 1) << 5); R = (st >> 1) * 16 + swz / 64; C = (st & 1) * 32 + (swz % 64) / 2; }
__host__ __device__ __forceinline__ int perm32(int rho) { const int n = rho >> 4, i = rho & 15; return 8 * (i >> 2) + 4 * n + (i & 3); }

struct Unit { int pm, pn, z; };
struct Gemm { const bf16_t* A; const bf16_t* Bt; int M, N, K, lda, ldb, nz, zdiv; size_t sA1, sA2, sB1, sB2; int krev = 0; };
__host__ __device__ __forceinline__ Gemm gemm_plain(const bf16_t* A, const bf16_t* Bt, int M, int N, int K) { return Gemm{A, Bt, M, N, K, K, K, 1, 1, 0, 0, 0, 0, 0}; }

struct StaticOrder {
    int nM, nN, per_z, nwg, G, c; int rev = 0;
    __host__ __device__ void init(const Gemm& g, int G_, int c_) { nM = g.M / BM; nN = g.N / BM; per_z = nM * nN; nwg = per_z * g.nz; G = G_; c = c_; }
    __host__ __device__ bool next(int i, Unit& u) const {
        const int nr = c < nwg ? (nwg - c + G - 1) / G : 0; if (i >= nr) return false;
        const long L = (long)(rev ? nr - 1 - i : i) * G + c;
        int wgid = (int)L; { const int q = nwg / NXCD, r = nwg % NXCD, xcd = wgid % NXCD, off = wgid / NXCD; wgid = (xcd < r ? xcd * (q + 1) : r * (q + 1) + (xcd - r) * q) + off; }
        u.z = wgid / per_z; wgid -= u.z * per_z;
        const int nig = WGM * nN, gid = wgid / nig, fm = gid * WGM, gsz = (nM - fm) < WGM ? (nM - fm) : WGM;
        u.pm = fm + ((wgid % nig) % gsz); u.pn = (wgid % nig) / gsz; return true;
    }
    __device__ __forceinline__ void a_ready(const Unit&) const {}
    __device__ __forceinline__ void done(const Unit&) const {}
};

#ifndef PANEL_INTERLEAVE
#define PANEL_INTERLEAVE 1
#endif
struct PanelOrder {
    int nM, nN, G, c;
    __host__ __device__ void init(const Gemm& g, int G_, int c_) { nM = g.M / BM; nN = g.N / BM; G = G_; c = c_; }
    __host__ __device__ __forceinline__ bool next(int i, Unit& u) const {
        const unsigned L = (unsigned)(i * G + c), CP = 2u * (unsigned)nM; const int lap = (int)(L / CP), w = (int)(L - (unsigned)lap * CP);
        if (lap >= nN / 2) return false;
        u.z = 0; u.pm = w >> 1; u.pn = PANEL_INTERLEAVE ? lap * 2 + (w & 1) : (w & 1) * (nN / 2) + lap; return true;
    }
    __device__ __forceinline__ void a_ready(const Unit&) const {}
    __device__ __forceinline__ void done(const Unit&) const {}
};

__device__ __forceinline__ unsigned cvt_pk_bf16(float lo, float hi) { unsigned r; asm volatile("v_cvt_pk_bf16_f32 %0, %1, %2" : "=v"(r) : "v"(lo), "v"(hi)); return r; }
#ifndef A_NT_AUX
#define A_NT_AUX 0
#endif
#ifndef NT_FOLD
#define NT_FOLD 0
#endif
#ifndef NT_STORES
#define NT_STORES 0
#endif
#ifndef WT_STORES
#define WT_STORES 0
#endif
template <int ACT  , bool NORM = false> struct EpiBf16 {
    static constexpr bool PERM = true, AFTER_DRAIN = false, PRE = NORM, PF = false; static constexpr int A_AUX = 0;
    bf16_t* O; int ldc, zdiv; size_t sO1, sO2; float scale; int scale_cols; const float* ssp; PG8_LAS float* rsl;
    __device__ __forceinline__ void pre_issue(const Unit& u, int tid, int ui) const {
        if (tid < 256) __builtin_amdgcn_global_load_lds((const unsigned*)(ssp + ((size_t)u.pm * BM + tid) * 4), (PG8_LAS unsigned*)(rsl + (ui & 1) * 1024 + (tid >> 6) * 256), 16, 0, 0); }
    __device__ __forceinline__ void operator()(const f32x4 (&acc)[2][2][4][2], const Unit& u, int wr, int wc, int fr, int fq, int ui) const {
        const int row0 = u.pm * BM + wr * 64 + fr, col0 = u.pn * BM + wc * 32 + 8 * fq;
        bf16_t* base = O + (size_t)(u.z / zdiv) * sO1 + (size_t)(u.z % zdiv) * sO2;
        const float sc0 = (u.pn * BM < scale_cols) ? scale : 1.f;
#pragma unroll
        for (int ai = 0; ai < 2; ++ai)
#pragma unroll
            for (int m = 0; m < 4; ++m) { bf16_t* rowp = base + (size_t)(row0 + ai * HALF + m * 16) * ldc + col0;
                float sc = sc0; if constexpr (NORM) { const f32x4 s4 = *(const PG8_LAS f32x4*)(rsl + (ui & 1) * 1024 + (ai * HALF + wr * 64 + m * 16 + fr) * 4); sc *= rsqrtf(((s4[0] + s4[1]) + (s4[2] + s4[3])) * (1.f / 1024.f) + 1e-6f); }
#pragma unroll
                for (int bj = 0; bj < 2; ++bj) { f32x4 v0 = acc[ai][bj][m][0] * sc, v1 = acc[ai][bj][m][1] * sc;
                    if (ACT == 1) {
#pragma unroll
                        for (int e = 0; e < 4; ++e) { const float a = v0[e] > 0.f ? v0[e] : 0.f, b = v1[e] > 0.f ? v1[e] : 0.f; v0[e] = a * a; v1[e] = b * b; } }
                    u32x4 w; w.x = cvt_pk_bf16(v0[0], v0[1]); w.y = cvt_pk_bf16(v0[2], v0[3]); w.z = cvt_pk_bf16(v1[0], v1[1]); w.w = cvt_pk_bf16(v1[2], v1[3]);
                    if (WT_STORES) asm volatile("global_store_dwordx4 %0, %1, off sc1\n\ts_nop 1" :: "v"(rowp + bj * HALF), "v"(w) : "memory");
                    else if (NT_STORES || (NT_FOLD && !NORM && ACT == 0)) __builtin_nontemporal_store(w, (u32x4*)(rowp + bj * HALF));
                    else *(u32x4*)(rowp + bj * HALF) = w; } }
    }
};
struct EpiResid {
    static constexpr bool PERM = true, AFTER_DRAIN = false, PRE = false, PF = false; static constexpr int A_AUX = A_NT_AUX; static constexpr int PF_LEAD = 8;
    const bf16_t* base; bf16_t* hb; int ldc; size_t sO1; float* ssp; PG8_LAS float* xch; int rows_per_z; int mode = 0;
    __device__ __forceinline__ void prefetch(const Unit& u, int tid_) const {
        int tid = tid_; asm volatile("" : "+v"(tid));
        const bf16_t* p = base + (size_t)u.z * sO1 + (size_t)(u.pm * BM + (tid >> 1)) * ldc + u.pn * BM + (tid & 1) * 128;
        PG8_LAS unsigned* d = (PG8_LAS unsigned*)(xch + 2048) + (tid >> 6) * 128;
        __builtin_amdgcn_global_load_lds((const unsigned*)p, d, 4, 0, 0); __builtin_amdgcn_global_load_lds((const unsigned*)(p + 64), d + 64, 4, 0, 0); }
    __device__ __forceinline__ void operator()(const f32x4 (&acc)[2][2][4][2], const Unit& u, int wr, int wc, int fr, int fq, int ui) const {
        if (mode == 1) return;
        const int row0 = u.pm * BM + wr * 64 + fr, col0 = u.pn * BM + wc * 32 + 8 * fq;
        const size_t zo = (size_t)u.z * sO1;
        u32x4 bw[4][2];
#define PG8_RLOAD(q) do { _Pragma("unroll") for (int bj = 0; bj < 2; ++bj) bw[(q) & 3][bj] = *(const u32x4*)(base + zo + (size_t)(row0 + ((q) >> 2) * HALF + ((q) & 3) * 16) * ldc + col0 + bj * HALF); } while (0)
        PG8_RLOAD(0); PG8_RLOAD(1); PG8_RLOAD(2); PG8_RLOAD(3);
#pragma unroll
        for (int q = 0; q < 8; ++q) { const int ai = q >> 2, m = q & 3;
            const size_t off = zo + (size_t)(row0 + ai * HALF + m * 16) * ldc + col0; float ss = 0.f;
#pragma unroll
            for (int bj = 0; bj < 2; ++bj) { const u32x4 b = bw[q & 3][bj]; f32x4 v0 = acc[ai][bj][m][0], v1 = acc[ai][bj][m][1];
                v0[0] += __uint_as_float(b.x << 16); v0[1] += __uint_as_float(b.x & 0xffff0000u); v0[2] += __uint_as_float(b.y << 16); v0[3] += __uint_as_float(b.y & 0xffff0000u);
                v1[0] += __uint_as_float(b.z << 16); v1[1] += __uint_as_float(b.z & 0xffff0000u); v1[2] += __uint_as_float(b.w << 16); v1[3] += __uint_as_float(b.w & 0xffff0000u);
                ss += ((v0[0] * v0[0] + v0[1] * v0[1]) + (v0[2] * v0[2] + v0[3] * v0[3])) + ((v1[0] * v1[0] + v1[1] * v1[1]) + (v1[2] * v1[2] + v1[3] * v1[3]));
                u32x4 w; w.x = cvt_pk_bf16(v0[0], v0[1]); w.y = cvt_pk_bf16(v0[2], v0[3]); w.z = cvt_pk_bf16(v1[0], v1[1]); w.w = cvt_pk_bf16(v1[2], v1[3]);
                *(u32x4*)(hb + off + bj * HALF) = w; }
            if (q + 4 < 8) PG8_RLOAD(q + 4);
            { auto r16 = __builtin_amdgcn_permlane16_swap(__float_as_uint(ss), __float_as_uint(ss), false, false); const unsigned a_ = r16[0], b_ = r16[1]; ss = __uint_as_float(a_) + __uint_as_float(b_); }
            { auto r32 = __builtin_amdgcn_permlane32_swap(__float_as_uint(ss), __float_as_uint(ss), false, false); const unsigned a_ = r32[0], b_ = r32[1]; ss = __uint_as_float(a_) + __uint_as_float(b_); }
            if (fq == 0) xch[(ai * HALF + wr * 64 + m * 16 + fr) * 4 + wc] = ss; }
#undef PG8_RLOAD
        asm volatile("s_waitcnt lgkmcnt(0)" ::: "memory"); __builtin_amdgcn_s_barrier(); asm volatile("" ::: "memory");
        { const int t = (wr * 4 + wc) * 64 + fq * 16 + fr;
          if (t < 256) { const f32x4 p = *(const PG8_LAS f32x4*)(xch + t * 4); ssp[((size_t)u.z * rows_per_z + (size_t)u.pm * BM + t) * 4 + u.pn] = (p[0] + p[1]) + (p[2] + p[3]); } }
    }
};
struct EpiSoftmax {
    static constexpr bool PERM = true, AFTER_DRAIN = false, PRE = true, PF = false; static constexpr int A_AUX = 0;
    bf16_t* O; int ldc; size_t sO1; PG8_LAS float* xch; const float* ssp;
    int rows_per_z; PG8_LAS float* rsl;
    __device__ __forceinline__ void pre_issue(const Unit& u, int tid, int ui) const {
        if (tid < 256) __builtin_amdgcn_global_load_lds((const unsigned*)(ssp + ((size_t)u.z * rows_per_z + (size_t)u.pm * BM + tid) * 4), (PG8_LAS unsigned*)(rsl + (ui & 1) * 1024 + (tid >> 6) * 256), 16, 0, 0); }
    __device__ __forceinline__ void operator()(const f32x4 (&acc_)[2][2][4][2], const Unit& u, int wr, int wc, int fr, int fq, int ui) const {
        f32x4 (&acc)[2][2][4][2] = const_cast<f32x4 (&)[2][2][4][2]>(acc_);
#define PG8_XSWAP16(v) ({ auto r_ = __builtin_amdgcn_permlane16_swap(__float_as_uint(v), __float_as_uint(v), false, false); const unsigned a_ = r_[0], b_ = r_[1]; (a_ == __float_as_uint(v)) ? __uint_as_float(b_) : __uint_as_float(a_); })
#pragma unroll
        for (int ai = 0; ai < 2; ++ai)
#pragma unroll
            for (int m = 0; m < 4; ++m) {
                const f32x4 s4 = *(const PG8_LAS f32x4*)(rsl + (ui & 1) * 1024 + (ai * HALF + wr * 64 + m * 16 + fr) * 4);
                const float rsc = rsqrtf(((s4[0] + s4[1]) + (s4[2] + s4[3])) * (1.f / 1024.f) + 1e-6f);
                float c = -3.0e38f;
#pragma unroll
                for (int bj = 0; bj < 2; ++bj)
#pragma unroll
                    for (int n = 0; n < 2; ++n)
#pragma unroll
                        for (int e = 0; e < 4; ++e) { acc[ai][bj][m][n][e] *= rsc; c = fmaxf(c, acc[ai][bj][m][n][e]); }
                { auto r16 = __builtin_amdgcn_permlane16_swap(__float_as_uint(c), __float_as_uint(c), false, false); const unsigned a_ = r16[0], b_ = r16[1]; c = fmaxf(__uint_as_float(a_), __uint_as_float(b_)); }
                { auto r32 = __builtin_amdgcn_permlane32_swap(__float_as_uint(c), __float_as_uint(c), false, false); const unsigned a_ = r32[0], b_ = r32[1]; c = fmaxf(__uint_as_float(a_), __uint_as_float(b_)); }
                float s = 0.f;
#pragma unroll
                for (int bj = 0; bj < 2; ++bj)
#pragma unroll
                    for (int n = 0; n < 2; ++n)
#pragma unroll
                        for (int e = 0; e < 4; ++e) { const float p = __builtin_amdgcn_exp2f(acc[ai][bj][m][n][e] - c); acc[ai][bj][m][n][e] = p; s += p; }
                { auto r16 = __builtin_amdgcn_permlane16_swap(__float_as_uint(s), __float_as_uint(s), false, false); const unsigned a_ = r16[0], b_ = r16[1]; s = __uint_as_float(a_) + __uint_as_float(b_); }
                { auto r32 = __builtin_amdgcn_permlane32_swap(__float_as_uint(s), __float_as_uint(s), false, false); const unsigned a_ = r32[0], b_ = r32[1]; s = __uint_as_float(a_) + __uint_as_float(b_); }
                const int row = ai * HALF + wr * 64 + m * 16 + fr;
                if (fq == 0) { xch[(row * 4 + wc) * 2] = c; xch[(row * 4 + wc) * 2 + 1] = s; }
            }
#undef PG8_XSWAP16
        asm volatile("s_waitcnt lgkmcnt(0)" ::: "memory"); __builtin_amdgcn_s_barrier(); asm volatile("" ::: "memory");
        const int col0 = u.pn * BM + wc * 32 + 8 * fq;
        bf16_t* base = O + (size_t)u.z * sO1;
#pragma unroll
        for (int ai = 0; ai < 2; ++ai)
#pragma unroll
            for (int m = 0; m < 4; ++m) {
                const int row = ai * HALF + wr * 64 + m * 16 + fr;
                const f32x4 x0 = *(const PG8_LAS f32x4*)(xch + row * 8), x1 = *(const PG8_LAS f32x4*)(xch + row * 8 + 4);
                const float mx = fmaxf(fmaxf(x0[0], x0[2]), fmaxf(x1[0], x1[2]));
                const float tot = x0[1] * __builtin_amdgcn_exp2f(x0[0] - mx) + x0[3] * __builtin_amdgcn_exp2f(x0[2] - mx) + x1[1] * __builtin_amdgcn_exp2f(x1[0] - mx) + x1[3] * __builtin_amdgcn_exp2f(x1[2] - mx);
                const float cl = wc == 0 ? x0[0] : wc == 1 ? x0[2] : wc == 2 ? x1[0] : x1[2];
                const float f = __builtin_amdgcn_exp2f(cl - mx) * __builtin_amdgcn_rcpf(tot);
                bf16_t* rowp = base + (size_t)(u.pm * BM + row) * ldc + col0;
#pragma unroll
                for (int bj = 0; bj < 2; ++bj) { const f32x4 v0 = acc[ai][bj][m][0] * f, v1 = acc[ai][bj][m][1] * f;
                    u32x4 w; w.x = cvt_pk_bf16(v0[0], v0[1]); w.y = cvt_pk_bf16(v0[2], v0[3]); w.z = cvt_pk_bf16(v1[0], v1[1]); w.w = cvt_pk_bf16(v1[2], v1[3]);
                    *(u32x4*)(rowp + bj * HALF) = w; }
            }
    }
};
struct EpiLora {
    static constexpr bool PERM = true, AFTER_DRAIN = false, PRE = false, PF = false; static constexpr int A_AUX = 0;
    unsigned char* ws; size_t off_dec, off_alpha, off_g; const float* w0; const float* a0; int pn_off = 0;
    __device__ __forceinline__ void operator()(const f32x4 (&acc)[2][2][4][2], const Unit& u, int wr, int wc, int fr, int fq, int ui) const {
        const int kind = (u.pn + pn_off) >> 1;
        const size_t off = off_dec + (size_t)(kind >= 1) * (off_alpha - off_dec) + (size_t)(kind >= 2) * (off_g - off_alpha);
        bf16_t* O = (bf16_t*)(ws + off);
        const float* bias = kind == 0 ? w0 : a0;
        const int row0 = u.pm * BM + wr * 64 + fr, col0 = (u.pn & 1) * BM + wc * 32 + 8 * fq;
        f32x4 bv[2][2];
#pragma unroll
        for (int bj = 0; bj < 2; ++bj)
#pragma unroll
            for (int n = 0; n < 2; ++n) bv[bj][n] = kind < 2 ? *(const f32x4*)(bias + col0 + bj * HALF + 4 * n) : (f32x4){0.f, 0.f, 0.f, 0.f};
        const float osc = kind == 0 ? 0.60653066f : 1.f;
#pragma unroll
        for (int ai = 0; ai < 2; ++ai)
#pragma unroll
            for (int m = 0; m < 4; ++m) { bf16_t* rowp = O + (size_t)(row0 + ai * HALF + m * 16) * 512 + col0;
#pragma unroll
                for (int bj = 0; bj < 2; ++bj) { f32x4 v0 = acc[ai][bj][m][0] + bv[bj][0], v1 = acc[ai][bj][m][1] + bv[bj][1];
                    if (kind < 2) {
#pragma unroll
                        for (int e = 0; e < 4; ++e) { v0[e] = osc * __builtin_amdgcn_rcpf(1.f + __builtin_amdgcn_exp2f(-1.4426950408889634f * v0[e])); v1[e] = osc * __builtin_amdgcn_rcpf(1.f + __builtin_amdgcn_exp2f(-1.4426950408889634f * v1[e])); } }
                    if (kind == 0) {
#pragma unroll
                        for (int e = 0; e < 4; ++e) { float a = -1.4426950408889634f * v0[e], b = -1.4426950408889634f * v1[e];
#define PG8_SHR(x, C) __builtin_bit_cast(float, __builtin_amdgcn_update_dpp(0, __builtin_bit_cast(int, x), C, 0xF, 0xF, true))
                            a += PG8_SHR(a, 0x111); a += PG8_SHR(a, 0x112); a += PG8_SHR(a, 0x114); a += PG8_SHR(a, 0x118);
                            b += PG8_SHR(b, 0x111); b += PG8_SHR(b, 0x112); b += PG8_SHR(b, 0x114); b += PG8_SHR(b, 0x118);
#undef PG8_SHR
                            v0[e] = a; v1[e] = b; }
                        typedef _Float16 h2_t __attribute__((ext_vector_type(2))); typedef float f2_t __attribute__((ext_vector_type(2)));
                        u32x4 w;
                        w.x = __builtin_bit_cast(unsigned, __builtin_convertvector((f2_t){v0[0], v0[1]}, h2_t)); w.y = __builtin_bit_cast(unsigned, __builtin_convertvector((f2_t){v0[2], v0[3]}, h2_t));
                        w.z = __builtin_bit_cast(unsigned, __builtin_convertvector((f2_t){v1[0], v1[1]}, h2_t)); w.w = __builtin_bit_cast(unsigned, __builtin_convertvector((f2_t){v1[2], v1[3]}, h2_t));
                        *(u32x4*)(rowp + bj * HALF) = w; continue; }
                    u32x4 w; w.x = cvt_pk_bf16(v0[0], v0[1]); w.y = cvt_pk_bf16(v0[2], v0[3]); w.z = cvt_pk_bf16(v1[0], v1[1]); w.w = cvt_pk_bf16(v1[2], v1[3]);
                    *(u32x4*)(rowp + bj * HALF) = w; } }
    }
};
template <class Epi, class Sched, bool ALIGN_EPI = false, bool SP2 = false>
__device__ __forceinline__ void gemm_phase(PG8_LAS unsigned char* lds, const Gemm g, const Sched& S, const Epi& E, const int tid) {
    const int wid = __builtin_amdgcn_readfirstlane(tid >> 6), lane = tid & 63, wr = wid >> 2, wc = wid & 3, fr = lane & 15, fq = lane >> 4;
    const int K = g.K, nt = K / BK;
    unsigned voffA[2], voffB[2];
#pragma unroll
    for (int i = 0; i < 2; ++i) { int R, C; stage_rc(tid * 16 + i * 8192, R, C); const int Rb = Epi::PERM ? ((R & ~31) + perm32(R & 31)) : R;
        voffA[i] = (unsigned)(R * g.lda + C) * 2u; voffB[i] = (unsigned)(Rb * g.ldb + C) * 2u; }
    const size_t kstep = (size_t)(BK * 2);
#define PG8_KR(ui_) (g.krev == 2 || ((PG8_KREV || g.krev == 1) && ((ui_) & 1)))
#define PG8_KS(ui_) (PG8_KR(ui_) ? -(int)(BK * 2) : (int)(BK * 2))
#define PG8_K0(ui_) (PG8_KR(ui_) ? (nt - 1) * (BK * 2) : 0)
    const size_t hstepA = (size_t)HALF * g.lda * 2, hstepB = (size_t)HALF * g.ldb * 2;
#define PG8_BASEA(u) ((const char*)g.A + ((size_t)((u).z / g.zdiv) * g.sA1 + (size_t)((u).z % g.zdiv) * g.sA2) * 2 + (size_t)(u).pm * 2 * hstepA)
#define PG8_BASEB(u) ((const char*)g.Bt + ((size_t)((u).z / g.zdiv) * g.sB1 + (size_t)((u).z % g.zdiv) * g.sB2) * 2 + (size_t)(u).pn * 2 * hstepB)
    const unsigned ldsw = (unsigned)wid * 1024u;
    const int aoff = lds_byte(wr * 64 + fr, fq * 8), boff = lds_byte(wc * 32 + fr, fq * 8);
#define PG8_SA(b, h) (((b) * 2 + (h)) * HTB)
#define PG8_SB(b, h) ((4 + (b) * 2 + (h)) * HTB)
#define PG8_STAGE_X(bufoff, gbase, voff, AUX) do { _Pragma("unroll") for (int _i = 0; _i < 2; ++_i) \
        __builtin_amdgcn_global_load_lds((const unsigned*)((const char*)(gbase) + (voff)[_i]), (PG8_LAS unsigned*)(lds + (bufoff) + ldsw + _i * 8192), 16, 0, AUX); } while (0)
#define PG8_STAGE(bufoff, gbase, voff) do { if constexpr (Epi::A_AUX != 0) { if ((bufoff) < 4 * HTB) PG8_STAGE_X(bufoff, gbase, voff, Epi::A_AUX); else PG8_STAGE_X(bufoff, gbase, voff, 0); } else PG8_STAGE_X(bufoff, gbase, voff, 0); } while (0)
#define PG8_LDA(dst, b, h) do { _Pragma("unroll") for (int m = 0; m < 4; ++m) _Pragma("unroll") for (int k = 0; k < 2; ++k) dst[m][k] = *(const PG8_LAS bf16x8*)(lds + PG8_SA(b, h) + aoff + m * 2048 + k * 1024); } while (0)
#define PG8_LDB(dst, b, h) do { _Pragma("unroll") for (int n = 0; n < 2; ++n) _Pragma("unroll") for (int k = 0; k < 2; ++k) dst[n][k] = *(const PG8_LAS bf16x8*)(lds + PG8_SB(b, h) + boff + n * 2048 + k * 1024); } while (0)
#define PG8_MMA(ai, bj, At, Bt) do { __builtin_amdgcn_s_setprio(1); _Pragma("unroll") for (int m = 0; m < 4; ++m) _Pragma("unroll") for (int n = 0; n < 2; ++n) _Pragma("unroll") for (int k = 0; k < 2; ++k) \
        acc[ai][bj][m][n] = __builtin_amdgcn_mfma_f32_16x16x32_bf16(Bt[n][k], At[m][k], acc[ai][bj][m][n], 0, 0, 0); __builtin_amdgcn_s_setprio(0); } while (0)
#define PG8_WAIT_V(n) asm volatile("s_waitcnt vmcnt(" #n ")" ::: "memory")
#define PG8_WAIT_L(n) asm volatile("s_waitcnt lgkmcnt(" #n ")" ::: "memory")
#define PG8_BAR __builtin_amdgcn_s_barrier()
#define PG8_SCHED __builtin_amdgcn_sched_barrier(0)
    Unit cur, nxt; int ui = 0;
    if (!S.next(0, cur)) return;
    f32x4 acc[2][2][4][2];
#pragma unroll
    for (int a = 0; a < 2; ++a)
#pragma unroll
        for (int b = 0; b < 2; ++b)
#pragma unroll
            for (int m = 0; m < 4; ++m)
#pragma unroll
                for (int n = 0; n < 2; ++n) acc[a][b][m][n] = (f32x4){0.f, 0.f, 0.f, 0.f};
    bf16x8 At[4][2], B0[2][2], B1[2][2];
    const char* cA = PG8_BASEA(cur) + PG8_K0(0); const char* cB = PG8_BASEB(cur) + PG8_K0(0); int ksc = PG8_KS(0);
    S.a_ready(cur);
    if constexpr (SP2) {
        PG8_STAGE(PG8_SB(0, 0), cB, voffB); PG8_STAGE(PG8_SB(0, 1), cB + hstepB, voffB); PG8_STAGE(PG8_SA(0, 0), cA, voffA); PG8_STAGE(PG8_SA(0, 1), cA + hstepA, voffA);
        if (wr == 1) PG8_BAR;
        PG8_WAIT_V(2); PG8_BAR;
        PG8_STAGE(PG8_SB(1, 0), cB + ksc, voffB); PG8_STAGE(PG8_SA(1, 0), cA + ksc, voffA); PG8_STAGE(PG8_SB(1, 1), cB + hstepB + ksc, voffB);
        PG8_WAIT_V(6); PG8_BAR;
    } else {
        PG8_STAGE(PG8_SB(0, 0), cB, voffB); PG8_STAGE(PG8_SA(0, 0), cA, voffA); PG8_STAGE(PG8_SB(0, 1), cB + hstepB, voffB); PG8_STAGE(PG8_SA(0, 1), cA + hstepA, voffA);
        if (wr == 1) PG8_BAR;
        PG8_WAIT_V(4); PG8_BAR;
        PG8_STAGE(PG8_SB(1, 0), cB + ksc, voffB); PG8_STAGE(PG8_SA(1, 0), cA + ksc, voffA); PG8_STAGE(PG8_SB(1, 1), cB + hstepB + ksc, voffB);
        PG8_WAIT_V(6); PG8_BAR;
    }
    for (;;) {
        const bool has_next = S.next(ui + 1, nxt);
        const char* nA = has_next ? PG8_BASEA(nxt) + PG8_K0(ui + 1) : cA; const char* nB = has_next ? PG8_BASEB(nxt) + PG8_K0(ui + 1) : cB; const int ksn = has_next ? PG8_KS(ui + 1) : ksc;
        if constexpr (Epi::PRE) { static_assert(SP2, "PRE epilogues ride on the SP2 wait pattern"); E.pre_issue(cur, tid, ui); }
        for (int t = 0; t < nt; t += 2) {
            const bool last = (t == nt - 2);
            if constexpr (Epi::PF) { if (t == nt - Epi::PF_LEAD) E.prefetch(cur, tid); }
            const char* a1 = cA + (t + 1) * ksc;
            const char* a2 = last ? nA : cA + (t + 2) * ksc; const char* b2 = last ? nB : cB + (t + 2) * ksc;
            const int ks3 = last ? ksn : ksc; const char* a3 = a2 + ks3; const char* b3 = b2 + ks3;
            if (last && has_next) S.a_ready(nxt);
            if constexpr (SP2) {
            PG8_LDB(B0, 0, 0); PG8_LDB(B1, 0, 1); PG8_SCHED; PG8_LDA(At, 0, 0); PG8_STAGE(PG8_SA(1, 1), a1 + hstepA, voffA);
            PG8_WAIT_V(8); PG8_WAIT_L(0); PG8_BAR; PG8_MMA(0, 0, At, B0); PG8_MMA(0, 1, At, B1); PG8_BAR; PG8_SCHED;
            PG8_LDA(At, 0, 1); PG8_STAGE(PG8_SB(0, 0), b2, voffB); PG8_STAGE(PG8_SB(0, 1), b2 + hstepB, voffB); PG8_STAGE(PG8_SA(0, 0), a2, voffA);
            PG8_WAIT_V(8); PG8_WAIT_L(0); PG8_BAR; PG8_MMA(1, 0, At, B0); PG8_MMA(1, 1, At, B1); PG8_BAR; PG8_SCHED;
            PG8_LDB(B0, 1, 0); PG8_LDB(B1, 1, 1); PG8_SCHED; PG8_LDA(At, 1, 0); PG8_STAGE(PG8_SA(0, 1), a2 + hstepA, voffA);
            PG8_WAIT_V(8); PG8_WAIT_L(0); PG8_BAR; PG8_MMA(0, 0, At, B0); PG8_MMA(0, 1, At, B1); PG8_BAR; PG8_SCHED;
            PG8_LDA(At, 1, 1); PG8_STAGE(PG8_SB(1, 0), b3, voffB); PG8_STAGE(PG8_SB(1, 1), b3 + hstepB, voffB); PG8_STAGE(PG8_SA(1, 0), a3, voffA);
            PG8_WAIT_V(8); PG8_WAIT_L(0); PG8_BAR; PG8_MMA(1, 0, At, B0); PG8_MMA(1, 1, At, B1); PG8_BAR; PG8_SCHED;
            } else {
            PG8_LDB(B0, 0, 0); PG8_SCHED; PG8_LDA(At, 0, 0); PG8_STAGE(PG8_SA(1, 1), a1 + hstepA, voffA);
            PG8_WAIT_L(8); PG8_BAR; PG8_WAIT_L(0); PG8_MMA(0, 0, At, B0); PG8_BAR; PG8_SCHED;
            PG8_LDB(B1, 0, 1); PG8_STAGE(PG8_SB(0, 0), b2, voffB);
            PG8_BAR; PG8_WAIT_L(0); PG8_MMA(0, 1, At, B1); PG8_BAR;
            PG8_LDA(At, 0, 1); PG8_STAGE(PG8_SA(0, 0), a2, voffA);
            PG8_BAR; PG8_WAIT_L(0); PG8_MMA(1, 0, At, B0); PG8_BAR; PG8_SCHED;
            PG8_STAGE(PG8_SB(0, 1), b2 + hstepB, voffB);
            PG8_WAIT_V(6); PG8_BAR; PG8_MMA(1, 1, At, B1); PG8_BAR;
            PG8_LDB(B0, 1, 0); PG8_SCHED; PG8_LDA(At, 1, 0); PG8_STAGE(PG8_SA(0, 1), a2 + hstepA, voffA);
            PG8_WAIT_L(8); PG8_BAR; PG8_WAIT_L(0); PG8_MMA(0, 0, At, B0); PG8_BAR; PG8_SCHED;
            PG8_LDB(B1, 1, 1); PG8_STAGE(PG8_SB(1, 0), b3, voffB);
            PG8_BAR; PG8_WAIT_L(0); PG8_MMA(0, 1, At, B1); PG8_BAR;
            PG8_LDA(At, 1, 1); PG8_STAGE(PG8_SA(1, 0), a3, voffA);
            PG8_BAR; PG8_WAIT_L(0); PG8_MMA(1, 0, At, B0); PG8_BAR; PG8_SCHED;
            PG8_STAGE(PG8_SB(1, 1), b3 + hstepB, voffB);
            PG8_WAIT_V(6); PG8_BAR; PG8_MMA(1, 1, At, B1); PG8_BAR;
            }
        }
        if constexpr (ALIGN_EPI) { if (wr == 0) PG8_BAR; }
        if constexpr (!Epi::AFTER_DRAIN) { E(acc, cur, wr, wc, fr, fq, ui); S.done(cur); }
        if (!has_next) break;
#pragma unroll
        for (int a = 0; a < 2; ++a)
#pragma unroll
            for (int b = 0; b < 2; ++b)
#pragma unroll
                for (int m = 0; m < 4; ++m)
#pragma unroll
                    for (int n = 0; n < 2; ++n) acc[a][b][m][n] = (f32x4){0.f, 0.f, 0.f, 0.f};
        cur = nxt; cA = nA; cB = nB; ksc = ksn; ++ui;
        if constexpr (ALIGN_EPI) { if (wr == 1) PG8_BAR; }
    }
    PG8_WAIT_V(0);
    if constexpr (!ALIGN_EPI) { if (wr == 0) PG8_BAR; }
    PG8_BAR;
    if constexpr (Epi::AFTER_DRAIN) { E.fused(acc, cur, wr, wc, fr, fq, lds, wid, lane); S.done(cur); }
#undef PG8_KS
#undef PG8_KR
#undef PG8_K0
#undef PG8_BASEA
#undef PG8_BASEB
#undef PG8_SA
#undef PG8_SB
#undef PG8_STAGE
#undef PG8_LDA
#undef PG8_LDB
#undef PG8_MMA
#undef PG8_WAIT_V
#undef PG8_WAIT_L
#undef PG8_BAR
#undef PG8_SCHED
}
}
#ifndef PG8_SP2
#define PG8_SP2 true
#endif
#ifndef PG8_ALIGN
#define PG8_ALIGN true
#endif

constexpr int BATCH = 8, SEQ = 4096, DM = 1024, NTOK = BATCH * SEQ, NMEM = 256, MROWS = BATCH * NMEM, DFF = 4096;
constexpr int HYB = 3840, QKVW = 3072;
constexpr int NWAVES = 8;
constexpr int PH_PER_LAYER = 13, PH_FINAL = 52, PH_TOTAL = 53;
#ifndef MK_ONE_LAUNCH
#define MK_ONE_LAUNCH 1
#endif

constexpr size_t MiB = 1u << 20;
constexpr size_t WS_CTL = 0, CTL_ZERO_BYTES = 1 * MiB;
constexpr size_t WS_MEMN = 1 * MiB;
constexpr size_t WS_KV = 8 * MiB;
constexpr size_t WS_W = 16 * MiB;
constexpr size_t WS_HN = 50 * MiB;
constexpr size_t WS_BIG = 114 * MiB;
constexpr size_t WS_LW = 5 * MiB;
constexpr size_t WS_ROT = 6 * MiB;
constexpr size_t WS_BONUS = 7 * MiB;
constexpr size_t WS_XL = WS_BIG + 240 * MiB;
constexpr size_t WS_DEC = 370 * MiB;
constexpr size_t WS_ALPHA = 434 * MiB;
constexpr size_t WS_G = 466 * MiB;
constexpr size_t WS_WQK = WS_DEC;
constexpr size_t WS_VWO = WS_DEC + 16 * MiB;
constexpr size_t WS_SSP = 498 * MiB;
constexpr size_t WS_HB2 = WS_BIG + 64 * MiB;
constexpr size_t WS_WKV2 = WS_DEC + 32 * MiB;
constexpr size_t WS_KV2 = WS_DEC + 36 * MiB;
constexpr size_t WS_END = 500 * MiB;
constexpr size_t WO_IN = 0, WO_OUT = WO_IN + (size_t)3840 * 1024, WO_Q = WO_OUT + (size_t)1024 * 1024, WO_KV = WO_Q + (size_t)1024 * 1024, WO_O = WO_KV + (size_t)2048 * 1024,
                 WO_1 = WO_O + (size_t)1024 * 1024, WO_2 = WO_1 + (size_t)4096 * 1024, WO_END = WO_2 + (size_t)4096 * 1024;
static_assert(WS_W + WO_END * 2 <= WS_HN, "weights fit");
constexpr int CW_BAR = 4096;

constexpr int RING_BYTES = 131072, LDSCTL_OFF = RING_BYTES, MISC_OFF = LDSCTL_OFF + 320, XCH_OFF = 135168, LDS_BYTES = 151552;

#define GAS __attribute__((address_space(1)))
#define LAS __attribute__((address_space(3)))
typedef unsigned short bf16;
typedef unsigned v4u __attribute__((ext_vector_type(4)));
typedef unsigned v2u __attribute__((ext_vector_type(2)));
typedef float f32x4 __attribute__((ext_vector_type(4)));
#define LDS_WAIT() asm volatile("s_waitcnt lgkmcnt(0)" ::: "memory")
__device__ __forceinline__ unsigned f2bf(float f) { unsigned u = __builtin_bit_cast(unsigned, f); return (u + 0x7fffu + ((u >> 16) & 1u)) >> 16; }
typedef float cf32x2_t __attribute__((ext_vector_type(2))); typedef __bf16 cbf16x2_t __attribute__((ext_vector_type(2)));
__device__ __forceinline__ unsigned pk2(float lo, float hi) { cf32x2_t v = {lo, hi}; cbf16x2_t b = __builtin_convertvector(v, cbf16x2_t); return __builtin_bit_cast(unsigned, b); }
__device__ __forceinline__ float bf2f(unsigned v) { return __builtin_bit_cast(float, v << 16); }
template <int CTRL> __device__ __forceinline__ float cdpp0(float v) { return __builtin_bit_cast(float, __builtin_amdgcn_update_dpp(0, __builtin_bit_cast(int, v), CTRL, 0xF, 0xF, true)); }
__device__ __forceinline__ float wave_sum(float x) {
    x += cdpp0<0xB1>(x); x += cdpp0<0x4E>(x); x += cdpp0<0x141>(x); x += cdpp0<0x140>(x);
    { auto r = __builtin_amdgcn_permlane16_swap(__float_as_uint(x), __float_as_uint(x), false, false); const unsigned a_ = r[0], b_ = r[1]; x = __uint_as_float(a_) + __uint_as_float(b_); }
    { auto r = __builtin_amdgcn_permlane32_swap(__float_as_uint(x), __float_as_uint(x), false, false); const unsigned a_ = r[0], b_ = r[1]; x = __uint_as_float(a_) + __uint_as_float(b_); }
    return x; }
template <int CTRL> __device__ __forceinline__ float cdpp(float v) { return __builtin_bit_cast(float, __builtin_amdgcn_update_dpp(0, __builtin_bit_cast(int, v), CTRL, 0xF, 0xF, true)); }
__device__ __forceinline__ float wave_sum_dpp(float x) {
    x += cdpp<0xB1>(x); x += cdpp<0x4E>(x); x += cdpp<0x141>(x); x += cdpp<0x140>(x);
    { auto r = __builtin_amdgcn_permlane16_swap(__float_as_uint(x), __float_as_uint(x), false, false); const unsigned a_ = r[0], b_ = r[1]; x = __uint_as_float(a_) + __uint_as_float(b_); }
    { auto r = __builtin_amdgcn_permlane32_swap(__float_as_uint(x), __float_as_uint(x), false, false); const unsigned a_ = r[0], b_ = r[1]; x = __uint_as_float(a_) + __uint_as_float(b_); }
    return x; }
__device__ __forceinline__ float rl(float v, int l) { return __builtin_bit_cast(float, __builtin_amdgcn_readlane(__builtin_bit_cast(int, v), l)); }
__device__ __forceinline__ float wave_max(float v) {
#pragma unroll
    for (int o = 1; o < 64; o <<= 1) v = fmaxf(v, __shfl_xor(v, o));
    return v;
}

#define XB_TMO      128
#define XB_XCNT(j)  (256  + 64 * (j))
#define XB_XSUB(j)  (1280 + 64 * (j))
#define XB_XGEN(j)  (2304 + 64 * (j))
#define XB_TOP      3328
#define XB_TOPGEN   3392
#define XCD_BAR_WORDS 3456
#define XB_SPIN_CAP (1u << 18)
__device__ __forceinline__ unsigned xb_ld(unsigned* p)              { return __hip_atomic_load(p, __ATOMIC_RELAXED, __HIP_MEMORY_SCOPE_AGENT); }
__device__ __forceinline__ unsigned xb_add(unsigned* p, unsigned v) { return __hip_atomic_fetch_add(p, v, __ATOMIC_RELAXED, __HIP_MEMORY_SCOPE_AGENT); }
__device__ __forceinline__ unsigned xb_xcc_id() { return (unsigned)__builtin_amdgcn_s_getreg((3 << 11) | 20) & 0xFu; }
#define XB_SPIN(cond, bar) do { unsigned _sp = 0; while (cond) { __builtin_amdgcn_s_sleep(1); \
    if ((++_sp & 255u) == 0u) { if (xb_ld(&(bar)[XB_TMO])) break; if (_sp > XB_SPIN_CAP) { atomicAdd(&(bar)[XB_TMO], 1u); break; } } } } while (0)
struct XcdBarrier { unsigned* bar; unsigned x; volatile LAS unsigned* st; };
__device__ __forceinline__ XcdBarrier xcd_barrier_post(unsigned* bar, volatile LAS unsigned* st) {
    XcdBarrier b; b.bar = bar; b.x = xb_xcc_id(); b.st = st;
    if (threadIdx.x == 0) (void)xb_add(&bar[XB_XCNT(b.x)], 1u);
    return b;
}
__device__ __forceinline__ void xcd_barrier_complete(unsigned* bar, unsigned x, unsigned& nloc, unsigned& nx) {
    const unsigned G = gridDim.x * gridDim.y * gridDim.z;
    unsigned sum, cnt, mine, sp = 0u;
    for (;;) {
        sum = 0u; cnt = 0u; mine = 0u;
#pragma unroll
        for (unsigned j = 0; j < 16; ++j) { const unsigned c = xb_ld(&bar[XB_XCNT(j)]); sum += c; cnt += (c > 0u) ? 1u : 0u; mine = (j == x) ? c : mine; }
        if (sum == G) break;
        __builtin_amdgcn_s_sleep(1);
        if ((++sp & 255u) == 0u) { if (xb_ld(&bar[XB_TMO])) break; if (sp > XB_SPIN_CAP) { atomicAdd(&bar[XB_TMO], 1u); break; } }
    }
    nloc = mine > 0u ? mine : 1u; nx = cnt > 0u ? cnt : 1u;
}
__device__ __forceinline__ void xcd_barrier(const XcdBarrier& b, int wave0_ = -1) {
    asm volatile("s_waitcnt vmcnt(0)" ::: "memory");
    __syncthreads();
    bool leader_;
    if (wave0_ < 0) leader_ = threadIdx.x == 0;
    else { int l_; asm volatile("v_mbcnt_lo_u32_b32 %0, -1, 0\n\tv_mbcnt_hi_u32_b32 %0, -1, %0" : "=v"(l_)); leader_ = (wave0_ == 0) && (l_ == 0); }
    if (leader_) {
        unsigned* bar = b.bar;
        __builtin_amdgcn_s_waitcnt(0);
        unsigned nloc = b.st[0], nx = b.st[1];
        if (nloc == 0u) { xcd_barrier_complete(bar, b.x, nloc, nx); b.st[0] = nloc; b.st[1] = nx; }
        const unsigned old = xb_add(&bar[XB_XSUB(b.x)], 1u);
        const unsigned gen = old / nloc;
        if (old + 1u == (gen + 1u) * nloc) {
            __builtin_amdgcn_fence(__ATOMIC_RELEASE, "agent");
            asm volatile("s_waitcnt vmcnt(0)" ::: "memory");
            const unsigned og = xb_add(&bar[XB_TOP], 1u);
            const unsigned tg = og / nx;
            if (og + 1u == (tg + 1u) * nx) xb_add(&bar[XB_TOPGEN], 1u);
            else XB_SPIN(xb_ld(&bar[XB_TOPGEN]) == tg, bar);
            __builtin_amdgcn_fence(__ATOMIC_ACQUIRE, "agent");
            xb_add(&bar[XB_XGEN(b.x)], 1u);
            asm volatile("s_waitcnt vmcnt(0)" ::: "memory");
        } else {
            XB_SPIN(xb_ld(&bar[XB_XGEN(b.x)]) == gen, bar);
            __builtin_amdgcn_fence(__ATOMIC_ACQUIRE, "agent");
            asm volatile("s_waitcnt vmcnt(0)" ::: "memory");
        }
    }
    __syncthreads();
}

__device__ __forceinline__ void grp_barrier(unsigned* cnt, unsigned members, unsigned& gen, unsigned* tmo) {
    asm volatile("s_waitcnt vmcnt(0)" ::: "memory");
    __syncthreads();
    ++gen;
    if (threadIdx.x == 0) {
        __builtin_amdgcn_fence(__ATOMIC_RELEASE, "agent");
        asm volatile("s_waitcnt vmcnt(0)" ::: "memory");
        (void)xb_add(cnt, 1u);
        const unsigned target = gen * members; unsigned sp = 0u;
        while (xb_ld(cnt) < target) { __builtin_amdgcn_s_sleep(1); if ((++sp & 255u) == 0u) { if (xb_ld(tmo)) break; if (sp > XB_SPIN_CAP) { atomicAdd(tmo, 1u); break; } } }
        __builtin_amdgcn_fence(__ATOMIC_ACQUIRE, "agent");
        asm volatile("s_waitcnt vmcnt(0)" ::: "memory");
    }
    __syncthreads();
}

__device__ __forceinline__ void transpose_item(const float* W, int K, int N, bf16* WT, LAS float* scr, int item, int lane, const float* ks) {
    const int nblk = N / 32, kb = item / nblk, nb = item % nblk, k0 = 64 * kb, n0 = 32 * nb;
    f32x4 wv[8];
#pragma unroll
    for (int i = 0; i < 8; ++i) wv[i] = __builtin_nontemporal_load((const f32x4*)(W + (size_t)(k0 + 8 * i + (lane >> 3)) * N + n0 + 4 * (lane & 7)));
#pragma unroll
    for (int i = 0; i < 8; ++i) { const int kk = 8 * i + (lane >> 3); const float g_ = ks ? ks[k0 + kk] : 1.f; LAS float* d_ = scr + kk * 33 + 4 * (lane & 7);
        d_[0] = wv[i].x * g_; d_[1] = wv[i].y * g_; d_[2] = wv[i].z * g_; d_[3] = wv[i].w * g_; }
    LDS_WAIT(); asm volatile("" ::: "memory");
    const int c = lane & 7;
#pragma unroll
    for (int j = 0; j < 4; ++j) { const int n = (lane >> 3) + 8 * j; const LAS float* s = scr + (8 * c) * 33 + n;
        v4u o; o.x = pk2(s[0 * 33], s[1 * 33]); o.y = pk2(s[2 * 33], s[3 * 33]); o.z = pk2(s[4 * 33], s[5 * 33]); o.w = pk2(s[6 * 33], s[7 * 33]);
        __builtin_nontemporal_store(o, (GAS v4u*)(WT + (size_t)(n0 + n) * K + k0 + 8 * c)); }
    LDS_WAIT(); asm volatile("" ::: "memory");
}
__device__ __forceinline__ void rms_row_to_bf16(const float* xrow, const float* w, bf16* orow, int lane) {
    const f32x4* xr = (const f32x4*)xrow + lane; const f32x4* wr = (const f32x4*)w + lane;
    f32x4 v[4]; float s = 0.f;
#pragma unroll
    for (int j = 0; j < 4; ++j) { v[j] = xr[64 * j]; s += (v[j].x * v[j].x + v[j].y * v[j].y) + (v[j].z * v[j].z + v[j].w * v[j].w); }
    const float rstd = rsqrtf(wave_sum(s) * (1.f / 1024.f) + 1e-6f);
    unsigned long long* o8 = (unsigned long long*)orow + lane;
#pragma unroll
    for (int j = 0; j < 4; ++j) { const f32x4 wv = wr[64 * j]; const f32x4 o = v[j] * rstd * wv;
        o8[64 * j] = (unsigned long long)pk2(o.x, o.y) | ((unsigned long long)pk2(o.z, o.w) << 32); }
}
__device__ __forceinline__ void row_to_bf16_ss(const float* xrow, bf16* orow, float* ssp4, int lane) {
    const f32x4* xr = (const f32x4*)xrow + lane; float s = 0.f; unsigned long long* o8 = (unsigned long long*)orow + lane;
#pragma unroll
    for (int j = 0; j < 4; ++j) { const f32x4 v = xr[64 * j]; s += (v.x * v.x + v.y * v.y) + (v.z * v.z + v.w * v.w); o8[64 * j] = (unsigned long long)pk2(v.x, v.y) | ((unsigned long long)pk2(v.z, v.w) << 32); }
    s = wave_sum(s); if (lane < 4) ssp4[lane] = lane == 0 ? s : 0.f;
}
__device__ __forceinline__ void rows4_to_bf16_ss(const float* x, bf16* U, float* ssp, int m, int st, int nrows, int lane) {
    f32x4 v[4][4];
#pragma unroll
    for (int r = 0; r < 4; ++r) { const int row = m + r * st; const f32x4* xr = (const f32x4*)(x + (size_t)(row < nrows ? row : m) * 1024) + lane;
#pragma unroll
        for (int j = 0; j < 4; ++j) v[r][j] = __builtin_nontemporal_load(xr + 64 * j); }
#pragma unroll
    for (int r = 0; r < 4; ++r) { const int row = m + r * st; if (row < nrows) { float s = 0.f; unsigned long long* o8 = (unsigned long long*)(U + (size_t)row * 1024) + lane;
#pragma unroll
        for (int j = 0; j < 4; ++j) { const f32x4 q = v[r][j]; s += (q.x * q.x + q.y * q.y) + (q.z * q.z + q.w * q.w); o8[64 * j] = (unsigned long long)pk2(q.x, q.y) | ((unsigned long long)pk2(q.z, q.w) << 32); }
        s = wave_sum_dpp(s); if (lane < 4) ssp[(size_t)row * 4 + lane] = lane == 0 ? s : 0.f; } }
}
__device__ __forceinline__ void rows4_bf16_to_f32_norm(const bf16* H, const float* w, float* out, int m, int st, int nrows, int lane) {
    v4u q[4][2];
#pragma unroll
    for (int r = 0; r < 4; ++r) { const int row = m + r * st; const bf16* hr = H + (size_t)(row < nrows ? row : m) * 1024;
#pragma unroll
        for (int j = 0; j < 2; ++j) q[r][j] = __builtin_nontemporal_load((const v4u*)(hr + j * 512 + lane * 8)); }
    f32x4 wv[2][2];
#pragma unroll
    for (int j = 0; j < 2; ++j) { wv[j][0] = *(const f32x4*)(w + j * 512 + lane * 8); wv[j][1] = *(const f32x4*)(w + j * 512 + lane * 8 + 4); }
#pragma unroll
    for (int r = 0; r < 4; ++r) { const int row = m + r * st; if (row < nrows) { float v[2][8]; float s = 0.f;
#pragma unroll
        for (int j = 0; j < 2; ++j) { const v4u t = q[r][j];
            v[j][0] = __uint_as_float(t.x << 16); v[j][1] = __uint_as_float(t.x & 0xffff0000u); v[j][2] = __uint_as_float(t.y << 16); v[j][3] = __uint_as_float(t.y & 0xffff0000u);
            v[j][4] = __uint_as_float(t.z << 16); v[j][5] = __uint_as_float(t.z & 0xffff0000u); v[j][6] = __uint_as_float(t.w << 16); v[j][7] = __uint_as_float(t.w & 0xffff0000u);
#pragma unroll
            for (int e = 0; e < 8; ++e) s += v[j][e] * v[j][e]; }
        const float rstd = rsqrtf(wave_sum_dpp(s) * (1.f / 1024.f) + 1e-6f); float* orow = out + (size_t)row * 1024;
#pragma unroll
        for (int j = 0; j < 2; ++j) { f32x4 o0, o1; o0.x = v[j][0] * rstd * wv[j][0].x; o0.y = v[j][1] * rstd * wv[j][0].y; o0.z = v[j][2] * rstd * wv[j][0].z; o0.w = v[j][3] * rstd * wv[j][0].w;
            o1.x = v[j][4] * rstd * wv[j][1].x; o1.y = v[j][5] * rstd * wv[j][1].y; o1.z = v[j][6] * rstd * wv[j][1].z; o1.w = v[j][7] * rstd * wv[j][1].w;
            *(f32x4*)(orow + j * 512 + lane * 8) = o0; *(f32x4*)(orow + j * 512 + lane * 8 + 4) = o1; } } }
}
__device__ __forceinline__ void rms_row_bf16_to_f32(const bf16* hrow, const float* w, float* orow, int lane) {
    float v[2][8]; float s = 0.f;
#pragma unroll
    for (int j = 0; j < 2; ++j) { const v4u q = *(const v4u*)(hrow + j * 512 + lane * 8);
        v[j][0] = __uint_as_float(q.x << 16); v[j][1] = __uint_as_float(q.x & 0xffff0000u); v[j][2] = __uint_as_float(q.y << 16); v[j][3] = __uint_as_float(q.y & 0xffff0000u);
        v[j][4] = __uint_as_float(q.z << 16); v[j][5] = __uint_as_float(q.z & 0xffff0000u); v[j][6] = __uint_as_float(q.w << 16); v[j][7] = __uint_as_float(q.w & 0xffff0000u);
#pragma unroll
        for (int e = 0; e < 8; ++e) s += v[j][e] * v[j][e]; }
    const float rstd = rsqrtf(wave_sum(s) * (1.f / 1024.f) + 1e-6f);
#pragma unroll
    for (int j = 0; j < 2; ++j) { const f32x4 w0 = *(const f32x4*)(w + j * 512 + lane * 8), w1 = *(const f32x4*)(w + j * 512 + lane * 8 + 4);
        f32x4 o0, o1; o0.x = v[j][0] * rstd * w0.x; o0.y = v[j][1] * rstd * w0.y; o0.z = v[j][2] * rstd * w0.z; o0.w = v[j][3] * rstd * w0.w;
        o1.x = v[j][4] * rstd * w1.x; o1.y = v[j][5] * rstd * w1.y; o1.z = v[j][6] * rstd * w1.z; o1.w = v[j][7] * rstd * w1.w;
        *(f32x4*)(orow + j * 512 + lane * 8) = o0; *(f32x4*)(orow + j * 512 + lane * 8 + 4) = o1; }
}
__device__ __forceinline__ void rms_row_inplace(float* xrow, const float* w, int lane) {
    f32x4* xr = (f32x4*)xrow + lane; const f32x4* wr = (const f32x4*)w + lane;
    f32x4 v[4]; float s = 0.f;
#pragma unroll
    for (int j = 0; j < 4; ++j) { v[j] = xr[64 * j]; s += (v[j].x * v[j].x + v[j].y * v[j].y) + (v[j].z * v[j].z + v[j].w * v[j].w); }
    const float rstd = rsqrtf(wave_sum(s) * (1.f / 1024.f) + 1e-6f);
#pragma unroll
    for (int j = 0; j < 4; ++j) { const f32x4 wv = wr[64 * j]; xr[64 * j] = v[j] * rstd * wv; }
}

namespace dattn {
typedef short bf16x8 __attribute__((ext_vector_type(8)));
typedef short s16x4 __attribute__((ext_vector_type(4)));
typedef float f32x16 __attribute__((ext_vector_type(16)));
typedef unsigned u32x4 __attribute__((ext_vector_type(4)));
typedef short v4i16_t __attribute__((ext_vector_type(4)));
typedef __attribute__((address_space(3))) const char* lds_cptr;
constexpr int PITCH = 3072, QB = 128, KVBLK = 64, SEQL = 4096;
constexpr int TBX = 392;
constexpr int SLOTB = 16384, LDS_K = 0, LDS_V = 3 * SLOTB, LDS_WS = 6 * SLOTB, LDS_TBL = LDS_WS + 8 * 256, LDS_END = LDS_TBL + 4 * TBX * 4;
constexpr int STG_F = 0, STG_B = 65536;
constexpr float C2 = 0.125f * 1.4426950408889634f;
constexpr int THRL = 8;
#define DA_SBAR() __builtin_amdgcn_sched_barrier(0)
#define DA_WAIT_BAR(N) asm volatile("s_waitcnt vmcnt(" #N ") lgkmcnt(0)\n\ts_barrier" ::: "memory")
#define DA_MFMA(a, b, c) __builtin_amdgcn_mfma_f32_32x32x16_bf16(a, b, c, 0, 0, 0)
__device__ __forceinline__ int crow(int r, int hi) { return (r & 3) + 8 * (r >> 2) + 4 * hi; }
__device__ __forceinline__ void glds16x2(const void* g0, const void* g1, unsigned d0, unsigned d1) {
    asm volatile("s_mov_b32 m0, %2\n\ts_nop 0\n\tglobal_load_lds_dwordx4 %0, off\n\ts_mov_b32 m0, %3\n\ts_nop 0\n\tglobal_load_lds_dwordx4 %1, off" :: "v"(g0), "v"(g1), "s"(d0), "s"(d1) : "memory", "m0"); }
__device__ __forceinline__ void glds16(const void* gsrc, unsigned lds_dst) { unsigned keep;
    asm volatile("s_mov_b32 %0, m0\n\ts_mov_b32 m0, %2\n\ts_nop 0\n\tglobal_load_lds_dwordx4 %1, off\n\ts_mov_b32 m0, %0" : "=&s"(keep) : "v"(gsrc), "s"(lds_dst) : "memory"); }
typedef float f32x2_t __attribute__((ext_vector_type(2))); typedef __bf16 bf16x2_t __attribute__((ext_vector_type(2)));
__device__ __forceinline__ unsigned cvtpk(float lo, float hi) { f32x2_t v = {lo, hi}; bf16x2_t b = __builtin_convertvector(v, bf16x2_t); return __builtin_bit_cast(unsigned, b); }
__device__ __forceinline__ void kload2(bf16x8* kf, lds_cptr kp, int j) { kf[2 * j] = *(const __attribute__((address_space(3))) bf16x8*)(kp + j * 2048); kf[2 * j + 1] = *(const __attribute__((address_space(3))) bf16x8*)(kp + j * 2048 + 512); }
__device__ __forceinline__ s16x4 vtr(lds_cptr p) { return __builtin_bit_cast(s16x4, __builtin_amdgcn_ds_read_tr16_b64_v4i16((__attribute__((address_space(3))) v4i16_t*)p)); }
#define DA_MX3(a, b, c) __builtin_fmaxf(__builtin_fmaxf((a), (b)), (c))
__device__ __forceinline__ float rowmax(const f32x16& p0, const f32x16& p1) {
    float a = DA_MX3(p0[0], p0[1], p1[0]), b = DA_MX3(p0[2], p0[3], p1[1]); a = DA_MX3(a, p1[2], p1[3]);
#pragma unroll
    for (int r = 4; r < 16; r += 4) { a = DA_MX3(a, p0[r], p0[r + 1]); b = DA_MX3(b, p0[r + 2], p0[r + 3]); a = DA_MX3(a, p1[r], p1[r + 1]); b = DA_MX3(b, p1[r + 2], p1[r + 3]); }
    float m = __builtin_fmaxf(a, b); auto rr = __builtin_amdgcn_permlane32_swap(__float_as_uint(m), __float_as_uint(m), false, false);
    return __builtin_fmaxf(__uint_as_float(rr[0]), __uint_as_float(rr[1])); }
__device__ __forceinline__ void band(f32x16& p0, f32x16& p1, int nrel, int hi, const __attribute__((address_space(3))) float* tbl, bool mask) {
    const int lim = mask ? 0 : -100000;
#pragma unroll
    for (int j = 0; j < 4; ++j) { int u0 = nrel - (8 * j + 4 * hi); asm volatile("" : "+v"(u0));
        { const int a0 = 256 - u0; const f32x4 b0 = *(const __attribute__((address_space(3))) f32x4*)(tbl + (a0 & 3) * TBX + (a0 & ~3));
#pragma unroll
          for (int k = 0; k < 4; ++k) { const int r = 4 * j + k; p0[r] = (u0 - k < lim) ? -INFINITY : p0[r] + b0[k]; } }
        { const int a1 = 288 - u0; const f32x4 b1 = *(const __attribute__((address_space(3))) f32x4*)(tbl + (a1 & 3) * TBX + (a1 & ~3));
#pragma unroll
          for (int k = 0; k < 4; ++k) { const int r = 4 * j + k; p1[r] = (u0 - 32 - k < lim) ? -INFINITY : p1[r] + b1[k]; } } } }

template <bool NOBAR> __device__ __forceinline__ void unit(int b, int h, int qb, const unsigned short* QKV, unsigned short* YC, __attribute__((address_space(3))) unsigned char* lds, const float* ln_w, float lam, float osc, int tid) {
    typedef unsigned short bf16;
    const int wid = __builtin_amdgcn_readfirstlane(tid >> 6); const int qs = wid & 3, c = wid >> 2;
    const long rowbase = (long)b * SEQL; const int q0 = qb * QB, NT = (q0 + QB) / KVBLK;
    const bf16* Qw = QKV + (rowbase + q0 + qs * 32) * PITCH + h * 128 + c * 64;
    f32x16 o[4]; float l_reg = 0.f;
    __attribute__((address_space(3))) float* wsf = (__attribute__((address_space(3))) float*)(lds + LDS_WS) + wid * 64;
    {
    const int lane = tid & 63, r32 = lane & 31, hi = lane >> 5;
    const bf16* Kh = QKV + rowbase * PITCH + 1024 + h * 128; const bf16* Vh = QKV + rowbase * PITCH + 2048 + h * 128;
    const unsigned lds0 = (unsigned)(uintptr_t)lds;
    const __attribute__((address_space(3))) float* tbl = (const __attribute__((address_space(3))) float*)(lds + LDS_TBL);
    const bf16* ksrc = Kh + (long)lane * PITCH + wid * 8;
    const bf16* vsrc = Vh + (long)(16 * (wid & 3) + (lane >> 2)) * PITCH + (wid >> 2) * 32 + (lane & 3) * 8;
    const unsigned kdst = lds0 + LDS_K + wid * 1024, vdst = lds0 + LDS_V + wid * 1024;
#define DA_DMA_K(t, slot) do { glds16x2(ksrc + (long)(t) * KVBLK * PITCH, ksrc + (long)(t) * KVBLK * PITCH + 64, (unsigned)__builtin_amdgcn_readfirstlane(kdst + (slot)), (unsigned)__builtin_amdgcn_readfirstlane(kdst + (slot) + 8192)); } while (0)
#define DA_DMA_V(t, slot) do { glds16x2(vsrc + (long)(t) * KVBLK * PITCH, vsrc + (long)(t) * KVBLK * PITCH + 64, (unsigned)__builtin_amdgcn_readfirstlane(vdst + (slot)), (unsigned)__builtin_amdgcn_readfirstlane(vdst + (slot) + 8192)); } while (0)
    const lds_cptr shm3 = (lds_cptr)lds;
    const lds_cptr kp0 = shm3 + LDS_K + c * 8192 + hi * 1024 + r32 * 16;
    const lds_cptr vp0 = shm3 + LDS_V + ((lane >> 4) & 1) * 32 + (lane & 3) * 8 + (4 * hi + ((lane & 15) >> 2)) * 64;
    DA_DMA_K(0, 0); DA_DMA_V(0, 0); DA_DMA_K(1, SLOTB);
    bf16x8 qr[4];
#pragma unroll
    for (int d0 = 0; d0 < 4; ++d0) qr[d0] = *reinterpret_cast<const bf16x8*>(&Qw[(long)r32 * PITCH + d0 * 16 + hi * 8]);
    float mhat = 0.f;
    const int qn = q0 + qs * 32 + r32;
    bool resc = false;
    int sl_prev = 2 * SLOTB, sl_cur = 0, sl_next = SLOTB;
#define DA_ROT() do { sl_prev = sl_cur; sl_cur = sl_next; sl_next = (sl_next == 2 * SLOTB) ? 0 : sl_next + SLOTB; } while (0)
#define DA_RESC() do { if (resc) { asm volatile("s_waitcnt lgkmcnt(0)" ::: "memory"); \
      _Pragma("unroll") for (int d_ = 0; d_ < 4; ++d_) _Pragma("unroll") for (int r = 0; r < 16; ++r) o[d_][r] *= wsf[crow(r, hi)]; } } while (0)
#define DA_BAND(P0, P1, t) do { if ((t) >= NT - 4) band(P0, P1, qn - (t) * KVBLK, hi, tbl, (t) >= NT - 2); } while (0)
    DA_DMA_K(2, 2 * SLOTB);
    if (wid >= 4) __builtin_amdgcn_s_setprio(1);
    DA_WAIT_BAR(2);
    float zf = 0.f; asm volatile("" : "+v"(zf));
    f32x16 negm;
#pragma unroll
    for (int r = 0; r < 16; ++r) { o[0][r] = zf; o[1][r] = zf; o[2][r] = zf; o[3][r] = zf; negm[r] = zf; }
    asm volatile("" : "+v"(negm));
    f32x16 C0, C1; bf16x8 kf[8]; s16x4 vlo[8], vhi[8];
    u32x4 pw0, pw1, pw2, pw3;
#pragma unroll
    for (int j = 0; j < 4; ++j) kload2(kf, kp0, j);
    C0 = DA_MFMA(kf[0], qr[0], negm); C1 = DA_MFMA(kf[1], qr[0], negm);
#pragma unroll
    for (int j = 1; j < 4; ++j) { C0 = DA_MFMA(kf[2 * j], qr[j], C0); C1 = DA_MFMA(kf[2 * j + 1], qr[j], C1); }
    DA_BAND(C0, C1, 0);
    { const float rm = rowmax(C0, C1); mhat = rm;
#pragma unroll
      for (int r = 0; r < 16; ++r) { C0[r] = __builtin_amdgcn_exp2f(C0[r] - rm); C1[r] = __builtin_amdgcn_exp2f(C1[r] - rm); negm[r] = -rm; }
      asm volatile("" : "+v"(negm));
      float sacc = 0.f;
#pragma unroll
      for (int r = 0; r < 16; ++r) sacc += C0[r] + C1[r];
      l_reg = sacc; }
#define DA_PK4(P, i) (u32x4){cvtpk(P[i], P[i + 1]), cvtpk(P[i + 2], P[i + 3]), cvtpk(P[i + 4], P[i + 5]), cvtpk(P[i + 6], P[i + 7])}
    pw0 = DA_PK4(C0, 0); pw1 = DA_PK4(C0, 8); pw2 = DA_PK4(C1, 0); pw3 = DA_PK4(C1, 8);
    DA_DMA_V(1, SLOTB);
    kload2(kf, kp0 + sl_next, 0); kload2(kf, kp0 + sl_next, 1);
    if (NT == 2) { DA_WAIT_BAR(0); } else { DA_WAIT_BAR(2); }
    DA_ROT();
#define DA_PAF(k) __builtin_bit_cast(bf16x8, pw##k)
#define DA_VFR(i) (bf16x8){vlo[i][0], vlo[i][1], vlo[i][2], vlo[i][3], vhi[i][0], vhi[i][1], vhi[i][2], vhi[i][3]}
#define DA_VRD(slot, db, ks) do { vlo[slot] = vtr(vp_ + ((db) * 4096 + (ks) * 1024)); vhi[slot] = vtr(vp_ + ((db) * 4096 + (ks) * 1024 + 512)); } while (0)
#define DA_PIN(x) asm volatile("" : "+v"(x))
#define DA_EX2(X, i) do { X[i] = __builtin_amdgcn_exp2f(X[i]); X[(i) + 1] = __builtin_amdgcn_exp2f(X[(i) + 1]); } while (0)
#define DA_STEP(t, GK, GV, GL, BANDON) do { DA_SBAR(); \
    if (GK) { DA_DMA_K((t) + 2, sl_prev); } \
    const lds_cptr vp_ = vp0 + sl_prev; const lds_cptr kp_ = kp0 + sl_cur; \
    kload2(kf, kp_, 2); DA_VRD(0, 0, 0); DA_SBAR(); \
    C0 = DA_MFMA(kf[0], qr[0], negm); kload2(kf, kp_, 3); DA_SBAR(); \
    C1 = DA_MFMA(kf[1], qr[0], negm); DA_VRD(1, 1, 0); DA_SBAR(); \
    C0 = DA_MFMA(kf[2], qr[1], C0);   DA_VRD(2, 2, 0); DA_SBAR(); \
    C1 = DA_MFMA(kf[3], qr[1], C1);   DA_VRD(3, 3, 0); DA_SBAR(); \
    C0 = DA_MFMA(kf[4], qr[2], C0);   DA_VRD(4, 0, 1); DA_SBAR(); \
    C1 = DA_MFMA(kf[5], qr[2], C1);   DA_VRD(5, 1, 1); DA_SBAR(); \
    C0 = DA_MFMA(kf[6], qr[3], C0);   DA_VRD(6, 2, 1); DA_SBAR(); \
    C1 = DA_MFMA(kf[7], qr[3], C1);   DA_VRD(7, 3, 1); DA_SBAR(); \
    if (GV) { DA_DMA_V((t) + 1, sl_next); } \
    if (BANDON) { DA_BAND(C0, C1, t); } \
    { float rm = rowmax(C0, C1); resc = false; \
      if (__builtin_expect(__any(rm > (float)THRL), 0)) { const float dl = __builtin_fmaxf(rm, 0.f); mhat += dl; \
        _Pragma("unroll") for (int r = 0; r < 16; ++r) { C0[r] -= dl; C1[r] -= dl; } \
        _Pragma("unroll") for (int r = 0; r < 16; ++r) negm[r] = -mhat; asm volatile("" : "+v"(negm)); \
        const float f = __builtin_amdgcn_exp2f(-dl); l_reg *= f; if (hi == 0) wsf[r32] = f; resc = true; } } \
    DA_SBAR(); float sacc = 0.f; \
    o[0] = DA_MFMA(DA_PAF(0), DA_VFR(0), o[0]); DA_EX2(C0, 0);  DA_PIN(C0); DA_VRD(0, 0, 2); DA_SBAR(); \
    o[1] = DA_MFMA(DA_PAF(0), DA_VFR(1), o[1]); DA_EX2(C0, 2);  DA_PIN(C0); DA_VRD(1, 1, 2); DA_SBAR(); \
    o[2] = DA_MFMA(DA_PAF(0), DA_VFR(2), o[2]); DA_EX2(C0, 4);  DA_PIN(C0); DA_VRD(2, 2, 2); DA_SBAR(); \
    o[3] = DA_MFMA(DA_PAF(0), DA_VFR(3), o[3]); DA_EX2(C0, 6);  DA_PIN(C0); DA_VRD(3, 3, 2); DA_SBAR(); \
    o[0] = DA_MFMA(DA_PAF(1), DA_VFR(4), o[0]); DA_EX2(C0, 8);  sacc += C0[0] + C0[1]; pw0[0] = cvtpk(C0[0], C0[1]); pw0[1] = cvtpk(C0[2], C0[3]); DA_PIN(C0); DA_PIN(pw0); DA_PIN(sacc); DA_VRD(4, 0, 3); DA_SBAR(); \
    o[1] = DA_MFMA(DA_PAF(1), DA_VFR(5), o[1]); DA_EX2(C0, 10); sacc += C0[2] + C0[3]; pw0[2] = cvtpk(C0[4], C0[5]); pw0[3] = cvtpk(C0[6], C0[7]); DA_PIN(C0); DA_PIN(pw0); DA_PIN(sacc); DA_VRD(5, 1, 3); DA_SBAR(); \
    o[2] = DA_MFMA(DA_PAF(1), DA_VFR(6), o[2]); DA_EX2(C0, 12); sacc += C0[4] + C0[5]; sacc += C0[6] + C0[7]; DA_PIN(C0); DA_PIN(sacc); DA_VRD(6, 2, 3); DA_SBAR(); \
    o[3] = DA_MFMA(DA_PAF(1), DA_VFR(7), o[3]); DA_EX2(C0, 14); sacc += C0[8] + C0[9]; sacc += C0[10] + C0[11]; DA_PIN(C0); DA_PIN(sacc); DA_VRD(7, 3, 3); DA_SBAR(); \
    o[0] = DA_MFMA(DA_PAF(2), DA_VFR(0), o[0]); DA_EX2(C1, 0);  pw1[0] = cvtpk(C0[8], C0[9]); pw1[1] = cvtpk(C0[10], C0[11]); sacc += C0[12] + C0[13]; DA_PIN(C1); DA_PIN(pw1); DA_PIN(sacc); DA_SBAR(); \
    o[1] = DA_MFMA(DA_PAF(2), DA_VFR(1), o[1]); DA_EX2(C1, 2);  pw1[2] = cvtpk(C0[12], C0[13]); pw1[3] = cvtpk(C0[14], C0[15]); sacc += C0[14] + C0[15]; DA_PIN(C1); DA_PIN(pw1); DA_PIN(sacc); DA_SBAR(); \
    o[2] = DA_MFMA(DA_PAF(2), DA_VFR(2), o[2]); DA_EX2(C1, 4);  sacc += C1[0] + C1[1]; sacc += C1[2] + C1[3]; DA_PIN(C1); DA_PIN(sacc); DA_SBAR(); \
    o[3] = DA_MFMA(DA_PAF(2), DA_VFR(3), o[3]); DA_EX2(C1, 6);  sacc += C1[4] + C1[5]; DA_PIN(C1); DA_PIN(sacc); DA_SBAR(); \
    o[0] = DA_MFMA(DA_PAF(3), DA_VFR(4), o[0]); DA_EX2(C1, 8);  pw2[0] = cvtpk(C1[0], C1[1]); pw2[1] = cvtpk(C1[2], C1[3]); sacc += C1[6] + C1[7]; DA_PIN(C1); DA_PIN(pw2); DA_PIN(sacc); if (GL) { kload2(kf, kp0 + sl_next, 0); } DA_SBAR(); \
    o[1] = DA_MFMA(DA_PAF(3), DA_VFR(5), o[1]); DA_EX2(C1, 10); pw2[2] = cvtpk(C1[4], C1[5]); pw2[3] = cvtpk(C1[6], C1[7]); DA_PIN(C1); DA_PIN(pw2); if (GL) { kload2(kf, kp0 + sl_next, 1); } DA_SBAR(); \
    o[2] = DA_MFMA(DA_PAF(3), DA_VFR(6), o[2]); DA_EX2(C1, 12); sacc += C1[8] + C1[9]; sacc += C1[10] + C1[11]; DA_PIN(C1); DA_PIN(sacc); DA_SBAR(); \
    o[3] = DA_MFMA(DA_PAF(3), DA_VFR(7), o[3]); DA_EX2(C1, 14); DA_PIN(C1); DA_SBAR(); \
    sacc += C1[12] + C1[13]; sacc += C1[14] + C1[15]; pw3 = DA_PK4(C1, 8); l_reg += sacc; \
    } while (0)
#define DA_ENDW(tt) do { if ((tt) + 2 < NT) { DA_WAIT_BAR(2); } else { DA_WAIT_BAR(0); } } while (0)
    int t = 1;
    for (; t + 5 < NT; t += 2) {
        DA_STEP(t, true, true, true, false);     if (NOBAR) asm volatile("s_waitcnt vmcnt(2) lgkmcnt(0)" ::: "memory"); else DA_WAIT_BAR(2); DA_RESC(); DA_ROT();
        DA_STEP(t + 1, true, true, true, false); if (NOBAR) asm volatile("s_waitcnt vmcnt(2) lgkmcnt(0)" ::: "memory"); else DA_WAIT_BAR(2); DA_RESC(); DA_ROT();
    }
    for (; t + 1 < NT; t += 2) {
        DA_STEP(t, (t + 2 < NT), (t + 1 < NT), (t + 1 < NT), true);         DA_ENDW(t);     DA_RESC(); DA_ROT();
        DA_STEP(t + 1, (t + 3 < NT), (t + 2 < NT), (t + 2 < NT), true);     DA_ENDW(t + 1); DA_RESC(); DA_ROT();
    }
    DA_STEP(NT - 1, false, false, false, true); DA_RESC();
    { const lds_cptr vp_ = vp0 + sl_cur;
#pragma unroll
      for (int ks = 0; ks < 4; ++ks) {
#pragma unroll
          for (int db = 0; db < 4; ++db) DA_VRD(db, db, ks);
          const bf16x8 pa = ks == 0 ? DA_PAF(0) : ks == 1 ? DA_PAF(1) : ks == 2 ? DA_PAF(2) : DA_PAF(3);
#pragma unroll
          for (int db = 0; db < 4; ++db) o[db] = DA_MFMA(pa, DA_VFR(db), o[db]); } }
    __builtin_amdgcn_s_setprio(0);
    }
    int te_ = tid; asm volatile("" : "+v"(te_)); const int lane_e = te_ & 63;
    const int r32 = lane_e & 31, hi = lane_e >> 5, lane = lane_e;
    float lnw[4];
#pragma unroll
    for (int db = 0; db < 4; ++db) lnw[db] = ln_w[db * 32 + r32];
    {
    { auto rr = __builtin_amdgcn_permlane32_swap(__float_as_uint(l_reg), __float_as_uint(l_reg), false, false); l_reg = __uint_as_float(rr[0]) + __uint_as_float(rr[1]); }
    if (hi == 0) wsf[32 + r32] = l_reg; asm volatile("s_waitcnt lgkmcnt(0)" ::: "memory");
    { const float cs = c == 0 ? 1.f : -lam;
#pragma unroll
      for (int r = 0; r < 16; ++r) { const float rl_ = __builtin_amdgcn_rcpf(wsf[32 + crow(r, hi)]) * cs;
#pragma unroll
          for (int db = 0; db < 4; ++db) o[db][r] *= rl_; } }
    asm volatile("s_waitcnt lgkmcnt(0)\n\ts_barrier" ::: "memory");
    __attribute__((address_space(3))) float* stf = (__attribute__((address_space(3))) float*)(lds + STG_F) + qs * 4096;
    if (c == 1) {
#pragma unroll
        for (int r = 0; r < 16; ++r)
#pragma unroll
            for (int db = 0; db < 4; ++db) stf[crow(r, hi) * 128 + db * 32 + r32] = o[db][r];
    }
    asm volatile("s_waitcnt lgkmcnt(0)\n\ts_barrier" ::: "memory");
    if (c == 0) {
        float ss[16];
#pragma unroll
        for (int r = 0; r < 16; ++r) { float s = 0.f;
#pragma unroll
            for (int db = 0; db < 4; ++db) { o[db][r] += stf[crow(r, hi) * 128 + db * 32 + r32]; s += o[db][r] * o[db][r]; }
            ss[r] = s; }
#pragma unroll
        for (int r = 0; r < 16; ++r) { float s = ss[r];
            s += cdpp<0xB1>(s); s += cdpp<0x4E>(s); s += cdpp<0x141>(s); s += cdpp<0x140>(s);
            { auto r16_ = __builtin_amdgcn_permlane16_swap(__float_as_uint(s), __float_as_uint(s), false, false); const unsigned a_ = r16_[0], b_ = r16_[1]; s = __uint_as_float(a_) + __uint_as_float(b_); }
            ss[r] = rsqrtf(s * (1.f / 128.f) + 1e-6f) * osc; }
        __attribute__((address_space(3))) bf16* stb = (__attribute__((address_space(3))) bf16*)(lds + STG_B) + qs * 4096;
#pragma unroll
        for (int r = 0; r < 16; ++r)
#pragma unroll
            for (int db = 0; db < 4; ++db) { const float v = o[db][r] * ss[r] * lnw[db]; stb[crow(r, hi) * 128 + db * 32 + r32] = (bf16)cvtpk(v, 0.f); }
        asm volatile("s_waitcnt lgkmcnt(0)" ::: "memory");
        bf16* Ow = YC + (rowbase + q0 + qs * 32) * 1024 + h * 128;
#pragma unroll
        for (int i = 0; i < 8; ++i) { const int row = i * 4 + (lane >> 4), ch = lane & 15; const u32x4 v = *(const __attribute__((address_space(3))) u32x4*)(stb + row * 128 + ch * 8); *(u32x4*)(Ow + (long)row * 1024 + ch * 8) = v; }
    }
    }
    asm volatile("s_waitcnt lgkmcnt(0)\n\ts_barrier" ::: "memory");
#undef DA_DMA_K
#undef DA_DMA_V
#undef DA_ROT
#undef DA_RESC
#undef DA_BAND
#undef DA_PK4
#undef DA_PAF
#undef DA_VFR
#undef DA_VRD
#undef DA_PIN
#undef DA_EX2
#undef DA_STEP
#undef DA_ENDW
}
template <bool NOBAR = false> __device__ __forceinline__ void phase(__attribute__((address_space(3))) unsigned char* lds, int bid, int G, int tid, const unsigned short* QKV, unsigned short* YC, const float* rel_bias, const float* ln_w, float lam, float lam_init) {
    const int vcu = (G % 8 == 0) ? (bid % 8) * (G / 8) + bid / 8 : bid;
    __attribute__((address_space(3))) float* tbl = (__attribute__((address_space(3))) float*)(lds + LDS_TBL);
    int hprev = -1;
    for (int v = vcu; v < 256; v += G) {
        const int bh = v >> 2, s = v & 3, b = bh >> 3, h = bh & 7;
        int tq = tid; asm volatile("" : "+v"(tq));
        if (h != hprev) {
            for (int idx = tq; idx < 4 * TBX; idx += 512) { const int s_ = idx / TBX, y_ = idx - s_ * TBX, dist = 256 - (y_ + s_); float v = 0.f;
                if (dist >= 0 && dist < 128) { int bk; if (dist < 16) bk = dist; else { bk = 16 + (int)(logf((float)dist * (1.f / 16.f)) * (16.f / 2.0794415416798357f)); bk = bk > 31 ? 31 : bk; }
                    v = (rel_bias[bk * 8 + h] - rel_bias[31 * 8 + h]) * 1.4426950408889634f; }
                tbl[idx] = v; }
            hprev = h; }
#pragma unroll 1
        for (int i = 0; i < 8; ++i) { const int qb = (i & 1) ? 31 - 4 * (i >> 1) - s : 4 * (i >> 1) + s;
            int tl = tid; asm volatile("" : "+v"(tl));
            unit<NOBAR>(b, h, qb, QKV, YC, lds, ln_w, lam, 1.f - lam_init, tl); }
    }
}
#undef DA_SBAR
#undef DA_WAIT_BAR
#undef DA_MFMA
#undef DA_MX3
}
namespace mix {
typedef unsigned short bf16;
typedef float f32x2 __attribute__((ext_vector_type(2)));
typedef float f32x4 __attribute__((ext_vector_type(4)));
#define MLAS __attribute__((address_space(3)))
constexpr int REC = 640, BLK = 16, NBLK = 4096 / BLK, RSLOTS = 3;
constexpr int R_A = 0, R_WR = 64, R_W = 128, R_B = 192, R_KM = 256, R_V = 320, R_Q2 = 384, R_K2 = 448, R_V2 = 512, R_SC = 576;
template <int CTRL> __device__ __forceinline__ float dppf(float v) { return __builtin_bit_cast(float, __builtin_amdgcn_update_dpp(0, __builtin_bit_cast(int, v), CTRL, 0xF, 0xF, true)); }
__device__ __forceinline__ float xsum16(float v) { auto r = __builtin_amdgcn_permlane16_swap(__float_as_uint(v), __float_as_uint(v), false, false); const unsigned r0 = r[0], r1 = r[1]; return __uint_as_float(r0) + __uint_as_float(r1); }
__device__ __forceinline__ float xsum32(float v) { auto r = __builtin_amdgcn_permlane32_swap(__float_as_uint(v), __float_as_uint(v), false, false); const unsigned r0 = r[0], r1 = r[1]; return __uint_as_float(r0) + __uint_as_float(r1); }
__device__ __forceinline__ float xother32(float v) { auto r = __builtin_amdgcn_permlane32_swap(__float_as_uint(v), __float_as_uint(v), false, false); const unsigned r0 = r[0], r1 = r[1]; const int l = (int)__builtin_amdgcn_mbcnt_hi(~0u, __builtin_amdgcn_mbcnt_lo(~0u, 0u)); return l < 32 ? __uint_as_float(r1) : __uint_as_float(r0); }
__device__ __forceinline__ float rowsum16(float x) { x += dppf<0xB1>(x); x += dppf<0x4E>(x); x += dppf<0x124>(x); x += dppf<0x128>(x); return x; }
__device__ __forceinline__ float sum8(float x) { x += dppf<0xB1>(x); x += dppf<0x4E>(x); x += dppf<0x141>(x); return x; }
__device__ __forceinline__ float treduce4(float x0, float x1, float x2, float x3, bool p1, bool p2) {
    const float k01 = p1 ? x1 : x0, s01 = p1 ? x0 : x1; const float y01 = k01 + dppf<0xB1>(s01);
    const float k23 = p1 ? x3 : x2, s23 = p1 ? x2 : x3; const float y23 = k23 + dppf<0xB1>(s23);
    const float kk = p2 ? y23 : y01, ss = p2 ? y01 : y23; float z = kk + dppf<0x4E>(ss);
    z += dppf<0x124>(z); z += dppf<0x128>(z);
    z = xsum16(z); z = xsum32(z); return z; }
__device__ __forceinline__ float b2f(unsigned v) { return __builtin_bit_cast(float, v << 16); }
typedef float mf32x2_t __attribute__((ext_vector_type(2))); typedef __bf16 mbf16x2_t __attribute__((ext_vector_type(2)));
__device__ __forceinline__ unsigned mixpk(float lo, float hi) { mf32x2_t v = {lo, hi}; mbf16x2_t b = __builtin_convertvector(v, mbf16x2_t); return __builtin_bit_cast(unsigned, b); }
__device__ __forceinline__ unsigned short f2b(float f) { unsigned u = __builtin_bit_cast(unsigned, f); return (unsigned short)((u + 0x7fffu + ((u >> 16) & 1u)) >> 16); }

__device__ __forceinline__ void scan_phase(MLAS float* ring, int bid, int G, int wave, int lane, const bf16* PROJ, const bf16* DECB, const bf16* ALPHA, bf16* YR, float* BONUS, const f32x2* ROT,
                                           const float* mu, const float* k_k, const float* k_a, const float* r_k) {
    constexpr int HYBW = 3840;
    const int vcu = (G % 8 == 0) ? (bid % 8) * (G / 8) + bid / 8 : bid;
    for (int cu = vcu; cu < 256; cu += G) {
        const int bh = cu >> 2, quarter = cu & 3, b = bh >> 3, hh = bh & 7;
        const size_t mb = (size_t)b * 4096;
        if (wave < 4) {
            const int rl = lane >> 4, kp = lane & 15, row = quarter * 16 + wave * 4 + rl;
            const float gamma = 1.f - exp2f(-5.f - (float)hh);
            f32x4 S = {0.f, 0.f, 0.f, 0.f}, T = {0.f, 0.f, 0.f, 0.f};
            bf16* yo = YR + mb * 1024 + hh * 64 + row;
            f32x4 A[2], WR[2], W[2], B[2], KM[2], Q2[2], K2[2]; float VS[2], V2S[2]; f32x2 SC[2];
#define MIX_RD(s, rec_) do { const MLAS float* r_ = (rec_); A[s] = *(const MLAS f32x4*)(r_ + R_A + 4 * kp); WR[s] = *(const MLAS f32x4*)(r_ + R_WR + 4 * kp); W[s] = *(const MLAS f32x4*)(r_ + R_W + 4 * kp); \
            B[s] = *(const MLAS f32x4*)(r_ + R_B + 4 * kp); KM[s] = *(const MLAS f32x4*)(r_ + R_KM + 4 * kp); Q2[s] = *(const MLAS f32x4*)(r_ + R_Q2 + 4 * kp); K2[s] = *(const MLAS f32x4*)(r_ + R_K2 + 4 * kp); \
            VS[s] = r_[R_V + row]; V2S[s] = r_[R_V2 + row]; SC[s] = *(const MLAS f32x2*)(r_ + R_SC); } while (0)
#define MIX_STEP(s, t_) do { \
            float z = (S[0] * A[s][0] + S[1] * A[s][1]) + (S[2] * A[s][2] + S[3] * A[s][3]); \
            float q = (S[0] * WR[s][0] + S[1] * WR[s][1]) + (S[2] * WR[s][2] + S[3] * WR[s][3]); \
            z = rowsum16(z); q = rowsum16(q); \
            const float y = q + z * SC[s][0] + VS[s] * SC[s][1]; \
            S = S * W[s] + (z * B[s] + VS[s] * KM[s]); \
            T = T * gamma + K2[s] * V2S[s]; \
            float o = (T[0] * Q2[s][0] + T[1] * Q2[s][1]) + (T[2] * Q2[s][2] + T[3] * Q2[s][3]); \
            o = rowsum16(o); \
            if (kp == 0) { bf16* yp = yo + (size_t)(t_) * 1024; yp[0] = f2b(y); yp[512] = f2b(o); } } while (0)
            asm volatile("s_waitcnt lgkmcnt(0)\n\ts_barrier" ::: "memory");
            for (int it = -2; it < NBLK; ++it) {
                if (it >= 0) {
                    const MLAS float* blk = ring + (it % RSLOTS) * (BLK * REC);
                    const MLAS float* nblk = ring + ((it + 1) % RSLOTS) * (BLK * REC);
                    if (it == 0) MIX_RD(0, blk);
#pragma unroll
                    for (int j = 0; j < BLK; j += 2) {
                        MIX_RD(1, blk + (j + 1) * REC);
                        MIX_STEP(0, it * BLK + j);
                        if (j + 2 < BLK) MIX_RD(0, blk + (j + 2) * REC); else if (it + 1 < NBLK) MIX_RD(0, nblk);
                        MIX_STEP(1, it * BLK + j + 1);
                    }
                }
                asm volatile("s_waitcnt lgkmcnt(0)\n\ts_barrier" ::: "memory");
            }
#undef MIX_RD
#undef MIX_STEP
        } else {
            const int pwv = wave - 4, par = pwv >> 1, sub = pwv & 1, tk = lane >> 3, ch = lane & 7, c0 = hh * 64 + 8 * ch;
            typedef unsigned v4u_ __attribute__((ext_vector_type(4)));
            const bf16* pr = PROJ + mb * HYBW + c0;
            v4u_ Lr[2][2], Lk[2][2], Lv[2][2], Lq[2], Lk2[2], Lv2[2], La[2], Le[2];
#define MIX_LOAD(s, blk_) do { const int t_ = (blk_) * BLK + 8 * sub + tk; const bf16* p_ = pr + (size_t)t_ * HYBW; const bool hp_ = t_ > 0; const bf16* pp_ = hp_ ? p_ - HYBW : p_; \
            Lr[s][0] = *(const v4u_*)(p_); Lk[s][0] = *(const v4u_*)(p_ + 512); Lv[s][0] = *(const v4u_*)(p_ + 1024); \
            Lr[s][1] = *(const v4u_*)(pp_); Lk[s][1] = *(const v4u_*)(pp_ + 512); Lv[s][1] = *(const v4u_*)(pp_ + 1024); \
            if (!hp_) { Lr[s][1] = (v4u_){0u, 0u, 0u, 0u}; Lk[s][1] = (v4u_){0u, 0u, 0u, 0u}; Lv[s][1] = (v4u_){0u, 0u, 0u, 0u}; } \
            Lq[s] = *(const v4u_*)(p_ + 1792); Lk2[s] = *(const v4u_*)(p_ + 2304); Lv2[s] = *(const v4u_*)(p_ + 2816); \
            La[s] = *(const v4u_*)(ALPHA + (mb + t_) * 512 + c0); Le[s] = *(const v4u_*)(DECB + (mb + t_) * 512 + c0); } while (0)
#define MIX_U(w_, e_) b2f(((e_) & 1) ? ((w_)[(e_) >> 1] >> 16) : ((w_)[(e_) >> 1] & 0xffffu))
#define MIX_PROC(s, blk_) do { const int t_ = (blk_) * BLK + 8 * sub + tk; \
            const f32x4* rp_ = (const f32x4*)(ROT + (size_t)t_ * 32 + 8 * (ch & 3)); f32x4 rot_[4]; rot_[0] = rp_[0]; rot_[1] = rp_[1]; rot_[2] = rp_[2]; rot_[3] = rp_[3];     \
            float p0 = 0.f, p1 = 0.f, p2 = 0.f, p3 = 0.f; \
            _Pragma("unroll") for (int e = 0; e < 8; ++e) { const float rc = MIX_U(Lr[s][0], e), rq = MIX_U(Lr[s][1], e), kc = MIX_U(Lk[s][0], e), kq = MIX_U(Lk[s][1], e); \
                const float r = rc + (rq - rc) * cst[0 * 64 + 8 * ch + e], kraw = kc + (kq - kc) * cst[1 * 64 + 8 * ch + e], al = MIX_U(La[s], e); \
                const float kkr = kraw * cst[3 * 64 + 8 * ch + e], km = kraw * (1.f + (al - 1.f) * cst[4 * 64 + 8 * ch + e]), x2 = km * r; \
                p0 += kkr * kkr; p1 += kkr * al * r; p2 += x2; p3 += x2 * cst[5 * 64 + 8 * ch + e]; } \
            p0 = sum8(p0); p1 = sum8(p1); p2 = sum8(p2); p3 = sum8(p3); \
            const float inv = rsqrtf(fmaxf(p0, 1e-24f)); \
            asm volatile("" : "+v"(Lr[s][0]), "+v"(Lr[s][1]), "+v"(Lk[s][0]), "+v"(Lk[s][1]), "+v"(La[s]));     \
            MLAS float* rec = ring + ((blk_) % RSLOTS) * (BLK * REC) + (8 * sub + tk) * REC + 8 * ch; \
            _Pragma("unroll") for (int h4 = 0; h4 < 2; ++h4) { f32x4 oa, owr, ow, ob, okm, ov, ov2, oq, ok; \
                _Pragma("unroll") for (int e4 = 0; e4 < 4; ++e4) { const int e = 4 * h4 + e4; \
                    const float rc = MIX_U(Lr[s][0], e), rq = MIX_U(Lr[s][1], e), kc = MIX_U(Lk[s][0], e), kq = MIX_U(Lk[s][1], e), vc = MIX_U(Lv[s][0], e), vq = MIX_U(Lv[s][1], e); \
                    const float r = rc + (rq - rc) * cst[0 * 64 + 8 * ch + e], kraw = kc + (kq - kc) * cst[1 * 64 + 8 * ch + e], v = vc + (vq - vc) * cst[2 * 64 + 8 * ch + e], al = MIX_U(La[s], e); \
                    const float dc = __builtin_amdgcn_exp2f(-1.4426950408889634f * MIX_U(Le[s], e)); \
                    const float kk = kraw * cst[3 * 64 + 8 * ch + e] * inv; \
                    oa[e4] = -kk; owr[e4] = dc * r; ow[e4] = dc; ob[e4] = kk * al; okm[e4] = kraw * (1.f + (al - 1.f) * cst[4 * 64 + 8 * ch + e]); ov[e4] = v; ov2[e4] = MIX_U(Lv2[s], e); \
                      \
                    const float cs = rot_[e >> 1][2 * (e & 1)], sn = rot_[e >> 1][2 * (e & 1) + 1]; const float qv = MIX_U(Lq[s], e), kv = MIX_U(Lk2[s], e); \
                    const float qp = __shfl_xor(qv, 4), kp = __shfl_xor(kv, 4); \
                    oq[e4] = ch < 4 ? qv * cs - qp * sn : qp * sn + qv * cs; ok[e4] = (ch < 4 ? kv * cs - kp * sn : kp * sn + kv * cs) * 0.125f; } \
                *(MLAS f32x4*)(rec + R_A + 4 * h4) = oa; *(MLAS f32x4*)(rec + R_WR + 4 * h4) = owr; *(MLAS f32x4*)(rec + R_W + 4 * h4) = ow; *(MLAS f32x4*)(rec + R_B + 4 * h4) = ob; \
                *(MLAS f32x4*)(rec + R_KM + 4 * h4) = okm; *(MLAS f32x4*)(rec + R_V + 4 * h4) = ov; *(MLAS f32x4*)(rec + R_V2 + 4 * h4) = ov2; *(MLAS f32x4*)(rec + R_Q2 + 4 * h4) = oq; *(MLAS f32x4*)(rec + R_K2 + 4 * h4) = ok; } \
            if (ch == 0) { rec[R_SC] = p1 * inv; rec[R_SC + 1] = p2; if (quarter == 0) BONUS[(mb + (size_t)t_) * 8 + hh] = p3; } \
            if ((blk_) + 4 < NBLK) MIX_LOAD(s, (blk_) + 4); } while (0)
#define MIX_BAR() asm volatile("s_waitcnt lgkmcnt(0)\n\ts_barrier" ::: "memory")
            MLAS float* cst = ring + RSLOTS * BLK * REC;
            if (wave == 4) { const int c = hh * 64 + lane; cst[lane] = mu[c]; cst[64 + lane] = mu[512 + c]; cst[128 + lane] = mu[1024 + c]; cst[192 + lane] = k_k[c]; cst[256 + lane] = k_a[c]; cst[320 + lane] = r_k[c]; }
            MIX_LOAD(0, par); MIX_LOAD(1, par + 2);
            MIX_BAR();
            if (par) MIX_BAR();
            for (int b2 = par; b2 < NBLK; b2 += 4) {
                MIX_PROC(0, b2); MIX_BAR(); MIX_BAR();
                MIX_PROC(1, b2 + 2); MIX_BAR(); MIX_BAR();
            }
            MIX_BAR(); if (!par) MIX_BAR();
#undef MIX_PROC
#undef MIX_BAR
#undef MIX_U
#undef MIX_LOAD
        }
    }
}

__device__ __forceinline__ void post_phase(int gw, int NGW, int lane, const bf16* PROJ, bf16* YR, const bf16* GG, const float* BONUS, const float* mu_v_, const float* ln_w, const float* ln_b, const float* ret_ln_w) {
    constexpr int HYBW = 3840;
    const bool p1 = (lane & 1) != 0, p2 = (lane & 2) != 0;
    float lw[8], lb[8], rw[8], muv[8];
#pragma unroll
    for (int j = 0; j < 8; ++j) { lw[j] = ln_w[j * 64 + lane]; lb[j] = ln_b[j * 64 + lane]; rw[j] = ret_ln_w[j * 64 + lane]; muv[j] = mu_v_[j * 64 + lane]; }
    for (int m = gw; m < 32768; m += NGW) {
        bf16* row = YR + (size_t)m * 1024; const bf16* prow = PROJ + (size_t)m * HYBW; const bool has_prev = (m & 4095) != 0;
        float y[8], o[8];
#pragma unroll
        for (int j = 0; j < 8; ++j) { y[j] = b2f(row[j * 64 + lane]); o[j] = b2f(row[512 + j * 64 + lane]); }
        float res[16];
#pragma unroll
        for (int g4 = 0; g4 < 2; ++g4) {
            const float zs = treduce4(y[4 * g4], y[4 * g4 + 1], y[4 * g4 + 2], y[4 * g4 + 3], p1, p2);
            const float m0 = dppf<0x00>(zs) * (1.f / 64.f), m1 = dppf<0x55>(zs) * (1.f / 64.f), m2 = dppf<0xAA>(zs) * (1.f / 64.f), m3 = dppf<0xFF>(zs) * (1.f / 64.f);
            const float d0 = y[4 * g4] - m0, d1 = y[4 * g4 + 1] - m1, d2 = y[4 * g4 + 2] - m2, d3 = y[4 * g4 + 3] - m3;
            const float zv = treduce4(d0 * d0, d1 * d1, d2 * d2, d3 * d3, p1, p2);
            const float r0 = rsqrtf(dppf<0x00>(zv) * (1.f / 64.f) + 64e-5f), r1 = rsqrtf(dppf<0x55>(zv) * (1.f / 64.f) + 64e-5f), r2 = rsqrtf(dppf<0xAA>(zv) * (1.f / 64.f) + 64e-5f), r3 = rsqrtf(dppf<0xFF>(zv) * (1.f / 64.f) + 64e-5f);
            const float dd[4] = {d0 * r0, d1 * r1, d2 * r2, d3 * r3};
#pragma unroll
            for (int q = 0; q < 4; ++q) { const int j = 4 * g4 + q, c = j * 64 + lane;
                const float vc = b2f(prow[1024 + c]), vp = has_prev ? b2f(prow[1024 + c - HYBW]) : 0.f; const float v = vc + (vp - vc) * muv[j];
                const float yn = dd[q] * lw[j] + lb[j];
                res[j] = (yn + BONUS[(size_t)m * 8 + j] * v) * b2f(GG[(size_t)m * 512 + c]); }
            const float zo = treduce4(o[4 * g4] * o[4 * g4], o[4 * g4 + 1] * o[4 * g4 + 1], o[4 * g4 + 2] * o[4 * g4 + 2], o[4 * g4 + 3] * o[4 * g4 + 3], p1, p2);
            const float q0 = rsqrtf(dppf<0x00>(zo) * (1.f / 64.f) + 1e-6f), q1 = rsqrtf(dppf<0x55>(zo) * (1.f / 64.f) + 1e-6f), q2 = rsqrtf(dppf<0xAA>(zo) * (1.f / 64.f) + 1e-6f), q3 = rsqrtf(dppf<0xFF>(zo) * (1.f / 64.f) + 1e-6f);
            const float qq[4] = {q0, q1, q2, q3};
#pragma unroll
            for (int q = 0; q < 4; ++q) { const int j = 4 * g4 + q, c = j * 64 + lane; const float g = b2f(prow[3328 + c]);
                res[8 + j] = o[j] * qq[q] * rw[j] * g / (1.f + __expf(-g)); }
        }
#pragma unroll
        for (int j = 0; j < 8; ++j) { row[j * 64 + lane] = f2b(res[j]); row[512 + j * 64 + lane] = f2b(res[8 + j]); }
    }
}
#define MIX_U(w_, e_) b2f(((e_) & 1) ? ((w_)[(e_) >> 1] >> 16) : ((w_)[(e_) >> 1] & 0xffffu))
__device__ __forceinline__ void post_phase_v(int gw, int NGW, int lane, const bf16* PROJ, bf16* YR, const bf16* GG, const float* BONUS, const float* mu_v_, const float* ln_w, const float* ln_b, const float* ret_ln_w) {
    constexpr int HYBW = 3840;
    typedef unsigned v4u_ __attribute__((ext_vector_type(4)));
    typedef float v4f_ __attribute__((ext_vector_type(4)));
    const int tk = lane >> 3, ch = lane & 7;
    for (int tg = gw; tg < 32768 / 8; tg += NGW) {
        const int m = tg * 8 + tk; const bool has_prev = (m & 4095) != 0;
        bf16* row = YR + (size_t)m * 1024 + 8 * ch; const bf16* prow = PROJ + (size_t)m * HYBW + 8 * ch; const bf16* grow = GG + (size_t)m * 512 + 8 * ch;
#pragma unroll 2
        for (int j = 0; j < 8; ++j) {
            const int c = j * 64 + 8 * ch;
            {
                const v4u_ yw = *(const v4u_*)(row + j * 64), vcw = __builtin_nontemporal_load((const v4u_*)(prow + 1024 + j * 64)), gw4 = __builtin_nontemporal_load((const v4u_*)(grow + j * 64));
                v4u_ vpw = {0u, 0u, 0u, 0u}; if (has_prev) vpw = *(const v4u_*)(prow + 1024 + j * 64 - HYBW);
                const float bon = BONUS[(size_t)m * 8 + j];
                const v4f_ lw0 = *(const v4f_*)(ln_w + c), lw1 = *(const v4f_*)(ln_w + c + 4), lb0 = *(const v4f_*)(ln_b + c), lb1 = *(const v4f_*)(ln_b + c + 4), mv0 = *(const v4f_*)(mu_v_ + c), mv1 = *(const v4f_*)(mu_v_ + c + 4);
                float y[8], s = 0.f;
#pragma unroll
                for (int e = 0; e < 8; ++e) { y[e] = MIX_U(yw, e); s += y[e]; }
                const float mean = sum8(s) * (1.f / 64.f); float q = 0.f;
#pragma unroll
                for (int e = 0; e < 8; ++e) { y[e] -= mean; q += y[e] * y[e]; }
                const float r = rsqrtf(sum8(q) * (1.f / 64.f) + 64e-5f);
                float res[8];
#pragma unroll
                for (int e = 0; e < 8; ++e) { const float vc = MIX_U(vcw, e), vp = MIX_U(vpw, e); const float lw_ = e < 4 ? lw0[e & 3] : lw1[e & 3], lb_ = e < 4 ? lb0[e & 3] : lb1[e & 3], mv_ = e < 4 ? mv0[e & 3] : mv1[e & 3];
                    const float v = vc + (vp - vc) * mv_; res[e] = (y[e] * r * lw_ + lb_ + bon * v) * MIX_U(gw4, e); }
                v4u_ ow;
#pragma unroll
                for (int e = 0; e < 4; ++e) ow[e] = mixpk(res[2 * e], res[2 * e + 1]);
                *(v4u_*)(row + j * 64) = ow; }
            {
                const v4u_ ow_ = *(const v4u_*)(row + 512 + j * 64), gt = __builtin_nontemporal_load((const v4u_*)(prow + 3328 + j * 64));
                const v4f_ rw0 = *(const v4f_*)(ret_ln_w + c), rw1 = *(const v4f_*)(ret_ln_w + c + 4);
                float o[8], s = 0.f;
#pragma unroll
                for (int e = 0; e < 8; ++e) { o[e] = MIX_U(ow_, e); s += o[e] * o[e]; }
                const float qn = rsqrtf(sum8(s) * (1.f / 64.f) + 1e-6f);
                float res[8];
#pragma unroll
                for (int e = 0; e < 8; ++e) { const float g = MIX_U(gt, e), rw_ = e < 4 ? rw0[e & 3] : rw1[e & 3]; res[e] = o[e] * qn * rw_ * g * __builtin_amdgcn_rcpf(1.f + __expf(-g)); }
                v4u_ ow;
#pragma unroll
                for (int e = 0; e < 4; ++e) ow[e] = mixpk(res[2 * e], res[2 * e + 1]);
                *(v4u_*)(row + 512 + j * 64) = ow; }
        }
    }
}
#undef MIX_U
__device__ __forceinline__ void xl_phase(int gtid, int NT_, const bf16* PROJ, const float* mu, bf16* XL, int row0 = 0, int nrows = 32768) {
    constexpr int HYBW = 3840;
    typedef unsigned v4u_ __attribute__((ext_vector_type(4)));
    constexpr int XLU = 8;
    const int ch0 = gtid & 31; const bool fixed = (NT_ & 31) == 0;
    typedef float v4f__ __attribute__((ext_vector_type(4)));
    const v4f__ mu0 = *(const v4f__*)(mu + 1536 + ch0 * 8), mu1 = *(const v4f__*)(mu + 1536 + ch0 * 8 + 4);
    for (int it0 = gtid; it0 < nrows * 32; it0 += XLU * NT_) {
        v4u_ cw[XLU], pw_[XLU];
#pragma unroll
        for (int u = 0; u < XLU; ++u) { const int it = it0 + u * NT_; const bool ok = it < nrows * 32; const int m = row0 + ((ok ? it : it0) >> 5), col = 1536 + ((ok ? it : it0) & 31) * 8;
            cw[u] = *(const v4u_*)(PROJ + (size_t)m * HYBW + col);
            pw_[u] = (v4u_){0u, 0u, 0u, 0u}; if ((m & 4095) != 0) pw_[u] = *(const v4u_*)(PROJ + (size_t)(m - 1) * HYBW + col); }
#pragma unroll
        for (int u = 0; u < XLU; ++u) { const int it = it0 + u * NT_; if (it < nrows * 32) {
            const int m = row0 + (it >> 5), ch = it & 31, col = 1536 + ch * 8;
            float x[8];
#pragma unroll
            for (int e = 0; e < 4; ++e) { const float c0 = b2f(cw[u][e] & 0xffffu), c1 = b2f(cw[u][e] >> 16), q0 = b2f(pw_[u][e] & 0xffffu), q1 = b2f(pw_[u][e] >> 16);
                const float m0 = fixed ? (e < 2 ? mu0[2 * (e & 1)] : mu1[2 * (e & 1)]) : mu[col + 2 * e], m1 = fixed ? (e < 2 ? mu0[2 * (e & 1) + 1] : mu1[2 * (e & 1) + 1]) : mu[col + 2 * e + 1];
                x[2 * e] = c0 + (q0 - c0) * m0; x[2 * e + 1] = c1 + (q1 - c1) * m1; }
            if (ch < 8) {
#pragma unroll
                for (int e = 0; e < 8; ++e) { const float t = __expf(2.f * x[e]); x[e] = 1.f - 2.f * __builtin_amdgcn_rcpf(t + 1.f); } }
            else if (ch >= 16) {
#pragma unroll
                for (int e = 0; e < 8; ++e) x[e] = __builtin_amdgcn_rcpf(1.f + __expf(-x[e])); }
            v4u_ ow;
#pragma unroll
            for (int e = 0; e < 4; ++e) ow[e] = mixpk(x[2 * e], x[2 * e + 1]);
            *(v4u_*)(XL + (size_t)m * 256 + ch * 8) = ow; } }
    }
}
#undef MLAS
}
#ifndef CK_SCAN_PRIO
#define CK_SCAN_PRIO 0
#endif
#ifndef CK_NT
#define CK_NT 0
#endif
#ifndef THREE_ROLE
#define THREE_ROLE 0
#endif
namespace ck {
typedef unsigned short bf16;
typedef float f32x2 __attribute__((ext_vector_type(2)));
typedef float f32x4 __attribute__((ext_vector_type(4)));
typedef short bf16x8 __attribute__((ext_vector_type(8)));
typedef short s16x4 __attribute__((ext_vector_type(4)));
typedef unsigned u32x4 __attribute__((ext_vector_type(4)));
typedef unsigned u32x2 __attribute__((ext_vector_type(2)));
typedef short v4i16_t __attribute__((ext_vector_type(4)));
#define CLAS __attribute__((address_space(3)))
constexpr int NBLK = 256, RING = 10, REC = 12800, NPREP = 6;
constexpr int O_AT = 0, O_RT = 2048, O_BT = 4096, O_KT = 6144, O_IE = 8192, O_CC = 9216, O_P15 = 10240, O_VT = 10496;
constexpr int O_RING = 0, O_SCR = 0, SCR = 0, O_CST = RING * REC  , O_FLAG = O_CST + 1536  ;
constexpr int GRING = 16;
#define CK_MFMA(a, b, c) __builtin_amdgcn_mfma_f32_16x16x32_bf16(a, b, c, 0, 0, 0)
__device__ __forceinline__ float b2f(unsigned v) { return __builtin_bit_cast(float, v << 16); }
__device__ __forceinline__ unsigned f2b(float f) { unsigned u = __builtin_bit_cast(unsigned, f); return (u + 0x7fffu + ((u >> 16) & 1u)) >> 16; }
typedef float f32x2_t __attribute__((ext_vector_type(2))); typedef __bf16 bf16x2_t __attribute__((ext_vector_type(2)));
__device__ __forceinline__ unsigned pk(float lo, float hi) { f32x2_t v = {lo, hi}; bf16x2_t b = __builtin_convertvector(v, bf16x2_t); return __builtin_bit_cast(unsigned, b); }
template <int CTRL> __device__ __forceinline__ float dppf(float v) { return __builtin_bit_cast(float, __builtin_amdgcn_update_dpp(0, __builtin_bit_cast(int, v), CTRL, 0xF, 0xF, true)); }
__device__ __forceinline__ float sum8(float x) { x += dppf<0xB1>(x); x += dppf<0x4E>(x); x += dppf<0x141>(x); return x; }
__device__ __forceinline__ s16x4 vtr(const CLAS unsigned char* p) { return __builtin_bit_cast(s16x4, __builtin_amdgcn_ds_read_tr16_b64_v4i16((CLAS v4i16_t*)p)); }
__device__ __forceinline__ unsigned ldw(volatile CLAS unsigned* p) { return *p; }
#define CK_U(w_, e_) b2f(((e_) & 1) ? ((w_)[(e_) >> 1] >> 16) : ((w_)[(e_) >> 1] & 0xffffu))
#define CK_H(w_, e_) ((float)__builtin_bit_cast(_Float16, (unsigned short)(((e_) & 1) ? ((w_)[(e_) >> 1] >> 16) : ((w_)[(e_) >> 1] & 0xffffu))))
__device__ __forceinline__ float scan8(float x, int lane, float& total) {
    const float s1 = x + dppf<0x118>(x);
    const float rot = dppf<0x128>(s1);
    const float R = (lane & 8) ? s1 : rot;
    auto r16 = __builtin_amdgcn_permlane16_swap(__float_as_uint(R), __float_as_uint(R), false, false); const unsigned e16 = r16[0], o16 = r16[1];
    const float Reven = __uint_as_float(e16), PT = Reven + __uint_as_float(o16);
    auto r32 = __builtin_amdgcn_permlane32_swap(__float_as_uint(PT), __float_as_uint(PT), false, false); const unsigned lo32 = r32[0], hi32 = r32[1];
    const float PTlo = __uint_as_float(lo32);
    total = PTlo + __uint_as_float(hi32);
    return s1 + ((lane & 32) ? PTlo : 0.f) + ((lane & 16) ? Reven : 0.f); }
__device__ __forceinline__ float xor4(float v) { return dppf<0x1B>(dppf<0x141>(v)); }

struct ScanOps { u32x2 r00, r01, r10, r11, a00, a01, a10, a11, vt, vt2; bf16x8 aie, acc_; s16x4 tb[4], tk[4]; f32x4 pp[4]; };
template <bool rw, bool TWO = false> __device__ __forceinline__ void scan_load(ScanOps& o, const CLAS unsigned char* rec, int n, int g, int n0) {
    const CLAS unsigned char* rr = rec + O_RT + n * 128 + g * 8;
    o.r00 = *(const CLAS u32x2*)(rr); o.r01 = *(const CLAS u32x2*)(rr + 32); o.r10 = *(const CLAS u32x2*)(rr + 64); o.r11 = *(const CLAS u32x2*)(rr + 96);
    o.vt = __builtin_bit_cast(u32x2, vtr(rec + O_VT + (4 * g + (n >> 2)) * 128 + (n0 + 4 * (n & 3)) * 2));
    if (TWO) o.vt2 = __builtin_bit_cast(u32x2, vtr(rec + O_VT + (4 * g + (n >> 2)) * 128 + (n0 + 16 + 4 * (n & 3)) * 2));
    if (rw) { const CLAS unsigned char* ra = rec + O_AT + n * 128 + g * 8;
        o.a00 = *(const CLAS u32x2*)(ra); o.a01 = *(const CLAS u32x2*)(ra + 32); o.a10 = *(const CLAS u32x2*)(ra + 64); o.a11 = *(const CLAS u32x2*)(ra + 96);
        o.aie = *(const CLAS bf16x8*)(rec + O_IE + n * 64 + g * 16); }
    o.acc_ = *(const CLAS bf16x8*)(rec + O_CC + n * 64 + g * 16);
    const CLAS unsigned char* tb = rec + O_BT + (4 * g + (n >> 2)) * 128 + (n & 3) * 8;
    const CLAS unsigned char* tk_ = rec + O_KT + (4 * g + (n >> 2)) * 128 + (n & 3) * 8;
#pragma unroll
    for (int m = 0; m < 4; ++m) { if (rw) o.tb[m] = vtr(tb + m * 32); o.tk[m] = vtr(tk_ + m * 32); if (rw) o.pp[m] = *(const CLAS f32x4*)(rec + O_P15 + (m * 16 + 4 * g) * 4); }
}
template <bool rw, int probe = 0> __device__ __forceinline__ void scan_wave(CLAS unsigned char* lds, volatile CLAS unsigned* flag, int wave, int lane, int n0, int hh, size_t mb, bf16* YR) {
    const int n = lane & 15, g = lane >> 4;
    f32x4 S0 = {0.f, 0.f, 0.f, 0.f}, S1 = S0, S2 = S0, S3 = S0;
    const float g16 = exp2f(16.f * log2f(1.f - exp2f(-5.f - (float)hh)));
    bf16* yo = YR + (mb + 4 * g) * 1024 + (rw ? 0 : 512) + hh * 64 + n0 + n;
    ScanOps A, B;
#define CK_WAITREADY(blk_) do { unsigned sp = 0; while (ldw(flag + ((blk_) % RING)) != (unsigned)((blk_) + 1)) { __builtin_amdgcn_s_sleep(1); if (++sp > (1u << 22)) break; } asm volatile("" ::: "memory"); } while (0)
#define CK_UPD(O, Sm, m) do { s16x4 tb_ = {0, 0, 0, 0}; if (rw) tb_ = O.tb[m]; const s16x4 tk2_ = O.tk[m]; \
        const bf16x8 abk = (bf16x8){tb_[0], tb_[1], tb_[2], tb_[3], tk2_[0], tk2_[1], tk2_[2], tk2_[3]}; Sm = CK_MFMA(abk, fu, Sm); \
        if (rw) { Sm = Sm * O.pp[m]; } else { Sm = Sm * g16; } } while (0)
#define CK_BLOCK(O, N, blk_) do { \
        asm volatile("s_waitcnt lgkmcnt(0)" ::: "memory"); \
        if (lane == 0) flag[12 + wave] = (unsigned)((blk_) + 1); \
        if ((blk_) + 1 < NBLK) { CK_WAITREADY((blk_) + 1); scan_load<rw>(N, lds + O_RING + (((blk_) + 1) % RING) * REC, n, g, n0); } \
        if (probe == 2) break; \
        const bf16x8 sb0 = __builtin_bit_cast(bf16x8, (u32x4){pk(S0[0], S0[1]), pk(S0[2], S0[3]), pk(S1[0], S1[1]), pk(S1[2], S1[3])}); \
        const bf16x8 sb1 = __builtin_bit_cast(bf16x8, (u32x4){pk(S2[0], S2[1]), pk(S2[2], S2[3]), pk(S3[0], S3[1]), pk(S3[2], S3[3])}); \
        f32x4 ZT = {0.f, 0.f, 0.f, 0.f}, YT = {0.f, 0.f, 0.f, 0.f}; \
        u32x4 fz; fz[0] = 0u; fz[1] = 0u; fz[2] = O.vt[0]; fz[3] = O.vt[1]; \
        if (rw) { \
            ZT = CK_MFMA(__builtin_bit_cast(bf16x8, (u32x4){O.a00[0], O.a00[1], O.a01[0], O.a01[1]}), sb0, ZT); \
            ZT = CK_MFMA(__builtin_bit_cast(bf16x8, (u32x4){O.a10[0], O.a10[1], O.a11[0], O.a11[1]}), sb1, ZT); } \
        YT = CK_MFMA(__builtin_bit_cast(bf16x8, (u32x4){O.r00[0], O.r00[1], O.r01[0], O.r01[1]}), sb0, YT); \
        YT = CK_MFMA(__builtin_bit_cast(bf16x8, (u32x4){O.r10[0], O.r10[1], O.r11[0], O.r11[1]}), sb1, YT); \
        if (rw) { fz[0] = pk(ZT[0], ZT[1]); fz[1] = pk(ZT[2], ZT[3]); \
            const f32x4 zero = {0.f, 0.f, 0.f, 0.f}; \
            const f32x4 UT = CK_MFMA(O.aie, __builtin_bit_cast(bf16x8, fz), zero); \
            fz[0] = pk(UT[0], UT[1]); fz[1] = pk(UT[2], UT[3]); } \
        const bf16x8 fu = __builtin_bit_cast(bf16x8, fz); \
        CK_UPD(O, S0, 0); CK_UPD(O, S1, 1); CK_UPD(O, S2, 2); CK_UPD(O, S3, 3); \
        YT = CK_MFMA(O.acc_, fu, YT); \
        bf16* yp = yo + (size_t)(blk_) * 16 * 1024; \
        { const unsigned y01 = pk(YT[0], YT[1]), y23 = pk(YT[2], YT[3]); yp[0] = (bf16)y01; yp[1024] = (bf16)(y01 >> 16); yp[2048] = (bf16)y23; yp[3072] = (bf16)(y23 >> 16); } \
    } while (0)
    CK_WAITREADY(0); scan_load<rw>(A, lds + O_RING, n, g, n0);
    for (int blk = 0; blk < NBLK; blk += 2) {
#ifdef PROBE_SCAN_DELAY
        if (rw) __builtin_amdgcn_s_sleep(PROBE_SCAN_DELAY);
#endif
        CK_BLOCK(A, B, blk);
        CK_BLOCK(B, A, blk + 1);
    }
#undef CK_BLOCK
#undef CK_UPD
#undef CK_WAITREADY
}
template <bool rw, int probe = 0> __device__ __forceinline__ void scan_wave2(CLAS unsigned char* lds, volatile CLAS unsigned* flag, int wave, int lane, int n0, int hh, size_t mb, bf16* YR) {
    const int n = lane & 15, g = lane >> 4;
    f32x4 S0 = {0.f, 0.f, 0.f, 0.f}, S1 = S0, S2 = S0, S3 = S0, T0 = S0, T1 = S0, T2 = S0, T3 = S0;
    const float g16 = exp2f(16.f * log2f(1.f - exp2f(-5.f - (float)hh)));
    bf16* yo = YR + (mb + 4 * g) * 1024 + (rw ? 0 : 512) + hh * 64 + n0 + n;
    ScanOps A, B;
#define CK_WAITREADY(blk_) do { unsigned sp = 0; while (ldw(flag + ((blk_) % RING)) != (unsigned)((blk_) + 1)) { __builtin_amdgcn_s_sleep(1); if (++sp > (1u << 22)) break; } asm volatile("" ::: "memory"); } while (0)
#define CK_UPD(O, Sm, m, FU) do { s16x4 tb_ = {0, 0, 0, 0}; if (rw) tb_ = O.tb[m]; const s16x4 tk2_ = O.tk[m]; \
        const bf16x8 abk = (bf16x8){tb_[0], tb_[1], tb_[2], tb_[3], tk2_[0], tk2_[1], tk2_[2], tk2_[3]}; Sm = CK_MFMA(abk, FU, Sm); \
        if (rw) { Sm = Sm * O.pp[m]; } else { Sm = Sm * g16; } } while (0)
#define CK_CHAIN(O, Q0, Q1, Q2, Q3, VT, YOFF, blk_) do { \
        const bf16x8 sb0 = __builtin_bit_cast(bf16x8, (u32x4){pk(Q0[0], Q0[1]), pk(Q0[2], Q0[3]), pk(Q1[0], Q1[1]), pk(Q1[2], Q1[3])}); \
        const bf16x8 sb1 = __builtin_bit_cast(bf16x8, (u32x4){pk(Q2[0], Q2[1]), pk(Q2[2], Q2[3]), pk(Q3[0], Q3[1]), pk(Q3[2], Q3[3])}); \
        f32x4 ZT = {0.f, 0.f, 0.f, 0.f}, YT = {0.f, 0.f, 0.f, 0.f}; \
        u32x4 fz; fz[0] = 0u; fz[1] = 0u; fz[2] = VT[0]; fz[3] = VT[1]; \
        if (rw) { \
            ZT = CK_MFMA(__builtin_bit_cast(bf16x8, (u32x4){O.a00[0], O.a00[1], O.a01[0], O.a01[1]}), sb0, ZT); \
            ZT = CK_MFMA(__builtin_bit_cast(bf16x8, (u32x4){O.a10[0], O.a10[1], O.a11[0], O.a11[1]}), sb1, ZT); } \
        YT = CK_MFMA(__builtin_bit_cast(bf16x8, (u32x4){O.r00[0], O.r00[1], O.r01[0], O.r01[1]}), sb0, YT); \
        YT = CK_MFMA(__builtin_bit_cast(bf16x8, (u32x4){O.r10[0], O.r10[1], O.r11[0], O.r11[1]}), sb1, YT); \
        if (rw) { fz[0] = pk(ZT[0], ZT[1]); fz[1] = pk(ZT[2], ZT[3]); \
            const f32x4 zero = {0.f, 0.f, 0.f, 0.f}; \
            const f32x4 UT = CK_MFMA(O.aie, __builtin_bit_cast(bf16x8, fz), zero); \
            fz[0] = pk(UT[0], UT[1]); fz[1] = pk(UT[2], UT[3]); } \
        const bf16x8 fu = __builtin_bit_cast(bf16x8, fz); \
        CK_UPD(O, Q0, 0, fu); CK_UPD(O, Q1, 1, fu); CK_UPD(O, Q2, 2, fu); CK_UPD(O, Q3, 3, fu); \
        YT = CK_MFMA(O.acc_, fu, YT); \
        bf16* yp = yo + (size_t)(blk_) * 16 * 1024 + (YOFF); \
        { const unsigned y01 = pk(YT[0], YT[1]), y23 = pk(YT[2], YT[3]); yp[0] = (bf16)y01; yp[1024] = (bf16)(y01 >> 16); yp[2048] = (bf16)y23; yp[3072] = (bf16)(y23 >> 16); } \
    } while (0)
#define CK_BLOCK2(O, N, blk_) do { \
        asm volatile("s_waitcnt lgkmcnt(0)" ::: "memory"); \
        if (lane == 0) flag[12 + wave] = (unsigned)((blk_) + 1); \
        if (probe == 2) { if ((blk_) + 1 < NBLK) { CK_WAITREADY((blk_) + 1); scan_load<rw, true>(N, lds + O_RING + (((blk_) + 1) % RING) * REC, n, g, n0); } break; } \
        CK_CHAIN(O, S0, S1, S2, S3, O.vt, 0, blk_); \
          \
        if ((blk_) + 1 < NBLK) { CK_WAITREADY((blk_) + 1); scan_load<rw, true>(N, lds + O_RING + (((blk_) + 1) % RING) * REC, n, g, n0); } \
        CK_CHAIN(O, T0, T1, T2, T3, O.vt2, 16, blk_); \
    } while (0)
    __builtin_amdgcn_s_setprio(CK_SCAN_PRIO);
    CK_WAITREADY(0); scan_load<rw, true>(A, lds + O_RING, n, g, n0);
    for (int blk = 0; blk < NBLK; blk += 2) {
#ifdef PROBE_SCAN_DELAY
        if (rw) __builtin_amdgcn_s_sleep(PROBE_SCAN_DELAY);
#endif
        CK_BLOCK2(A, B, blk);
        CK_BLOCK2(B, A, blk + 1);
    }
    __builtin_amdgcn_s_setprio(0);
#undef CK_BLOCK2
#undef CK_CHAIN
#undef CK_UPD
#undef CK_WAITREADY
}
template <bool rw, int NP, bool GLOBAL, int probe = 0, int NSCAN = 2> __device__ __forceinline__ void prep_wave(CLAS unsigned char* lds, volatile CLAS unsigned* flag, int pwv, int first, int lane, int hh, size_t mb, bool bonus_on,
        const bf16* PROJ, const bf16* DECB, const bf16* ALPHA, float* BONUS, const f32x2* ROT, unsigned char* gring, unsigned* gflag, unsigned* gack, unsigned ep0) {
    constexpr int HYBW = 3840;
            const int tk = lane >> 3, ch = lane & 7, c0 = hh * 64 + 8 * ch;
            const CLAS float* cst = (const CLAS float*)(lds + O_CST);
            CLAS unsigned char* scr = lds + O_SCR + pwv * SCR;
            const bf16* pr = PROJ + mb * HYBW + c0;
            const float l2g = log2f(1.f - exp2f(-5.f - (float)hh));
            u32x4 LG[2][9];
#define CK_NTL(p__) (CK_NT ? __builtin_nontemporal_load((const u32x4*)(p__)) : *(const u32x4*)(p__))
#define CK_LOAD(rd_, blk_) do { int t_ = (blk_) * 16 + 8 * (rd_) + tk; asm volatile("" : "+v"(t_));     \
                const bf16* p_ = pr + (size_t)t_ * HYBW; \
                if (rw) { const bool hp_ = t_ > 0; const bf16* pp_ = hp_ ? p_ - HYBW : p_; \
                    LG[rd_][0] = CK_NTL(p_); LG[rd_][1] = CK_NTL(p_ + 512); LG[rd_][2] = CK_NTL(p_ + 1024); \
                    LG[rd_][3] = *(const u32x4*)(pp_); LG[rd_][4] = *(const u32x4*)(pp_ + 512); LG[rd_][5] = *(const u32x4*)(pp_ + 1024); \
                    if (!hp_) { LG[rd_][3] = (u32x4){0u, 0u, 0u, 0u}; LG[rd_][4] = LG[rd_][3]; LG[rd_][5] = LG[rd_][3]; } \
                    LG[rd_][6] = *(const u32x4*)(ALPHA + (mb + t_) * 512 + c0); LG[rd_][7] = *(const u32x4*)(DECB + (mb + t_) * 512 + c0); \
                    LG[rd_][8] = (u32x4){0u, 0u, 0u, 0u}; if ((t_ & 15) != 0) LG[rd_][8] = *(const u32x4*)(DECB + (mb + t_ - 1) * 512 + c0); } \
                else { LG[rd_][0] = CK_NTL(p_ + 1792); LG[rd_][1] = CK_NTL(p_ + 2304); LG[rd_][2] = CK_NTL(p_ + 2816); \
                    const u32x4* rp_ = (const u32x4*)(ROT + (size_t)t_ * 32 + 8 * (ch & 3)); LG[rd_][3] = rp_[0]; LG[rd_][4] = rp_[1]; LG[rd_][5] = rp_[2]; LG[rd_][6] = rp_[3]; } } while (0)
#define CK_NEXTBLK() ({ unsigned v_ = 0u; if (lane == 0) v_ = __hip_atomic_fetch_add((CLAS unsigned*)(flag + 16), 1u, __ATOMIC_RELAXED, __HIP_MEMORY_SCOPE_WORKGROUP); (int)__builtin_amdgcn_readfirstlane(v_); })
            int blk = GLOBAL ? first : CK_NEXTBLK();
            if (blk < NBLK) { CK_LOAD(0, blk); CK_LOAD(1, blk); }
            while (blk < NBLK) {
                const int nxt = GLOBAL ? blk + NP : CK_NEXTBLK();
                CLAS unsigned char* rec = lds + O_RING + (GLOBAL ? pwv : (blk % RING)) * REC;
                if (!GLOBAL && blk >= RING) { unsigned sp = 0; const unsigned need = (unsigned)(blk - RING + 1); while (ldw(flag + 12) < need || (NSCAN > 1 && ldw(flag + 13) < need) || (NSCAN > 2 && (ldw(flag + 14) < need || ldw(flag + 15) < need))) { __builtin_amdgcn_s_sleep(2); if (++sp > (1u << 22)) break; } }
                asm volatile("" ::: "memory");
                if (probe == 1) { if (lane == 0) flag[blk % RING] = (unsigned)(blk + 1); blk = nxt; continue; }
#ifdef PROBE_PREP_DELAY
                if (rw) __builtin_amdgcn_s_sleep(PROBE_PREP_DELAY);
#endif
#pragma unroll
                for (int rd = 0; rd < 2; ++rd) {
                    const int j = 8 * rd + tk, t = blk * 16 + j;
                    if (rw) {
                        const u32x4 Lr0 = LG[rd][0], Lk0 = LG[rd][1], Lv0 = LG[rd][2], Lr1 = LG[rd][3], Lk1 = LG[rd][4], Lv1 = LG[rd][5], La = LG[rd][6], Le = LG[rd][7], Lm = LG[rd][8];
                        float r[8], km[8], kkr[8], al[8], vv[8]; float n2 = 0.f, bon = 0.f;
#pragma unroll
                        for (int e = 0; e < 8; ++e) { const float rc = CK_U(Lr0, e), rq = CK_U(Lr1, e), kc = CK_U(Lk0, e), kq = CK_U(Lk1, e), vc = CK_U(Lv0, e), vq = CK_U(Lv1, e);
                            r[e] = rc + (rq - rc) * cst[8 * ch + e]; const float kraw = kc + (kq - kc) * cst[64 + 8 * ch + e]; vv[e] = vc + (vq - vc) * cst[128 + 8 * ch + e];
                            al[e] = CK_U(La, e);
                            kkr[e] = kraw * cst[192 + 8 * ch + e]; km[e] = kraw * (1.f + (al[e] - 1.f) * cst[256 + 8 * ch + e]);
                            n2 += kkr[e] * kkr[e]; bon += r[e] * km[e] * cst[320 + 8 * ch + e]; }
                        if (nxt < NBLK) CK_LOAD(rd, nxt);
                        n2 = sum8(n2); bon = sum8(bon);
                        const float inv = rsqrtf(fmaxf(n2, 1e-24f));
                        if (ch == 0 && bonus_on) BONUS[(mb + t) * 8 + hh] = bon;
                        u32x4 oa, ob, ok, orr; float lpl[8];
#pragma unroll
                        for (int e = 0; e < 8; ++e) {
                            const float lp = CK_H(Le, e), lpm = CK_H(Lm, e); lpl[e] = lp;
                            const float em = __builtin_amdgcn_exp2f(-lp), ep = __builtin_amdgcn_exp2f(lp), epm = __builtin_amdgcn_exp2f(lpm);
                            const float kk = kkr[e] * inv;
                            r[e] = r[e] * ep; km[e] = km[e] * em; kkr[e] = -kk * epm; al[e] = kk * al[e] * em; }
#pragma unroll
                        for (int e = 0; e < 4; ++e) { oa[e] = pk(kkr[2 * e], kkr[2 * e + 1]); ob[e] = pk(al[2 * e], al[2 * e + 1]); ok[e] = pk(km[2 * e], km[2 * e + 1]); orr[e] = pk(r[2 * e], r[2 * e + 1]); }
                        *(CLAS u32x4*)(rec + O_AT + j * 128 + ch * 16) = oa; *(CLAS u32x4*)(rec + O_BT + j * 128 + ch * 16) = ob;
                        *(CLAS u32x4*)(rec + O_KT + j * 128 + ch * 16) = ok; *(CLAS u32x4*)(rec + O_RT + j * 128 + ch * 16) = orr;
#pragma unroll
                        for (int e = 0; e < 8; ++e) { (void)0; }
                        { u32x4 ov; ov[0] = pk(vv[0], vv[1]); ov[1] = pk(vv[2], vv[3]); ov[2] = pk(vv[4], vv[5]); ov[3] = pk(vv[6], vv[7]); *(CLAS u32x4*)(rec + O_VT + j * 128 + ch * 16) = ov; }
                        if (rd == 1 && tk == 7) { *(CLAS f32x4*)(rec + O_P15 + ch * 32) = (f32x4){__builtin_amdgcn_exp2f(lpl[0]), __builtin_amdgcn_exp2f(lpl[1]), __builtin_amdgcn_exp2f(lpl[2]), __builtin_amdgcn_exp2f(lpl[3])};
                            *(CLAS f32x4*)(rec + O_P15 + ch * 32 + 16) = (f32x4){__builtin_amdgcn_exp2f(lpl[4]), __builtin_amdgcn_exp2f(lpl[5]), __builtin_amdgcn_exp2f(lpl[6]), __builtin_amdgcn_exp2f(lpl[7])}; }
                    } else {
                        const u32x4 Lq = LG[rd][0], Lk = LG[rd][1], Lv = LG[rd][2]; f32x4 rot_[4]; rot_[0] = __builtin_bit_cast(f32x4, LG[rd][3]); rot_[1] = __builtin_bit_cast(f32x4, LG[rd][4]); rot_[2] = __builtin_bit_cast(f32x4, LG[rd][5]); rot_[3] = __builtin_bit_cast(f32x4, LG[rd][6]);
                        if (nxt < NBLK) CK_LOAD(rd, nxt);
                        const float pw = __builtin_amdgcn_exp2f((float)(j + 1) * l2g), ipw = 0.125f * __builtin_amdgcn_exp2f(-(float)(j + 1) * l2g);
                        u32x4 oq, ok; float qo[8], ko[8];
#pragma unroll
                        for (int e = 0; e < 8; ++e) { const float cs = rot_[e >> 1][2 * (e & 1)], sn = rot_[e >> 1][2 * (e & 1) + 1]; const float qv = CK_U(Lq, e), kv = CK_U(Lk, e);
                            const float qp = xor4(qv), kp = xor4(kv);
                            qo[e] = (ch < 4 ? qv * cs - qp * sn : qp * sn + qv * cs) * pw; ko[e] = (ch < 4 ? kv * cs - kp * sn : kp * sn + kv * cs) * ipw;
                        }
                        *(CLAS u32x4*)(rec + O_VT + j * 128 + ch * 16) = Lv;
#pragma unroll
                        for (int e = 0; e < 4; ++e) { oq[e] = pk(qo[2 * e], qo[2 * e + 1]); ok[e] = pk(ko[2 * e], ko[2 * e + 1]); }
                        *(CLAS u32x4*)(rec + O_RT + j * 128 + ch * 16) = oq; *(CLAS u32x4*)(rec + O_KT + j * 128 + ch * 16) = ok;
                    }
                }
                asm volatile("s_waitcnt lgkmcnt(0)" ::: "memory");
                const int jc = lane & 15, gg = lane >> 4;
                const bf16x8 bR0 = *(const CLAS bf16x8*)(rec + O_RT + jc * 128 + gg * 16), bR1 = *(const CLAS bf16x8*)(rec + O_RT + jc * 128 + 64 + gg * 16);
                const bf16x8 aK0 = *(const CLAS bf16x8*)(rec + O_KT + jc * 128 + gg * 16), aK1 = *(const CLAS bf16x8*)(rec + O_KT + jc * 128 + 64 + gg * 16);
                const f32x4 zero = {0.f, 0.f, 0.f, 0.f};
                f32x4 crk = CK_MFMA(aK0, bR0, zero); crk = CK_MFMA(aK1, bR1, crk);
#pragma unroll
                for (int r = 0; r < 4; ++r) crk[r] = (4 * gg + r <= jc) ? crk[r] : 0.f;
                if (!rw) {
                    u32x4 w; w[0] = 0u; w[1] = 0u; w[2] = pk(crk[0], crk[1]); w[3] = pk(crk[2], crk[3]);
                    *(CLAS u32x4*)(rec + O_CC + jc * 64 + gg * 16) = w;
                } else {
                    const bf16x8 bA0 = *(const CLAS bf16x8*)(rec + O_AT + jc * 128 + gg * 16), bA1 = *(const CLAS bf16x8*)(rec + O_AT + jc * 128 + 64 + gg * 16);
                    const bf16x8 aB0 = *(const CLAS bf16x8*)(rec + O_BT + jc * 128 + gg * 16), aB1 = *(const CLAS bf16x8*)(rec + O_BT + jc * 128 + 64 + gg * 16);
                    f32x4 crb = CK_MFMA(aB0, bR0, zero); crb = CK_MFMA(aB1, bR1, crb);
                    f32x4 cab = CK_MFMA(aB0, bA0, zero); cab = CK_MFMA(aB1, bA1, cab);
                    f32x4 cba = CK_MFMA(bA0, aB0, zero); cba = CK_MFMA(bA1, aB1, cba);
                    f32x4 cka = CK_MFMA(bA0, aK0, zero); cka = CK_MFMA(bA1, aK1, cka);
                    f32x4 idn;
#pragma unroll
                    for (int r = 0; r < 4; ++r) { crb[r] = (4 * gg + r <= jc) ? crb[r] : 0.f; cab[r] = (4 * gg + r < jc) ? cab[r] : 0.f;
                        cba[r] = (jc < 4 * gg + r) ? cba[r] : 0.f; cka[r] = (jc < 4 * gg + r) ? cka[r] : 0.f; idn[r] = (4 * gg + r == jc) ? 1.f : 0.f; }
                    { u32x4 w; w[0] = pk(crb[0], crb[1]); w[1] = pk(crb[2], crb[3]); w[2] = pk(crk[0], crk[1]); w[3] = pk(crk[2], crk[3]); *(CLAS u32x4*)(rec + O_CC + jc * 64 + gg * 16) = w; }
#define CK_PROD(X, Y, ACC) ({ f32x4 p_ = (ACC); _Pragma("unroll") for (int r_ = 0; r_ < 4; ++r_) p_ = __builtin_amdgcn_mfma_f32_16x16x4f32((X)[r_], (Y)[r_], p_, 0, 0, 0); p_; })
                    const f32x4 d2 = CK_PROD(cab, cba, zero), c2 = CK_PROD(cba, cab, zero);
                    const f32x4 d4 = CK_PROD(c2, d2, zero), c4 = CK_PROD(d2, c2, zero);
                    const f32x4 d8 = CK_PROD(c4, d4, zero);
                    const f32x4 s1 = cba + idn, t1 = cab + idn;
                    const f32x4 s2 = CK_PROD(t1, d2, s1), t2 = CK_PROD(d2, t1, t1);
                    const f32x4 s3 = CK_PROD(t2, d4, s2), t3 = CK_PROD(d4, t2, t2);
                    const f32x4 s4 = CK_PROD(t3, d8, s3), t4 = CK_PROD(d8, t3, t3);
                    const f32x4 et = CK_PROD(t4, cka, zero);
#undef CK_PROD
#pragma unroll
                    for (int r = 0; r < 4; ++r) { const int i = 4 * gg + r;
                        *(CLAS bf16*)(rec + O_IE + i * 64 + ((jc >> 2) * 8 + (jc & 3)) * 2) = (bf16)pk(s4[r], 0.f);
                        *(CLAS bf16*)(rec + O_IE + i * 64 + ((jc >> 2) * 8 + 4 + (jc & 3)) * 2) = (bf16)pk(et[r], 0.f); }
                }
                asm volatile("s_waitcnt lgkmcnt(0)" ::: "memory");
                if (!GLOBAL) { if (lane == 0) flag[blk % RING] = (unsigned)(blk + 1); }
                else {
                    const int gs = blk & (GRING - 1);
                    if (blk >= GRING) { const unsigned need = ep0 + (unsigned)(blk - GRING + 1); unsigned sp = 0;
                        while (__hip_atomic_load(gack + gs * 64, __ATOMIC_RELAXED, __HIP_MEMORY_SCOPE_AGENT) != need) { __builtin_amdgcn_s_sleep(2); if (++sp > (1u << 20)) break; } }
                    unsigned char* gd = gring + (size_t)gs * REC + lane * 16;
#pragma unroll
                    for (int i = 0; i < 13; ++i) { if (i < 12 || lane < 32) { const u32x4 v = *(const CLAS u32x4*)(rec + i * 1024 + lane * 16);
                        asm volatile("global_store_dwordx4 %0, %1, off sc1" :: "v"(gd + i * 1024), "v"(v) : "memory"); } }
                    asm volatile("s_waitcnt vmcnt(0)" ::: "memory");
                    if (lane == 0) __hip_atomic_store(gflag + gs * 64, ep0 + (unsigned)(blk + 1), __ATOMIC_RELAXED, __HIP_MEMORY_SCOPE_AGENT);
                }
                blk = nxt;
            }
#undef CK_NEXTBLK
}

__device__ __forceinline__ void rwkv_consumer(CLAS unsigned char* lds, volatile CLAS unsigned* flag, int wave, int lane, int hh, size_t mb, bf16* YR, const unsigned char* gring, unsigned* gflag, unsigned* gack, unsigned ep0) {
    if (wave < 4) { scan_wave<true, 0>(lds, flag, wave, lane, wave * 16, hh, mb, YR); return; }
    if (wave == 4) {
        int avail = 0; unsigned sp = 0;
        while (avail < NBLK) {
            const int bi = avail + (lane & (GRING - 1));
            const unsigned v = __hip_atomic_load(gflag + (bi & (GRING - 1)) * 64, __ATOMIC_RELAXED, __HIP_MEMORY_SCOPE_AGENT);
            const bool ok = (lane < GRING) && (bi < NBLK) && (v == ep0 + (unsigned)(bi + 1));
            const unsigned long long m = __ballot(ok);
            const int n = __builtin_ctzll(~m);
            if (n > 0) { __builtin_amdgcn_fence(__ATOMIC_ACQUIRE, "agent"); asm volatile("s_waitcnt vmcnt(0)" ::: "memory"); avail += n; if (lane == 0) flag[16] = (unsigned)avail; sp = 0; }
            else { __builtin_amdgcn_s_sleep(1); if (++sp > (1u << 20)) break; }
        }
        if (lane == 0) flag[16] = (unsigned)NBLK;
        return;
    }
    int prev = -1;
    for (int blk = wave - 5; blk < NBLK; blk += 3) {
        const int slot = blk % RING, gs = blk & (GRING - 1);
        if (blk >= RING) { unsigned sp = 0; const unsigned need = (unsigned)(blk - RING + 1);
            while (ldw(flag + 12) < need || ldw(flag + 13) < need || ldw(flag + 14) < need || ldw(flag + 15) < need) { __builtin_amdgcn_s_sleep(1); if (++sp > (1u << 22)) break; } }
        { unsigned sp = 0; while (ldw(flag + 16) <= (unsigned)blk) { __builtin_amdgcn_s_sleep(1); if (++sp > (1u << 22)) break; } }
        asm volatile("" ::: "memory");
        const unsigned char* gsrc = gring + (size_t)gs * REC + lane * 16;
        CLAS unsigned char* dst = lds + O_RING + slot * REC;
#pragma unroll
        for (int i = 0; i < 13; ++i) { if (i < 12 || lane < 32) __builtin_amdgcn_global_load_lds((const unsigned*)(gsrc + i * 1024), (CLAS unsigned*)(dst + i * 1024), 16, 0, 0); }
        if (prev >= 0) { asm volatile("s_waitcnt vmcnt(13)" ::: "memory");
            if (lane == 0) { flag[prev % RING] = (unsigned)(prev + 1); __hip_atomic_store(gack + (prev & (GRING - 1)) * 64, ep0 + (unsigned)(prev + 1), __ATOMIC_RELAXED, __HIP_MEMORY_SCOPE_AGENT); } }
        prev = blk;
    }
    asm volatile("s_waitcnt vmcnt(0)" ::: "memory");
    if (prev >= 0 && lane == 0) { flag[prev % RING] = (unsigned)(prev + 1); __hip_atomic_store(gack + (prev & (GRING - 1)) * 64, ep0 + (unsigned)(prev + 1), __ATOMIC_RELAXED, __HIP_MEMORY_SCOPE_AGENT); }
}

template <int probe = 0> __device__ __forceinline__ void phase(CLAS unsigned char* lds, int bid, int G, int wave, int lane, const bf16* PROJ, const bf16* DECB, const bf16* ALPHA, bf16* YR, float* BONUS, const f32x2* ROT,
                                      const float* mu, const float* k_k, const float* k_a, const float* r_k, unsigned char* gring0, unsigned* gflag0, unsigned* gack0, unsigned ep0) {
    const int vcu = (G % 8 == 0) ? (bid % 8) * (G / 8) + bid / 8 : bid;
    volatile CLAS unsigned* flag = (volatile CLAS unsigned*)(lds + O_FLAG);
    const bool three = (G == 256) && (THREE_ROLE != 0);
    for (int cu = vcu; cu < 256; cu += G) {
        const bool rw = three ? ((cu & 3) < 3) : (cu < 128); const int cc = rw ? cu : cu - 128, role = cu & 3;
        const int bh = three ? (cu >> 2) : (cc >> 1), half = three ? 0 : (cc & 1), b = bh >> 3, hh = bh & 7;
        const size_t mb = (size_t)b * 4096;
        __syncthreads();
        if (wave == 0 && lane < 32) flag[lane] = 0u;
        if (wave == 1) { CLAS float* cst = (CLAS float*)(lds + O_CST); const int c = hh * 64 + lane;
            cst[lane] = mu[c]; cst[64 + lane] = mu[512 + c]; cst[128 + lane] = mu[1024 + c]; cst[192 + lane] = k_k[c]; cst[256 + lane] = k_a[c]; cst[320 + lane] = r_k[c]; }
        __syncthreads();
        if (three) {
            unsigned char* gring = gring0 + (size_t)bh * (GRING * REC); unsigned* gflag = gflag0 + bh * (GRING * 64); unsigned* gack = gack0 + bh * (GRING * 64);
            if (role < 2) prep_wave<true, 16, true, 0, 2>(lds, flag, wave, 2 * wave + role, lane, hh, mb, true, PROJ, DECB, ALPHA, BONUS, ROT, gring, gflag, gack, ep0);
            else if (role == 2) rwkv_consumer(lds, flag, wave, lane, hh, mb, YR, gring, gflag, gack, ep0);
            else { if (wave < 4) scan_wave<false, 0>(lds, flag, wave, lane, wave * 16, hh, mb, YR);
                   else prep_wave<false, 4, false, 0, 4>(lds, flag, wave - 4, wave - 4, lane, hh, mb, false, PROJ, DECB, ALPHA, BONUS, ROT, nullptr, nullptr, nullptr, 0u); }
        } else if (!rw) {
            if (wave < 2) scan_wave<false, probe>(lds, flag, wave, lane, half * 32 + wave * 16, hh, mb, YR);
            else prep_wave<false, 6, false, probe>(lds, flag, wave - 2, wave - 2, lane, hh, mb, false, PROJ, DECB, ALPHA, BONUS, ROT, nullptr, nullptr, nullptr, 0u);
        } else {
            if (wave < 1) scan_wave2<true, probe>(lds, flag, wave, lane, half * 32, hh, mb, YR);
            else prep_wave<true, 7, false, probe, 1>(lds, flag, wave - 1, wave - 1, lane, hh, mb, half == 0, PROJ, DECB, ALPHA, BONUS, ROT, nullptr, nullptr, nullptr, 0u);
        }
    }
    __syncthreads();
}
#undef CK_MFMA
#undef CK_LOAD
#undef CK_U
#undef CK_H
#undef CLAS
}
#ifndef REP_SCAN
#define REP_SCAN 1
#endif
#ifndef REP_DATTN
#define REP_DATTN 1
#endif
#ifndef REP_MLP1
#define REP_MLP1 1
#endif
#ifndef REP_W
#define REP_W 1
#endif
#ifndef REP_XL
#define REP_XL 1
#endif
#ifndef REP_P6
#define REP_P6 1
#endif
#ifndef REP_P9
#define REP_P9 1
#endif
#ifndef LORA_ALIGN
#define LORA_ALIGN false
#endif
#ifndef P1_REV_ODD
#define P1_REV_ODD 1
#endif
#ifndef LORA_KTRIM
#define LORA_KTRIM 1
#endif
#ifndef HIDLD
#define HIDLD DFF
#endif
#ifndef BOUS
#define BOUS 1
#endif
#ifndef P1_REV
#define P1_REV 1
#endif
#ifndef REP_P12
#define REP_P12 1
#endif
#ifndef PROBE_P9_MODE
#define PROBE_P9_MODE 0
#endif
#ifndef PROBE_MLP1_HOT
#define PROBE_MLP1_HOT 0
#endif
#ifndef PROBE_MLP1_ROWS
#define PROBE_MLP1_ROWS NTOK
#endif
#ifndef REP_P1
#define REP_P1 1
#endif
#ifndef REP_P3
#define REP_P3 1
#endif
#ifndef HOIST_L2
#define HOIST_L2 0
#endif
#ifndef GROUP_SEAMS
#define GROUP_SEAMS 0
#endif
#ifndef PROBE_CK
#define PROBE_CK 0
#endif
#ifndef PG8_ALIGN_BIG
#define PG8_ALIGN_BIG PG8_ALIGN
#endif
#ifndef PROBE_DATTN_NOBAR
#define PROBE_DATTN_NOBAR false
#endif
#ifndef HOIST_FOLDS
#define HOIST_FOLDS 1
#endif
#ifndef MLP2_REV
#define MLP2_REV 1
#endif
#ifndef REP_LOGITS
#define REP_LOGITS 1
#endif
#ifndef REP_NORM
#define REP_NORM 1
#endif
struct Args { const float* in[34]; float* out; unsigned char* ws; int ph_lo, ph_hi, li, pad; };
typedef const __attribute__((address_space(4))) Args* ArgsP;
__device__ __forceinline__ const float* ldarg(ArgsP p, int k) { asm volatile("" : "+s"(p)); return p->in[k]; }
#define INP(k) ldarg(ap0, k)
__device__ __forceinline__ bf16* wptr(unsigned char* ws, unsigned char* outb, int layer, int which) {
    const bool odd = layer & 1;
    unsigned char* ob = outb + 64 * MiB;
    unsigned char* eb = (layer == 0 || !HOIST_L2) ? ws + WS_W : outb + 92 * MiB;
    switch (which) {
        case 0: return (bf16*)(odd ? ob : eb + WO_IN * 2);
        case 1: return (bf16*)(odd ? ob + 6 * MiB : eb + WO_OUT * 2);
        case 2: return (bf16*)(odd ? ob + 8 * MiB : eb + WO_Q * 2);
        case 3: return (bf16*)(odd ? ob + 10 * MiB : eb + WO_O * 2);
        case 4: return (bf16*)(odd ? ob + 12 * MiB : eb + WO_1 * 2);
        case 5: return (bf16*)(odd ? ob + 20 * MiB : eb + WO_2 * 2);
        default: return (bf16*)(eb + WO_KV * 2);
    }
}
__device__ __forceinline__ void convert_layer(ArgsP ap0, unsigned char* ws, unsigned char* outb, int layer, int gwv, int ngw, int gt, int ngt, int lane, LAS float* scr) {
    const int li = layer >> 1; const bool even = (layer & 1) == 0;
    bf16* Win = wptr(ws, outb, layer, 0); bf16* Wout = wptr(ws, outb, layer, 1); bf16* Wq = wptr(ws, outb, layer, 2); bf16* Wo = wptr(ws, outb, layer, 3);
    bf16* W1 = wptr(ws, outb, layer, 4); bf16* W2 = wptr(ws, outb, layer, 5); bf16* Wkv = wptr(ws, outb, layer, 6);
            const int nin = even ? HYB : QKVW;
            const float* w_in = even ? INP(13) + (size_t)li * 1024 * HYB : INP(27) + (size_t)li * 1024 * QKVW;
            const float* w_out = even ? INP(26) + (size_t)li * 1024 * 1024 : INP(33) + (size_t)li * 1024 * 1024;
            const float* w_q = INP(8) + (size_t)layer * 1024 * 1024; const float* w_kv = INP(9) + (size_t)layer * 1024 * 2048; const float* w_o = INP(10) + (size_t)layer * 1024 * 1024;
            const float* w_1 = INP(11) + (size_t)layer * 1024 * 4096; const float* w_2 = INP(12) + (size_t)layer * 4096 * 1024;
            const int c_in = 16 * (nin / 32), c_sq = 16 * 32, c_kv = even ? 2 * 16 * 64 : 0, c_1 = 16 * 128, c_2 = 64 * 32;
            const int total = c_in + 2 * c_sq + c_kv + c_1 + c_2;
            for (int it = gwv; it < total; it += ngw) {
                int r = it;
                if (r < c_in) { transpose_item(w_in, 1024, nin, Win, scr, r, lane, INP(5) + layer * 1024); continue; } r -= c_in;
                if (r < c_sq) { transpose_item(w_out, 1024, 1024, Wout, scr, r, lane, nullptr); continue; } r -= c_sq;
                if (r < c_kv) { if (r < 16 * 64) transpose_item(w_kv, 1024, 2048, Wkv, scr, r, lane, nullptr); else transpose_item(w_kv + (size_t)1024 * 2048, 1024, 2048, (bf16*)(ws + WS_WKV2), scr, r - 16 * 64, lane, nullptr); continue; } r -= c_kv;
                if (r < c_sq) { transpose_item(w_o, 1024, 1024, Wo, scr, r, lane, nullptr); continue; } r -= c_sq;
                if (r < c_1) { transpose_item(w_1, 1024, 4096, W1, scr, r, lane, INP(7) + layer * 1024); continue; } r -= c_1;
                transpose_item(w_2, 4096, 1024, W2, scr, r, lane, nullptr);
            }
            for (int i = gt * 8; i < 1024 * 1024; i += ngt * 8) {
                const float g_ = INP(6)[layer * 1024 + (i >> 10)]; const f32x4 a = __builtin_nontemporal_load((const f32x4*)(w_q + i)) * g_, c = __builtin_nontemporal_load((const f32x4*)(w_q + i + 4)) * g_; v4u o; o.x = pk2(a.x, a.y); o.y = pk2(a.z, a.w); o.z = pk2(c.x, c.y); o.w = pk2(c.z, c.w); __builtin_nontemporal_store(o, (v4u*)(Wq + i)); }
            if (even) {
                const float* w2 = INP(16) + (size_t)li * 64 * 512; const float* a2 = INP(18) + (size_t)li * 64 * 512; const float* g2 = INP(19) + (size_t)li * 128 * 512;
                for (int i = gt; i < 1536 * 32; i += ngt) { const int n = i >> 5, k0 = (i & 31) * 8; float v[8];
#pragma unroll
                    for (int e = 0; e < 8; ++e) { const int k = k0 + e; v[e] = n < 512 ? (k < 64 ? w2[k * 512 + n] : 0.f) : n < 1024 ? ((k >= 64 && k < 128) ? a2[(k - 64) * 512 + n - 512] : 0.f) : (k >= 128 ? g2[(k - 128) * 512 + n - 1024] : 0.f); }
                    v4u o; o.x = pk2(v[0], v[1]); o.y = pk2(v[2], v[3]); o.z = pk2(v[4], v[5]); o.w = pk2(v[6], v[7]); *(v4u*)((bf16*)(ws + WS_LW) + (size_t)n * 256 + k0) = o; }
            }
}
#ifndef PF_W
#define PF_W 1
#endif
__device__ __forceinline__ void pf_w(const bf16* W, int N, int K, bool tail, int bid, int wave0) {
    if (!PF_W) return;
    int lane; asm volatile("v_mbcnt_lo_u32_b32 %0, -1, 0\n\tv_mbcnt_hi_u32_b32 %0, -1, %0" : "=v"(lane));
    const int idx = (bid >> 3) * 512 + wave0 * 64 + lane;
    if (idx < N * 4) { const int n = idx >> 2, l = idx & 3; const char* p = (const char*)(W + (size_t)n * K) + (tail ? (K * 2 - 512) : 0) + l * 128; unsigned d;
        asm volatile("global_load_dword %0, %1, off\n\ts_waitcnt vmcnt(0)" : "=v"(d) : "v"(p) : "memory"); }
}
__global__ void __launch_bounds__(NWAVES * 64, 2) fwd(Args args) {
    const ArgsP ap0 = (ArgsP)__builtin_amdgcn_kernarg_segment_ptr();
#define INP(k) ldarg(ap0, k)
    extern __shared__ __attribute__((aligned(16))) unsigned char lds_raw[];
    LAS unsigned char* lds = (LAS unsigned char*)lds_raw;
    const int tid0 = threadIdx.x; const int wave0 = __builtin_amdgcn_readfirstlane(tid0 >> 6);
    const int G = gridDim.x, bid = blockIdx.x, NGW = G * NWAVES;
    unsigned char* ws = args.ws;
    for (int u = tid0; u < (LDS_BYTES - LDSCTL_OFF) / 4; u += NWAVES * 64) ((LAS unsigned*)(lds + LDSCTL_OFF))[u] = 0u;
    __syncthreads();
    volatile LAS unsigned* MISC = (volatile LAS unsigned*)(lds + MISC_OFF);
    XcdBarrier bar = xcd_barrier_post((unsigned*)(ws + WS_CTL) + CW_BAR + args.li * XCD_BAR_WORDS, MISC + 8);
    const int lo = args.ph_lo, hi = args.ph_hi;
#define IN(k) (lo <= (k) && (k) < hi)
#define PHASE_IDS() int lane; asm volatile("v_mbcnt_lo_u32_b32 %0, -1, 0\n\tv_mbcnt_hi_u32_b32 %0, -1, %0" : "=v"(lane)); const int tid = wave0 * 64 + lane, wave = wave0, gw = bid * NWAVES + wave; (void)tid; (void)gw
#define SEAM2(k, nx) do { if (IN(k) && IN(nx)) xcd_barrier(bar, wave0); } while (0)
    unsigned* gcnt = (unsigned*)(ws + WS_CTL + 128 * 1024) + (bid & 7) * 64 + args.li * 1024; unsigned ggen = 0u; const bool grouped = (G % 8 == 0) && GROUP_SEAMS;
#define SEAMG(k, nx) do { if (IN(k) && IN(nx)) { if (grouped) grp_barrier(gcnt, (unsigned)(G / 8), ggen, (unsigned*)(ws + WS_CTL) + CW_BAR + args.li * XCD_BAR_WORDS + XB_TMO); else xcd_barrier(bar, wave0); } } while (0)
    const float* x = INP(0); float* out = args.out; bf16* U = (bf16*)args.out;
    bf16* MEMN = (bf16*)(ws + WS_MEMN); bf16* KVB = (bf16*)(ws + WS_KV); bf16* WB = (bf16*)(ws + WS_W); bf16* HN = (bf16*)(ws + WS_HN); bf16* BIG = (bf16*)(ws + WS_BIG);
    bf16* WQK = (bf16*)(ws + WS_WQK); bf16* VWO = (bf16*)(ws + WS_VWO); bf16* LW = (bf16*)(ws + WS_LW); bf16* XL = (bf16*)(ws + WS_XL);
    bf16* DECB = (bf16*)(ws + WS_DEC); bf16* ALPHA = (bf16*)(ws + WS_ALPHA); bf16* GGB = (bf16*)(ws + WS_G); float* BONUS = (float*)(ws + WS_BONUS); float* SSP = (float*)(ws + WS_SSP); mix::f32x2* ROT = (mix::f32x2*)(ws + WS_ROT);

    for (int layer = 0; layer < 4; ++layer) {
        const int pb = layer * PH_PER_LAYER, li = layer >> 1; const bool even = (layer & 1) == 0;
        unsigned char* outb = (unsigned char*)args.out;
        bf16* Win = wptr(ws, outb, layer, 0); bf16* Wout = wptr(ws, outb, layer, 1); bf16* Wq = wptr(ws, outb, layer, 2); bf16* Wo = wptr(ws, outb, layer, 3); bf16* W1 = wptr(ws, outb, layer, 4); bf16* W2 = wptr(ws, outb, layer, 5);
        const bool foldh = HOIST_FOLDS && even && (G == 256) && !THREE_ROLE && !HOIST_L2;
        bf16* WQKl = foldh ? (bf16*)(outb + 92 * MiB) : WQK; bf16* VWOl = foldh ? (bf16*)(outb + 108 * MiB) : VWO;
        bf16* Ua = U; bf16* Ub = U;
        if ((layer == 0 || (!HOIST_L2 && even)) && IN(pb + 0)) for (int rep_ = 0; rep_ < REP_W; ++rep_) { if (rep_) xcd_barrier(bar, wave0); PHASE_IDS();
            LAS float* scr = (LAS float*)(lds + wave * 16384);
            convert_layer(ap0, ws, (unsigned char*)args.out, layer, gw, NGW, bid * 512 + tid, G * 512, lane, scr);
            if (layer == 0) {
                for (int i = bid * 512 + tid; i < 4096 * 32; i += G * 512) { const int t = i >> 5, fi = i & 31; const float inv = exp2f(-(float)(2 * fi) * (1.f / 64.f) * 13.287712379549449f); const float ang = (float)t * inv;
                    float sn, cs; sincosf(ang, &sn, &cs); mix::f32x2 v; v.x = cs; v.y = sn; ROT[i] = v; }
                for (int m = gw; m < MROWS; m += NGW) rms_row_to_bf16(INP(1) + (size_t)m * 1024, INP(3), MEMN + (size_t)m * 1024, lane);
            }
            if (layer == 0) for (int m = gw; m < NTOK; m += 4 * NGW) rows4_to_bf16_ss(x, Ua, SSP, m, NGW, NTOK, lane);
        }
        if (layer == 0 || (!HOIST_L2 && even)) SEAM2(pb + 0, pb + 1);
        if (IN(pb + 1)) for (int rep_ = 0; rep_ < REP_P1; ++rep_) { if (rep_) xcd_barrier(bar, wave0); PHASE_IDS();
            if (even) { const pg8::Gemm g = pg8::gemm_plain(Ua, Win, NTOK, HYB, 1024); pg8::StaticOrder S; S.init(g, G, bid); S.rev = P1_REV;     pg8::EpiBf16<0, true> E{BIG, HYB, 1, 0, 0, 1.f, 0, SSP, (LAS float*)(lds + XCH_OFF + 8192)};
                pg8::gemm_phase<pg8::EpiBf16<0, true>, pg8::StaticOrder, PG8_ALIGN_BIG, PG8_SP2>(lds, g, S, E, tid); }
            else { const pg8::Gemm g = pg8::gemm_plain(Ua, Win, NTOK, QKVW, 1024); pg8::StaticOrder S; S.init(g, G, bid); S.rev = P1_REV_ODD; pg8::EpiBf16<0, true> E{BIG, QKVW, 1, 0, 0, dattn::C2, 1024, SSP, (LAS float*)(lds + XCH_OFF + 8192)};
                pg8::gemm_phase<pg8::EpiBf16<0, true>, pg8::StaticOrder, PG8_ALIGN_BIG, PG8_SP2>(lds, g, S, E, tid); }
            if (even) {
                { const pg8::Gemm g = pg8::gemm_plain(MEMN, wptr(ws, outb, layer, 6), MROWS, 2048, 1024); pg8::StaticOrder S; S.init(g, G, (bid + G / 2) % G); pg8::EpiBf16<0> E{KVB, 2048, 1, 0, 0, 1.f, 0, nullptr, nullptr};
                  pg8::gemm_phase<pg8::EpiBf16<0>, pg8::StaticOrder, PG8_ALIGN, PG8_SP2>(lds, g, S, E, tid); }
                { const pg8::Gemm g = pg8::gemm_plain(MEMN, (const bf16*)(ws + WS_WKV2), MROWS, 2048, 1024); pg8::StaticOrder S; S.init(g, G, (bid + G / 4) % G); pg8::EpiBf16<0> E{(bf16*)(ws + WS_KV2), 2048, 1, 0, 0, 1.f, 0, nullptr, nullptr};
                  pg8::gemm_phase<pg8::EpiBf16<0>, pg8::StaticOrder, PG8_ALIGN, PG8_SP2>(lds, g, S, E, tid); }
            }
        }
        if (even) {
            SEAM2(pb + 1, pb + 3);
            if (IN(pb + 3)) for (int rep_ = 0; rep_ < REP_P3; ++rep_) { if (rep_) xcd_barrier(bar, wave0); { PHASE_IDS(); const pg8::Gemm g = pg8::gemm_plain(XL, LW, NTOK, 1536, 256); pg8::PanelOrder S; S.init(g, G, bid);
                  pg8::Unit u_; int last = -1; for (int i = 0; S.next(i, u_); ++i) if (u_.pm != last) { last = u_.pm; mix::xl_phase(tid, 512, BIG, INP(14) + li * 1792, XL, u_.pm * 256, 256); } }
                asm volatile("s_waitcnt vmcnt(0)" ::: "memory"); __syncthreads();
                PHASE_IDS();
                if (LORA_KTRIM) {
                    _Pragma("unroll 1") for (int c2_ = 0; c2_ < 2; ++c2_) { int c2 = c2_; asm volatile("" : "+s"(c2));     int kv_ = 128; asm volatile("" : "+s"(kv_)); pg8::Gemm g = pg8::gemm_plain(XL + c2 * 128, LW + (size_t)c2 * (1024 * 256 + 128), NTOK, c2 ? 512 : 1024, kv_); g.lda = 256; g.ldb = 256; pg8::PanelOrder S; S.init(g, G, bid);
                        pg8::EpiLora E{ws, WS_DEC, WS_ALPHA, WS_G, INP(15) + li * 512, INP(17) + li * 512, c2 * 4};
                        pg8::gemm_phase<pg8::EpiLora, pg8::PanelOrder, LORA_ALIGN, PG8_SP2>(lds, g, S, E, tid); } }
                else { const pg8::Gemm g = pg8::gemm_plain(XL, LW, NTOK, 1536, 256); pg8::PanelOrder S; S.init(g, G, bid);
                pg8::EpiLora E{ws, WS_DEC, WS_ALPHA, WS_G, INP(15) + li * 512, INP(17) + li * 512};
                pg8::gemm_phase<pg8::EpiLora, pg8::PanelOrder, LORA_ALIGN, PG8_SP2>(lds, g, S, E, tid); } }
            SEAM2(pb + 3, pb + 4);
            if (IN(pb + 4)) for (int rep_ = 0; rep_ < REP_SCAN; ++rep_) { if (rep_) xcd_barrier(bar, wave0); PHASE_IDS();
                if (rep_ + 1 < REP_SCAN) ck::phase<PROBE_CK>(lds, bid, G, wave, lane, BIG, DECB, ALPHA, HN, BONUS, (const ck::f32x2*)ROT, INP(14) + li * 1792, INP(20) + li * 512, INP(21) + li * 512, INP(22) + li * 512,
                    ws + WS_XL, (unsigned*)(ws + WS_CTL + 256 * 1024), (unsigned*)(ws + WS_CTL + 512 * 1024), (unsigned)(li * REP_SCAN + rep_) * 1024u);
                else ck::phase<0>(lds, bid, G, wave, lane, BIG, DECB, ALPHA, HN, BONUS, (const ck::f32x2*)ROT, INP(14) + li * 1792, INP(20) + li * 512, INP(21) + li * 512, INP(22) + li * 512,
                    ws + WS_XL, (unsigned*)(ws + WS_CTL + 256 * 1024), (unsigned*)(ws + WS_CTL + 512 * 1024), (unsigned)(li * REP_SCAN + rep_) * 1024u); }
            if (IN(pb + 4)) { PHASE_IDS();
                    LAS float* scr = (LAS float*)(lds + wave * 16384);
                    const int vcu_ = (G % 8 == 0) ? (bid % 8) * (G / 8) + bid / 8 : bid;
                    if (foldh && vcu_ >= 128) {
                        { const pg8::Gemm g{KVB, Wq, 256, 1024, 256, 2048, 1024, 32, 4, (size_t)256 * 2048, 256, 0, 256}; pg8::StaticOrder S; S.init(g, 128, vcu_ - 128);
                          pg8::EpiBf16<0> E{WQKl, 1024, 4, (size_t)1024 * 1024, (size_t)256 * 1024, 0.0625f * 1.4426950408889634f, 1 << 30, nullptr, nullptr};
                          pg8::gemm_phase<pg8::EpiBf16<0>, pg8::StaticOrder, PG8_ALIGN, PG8_SP2>(lds, g, S, E, tid); }
                        { const pg8::Gemm g{Wo, KVB + 1024, 1024, 256, 256, 1024, 2048, 32, 4, 0, 256, (size_t)256 * 2048, 256}; pg8::StaticOrder S; S.init(g, 128, vcu_ - 128);
                          pg8::EpiBf16<0> E{VWOl, 1024, 4, (size_t)1024 * 1024, 256, 1.f, 0, nullptr, nullptr};
                          pg8::gemm_phase<pg8::EpiBf16<0>, pg8::StaticOrder, PG8_ALIGN, PG8_SP2>(lds, g, S, E, tid); }
                        __syncthreads(); }
                    for (int nl = layer + 1; nl <= ((layer == 0 && HOIST_L2) ? 2 : layer + 1); ++nl) {
                        if (G == 256 && THREE_ROLE) { const int role_ = vcu_ & 3, hidx = (vcu_ >> 2) * 3 + (role_ == 3 ? 2 : role_);
                            if (role_ != 2) convert_layer(ap0, ws, (unsigned char*)args.out, nl, hidx * NWAVES + wave, 192 * NWAVES, hidx * 512 + tid, 192 * 512, lane, scr); }
                        else if (G == 256) { if (vcu_ >= 128) convert_layer(ap0, ws, (unsigned char*)args.out, nl, (vcu_ - 128) * NWAVES + wave, 128 * NWAVES, (vcu_ - 128) * 512 + tid, 128 * 512, lane, scr); }
                        else convert_layer(ap0, ws, (unsigned char*)args.out, nl, gw, NGW, bid * 512 + tid, G * 512, lane, scr); } }
            SEAM2(pb + 4, pb + 5);
            if (IN(pb + 5)) { PHASE_IDS(); mix::post_phase_v(gw, NGW, lane, BIG, HN, GGB, BONUS, INP(14) + li * 1792 + 1024, INP(23) + li * 512, INP(24) + li * 512, INP(25) + li * 512); }
            pf_w(Wout, 1024, 1024, false, bid, wave0); SEAM2(pb + 5, pb + 6);
        } else {
            SEAM2(pb + 1, pb + 4);
            if (IN(pb + 4)) for (int rep_ = 0; rep_ < REP_DATTN; ++rep_) { if (rep_) xcd_barrier(bar, wave0); PHASE_IDS();
                const float lam_init = layer == 1 ? 0.35550906f : 0.55605818f;
                const float d1 = wave_sum(INP(28)[li * 64 + lane] * INP(29)[li * 64 + lane]), d2 = wave_sum(INP(30)[li * 64 + lane] * INP(31)[li * 64 + lane]);
                const float lam = expf(d1) - expf(d2) + lam_init;
                if (rep_ + 1 < REP_DATTN) dattn::phase<PROBE_DATTN_NOBAR>(lds, bid, G, tid, BIG, HN, INP(2), INP(32) + li * 128, lam, lam_init);
                else dattn::phase<false>(lds, bid, G, tid, BIG, HN, INP(2), INP(32) + li * 128, lam, lam_init); }
            pf_w(Wout, 1024, 1024, false, bid, wave0); SEAM2(pb + 4, pb + 6);
        }
        if (IN(pb + 6)) for (int rep_ = 0; rep_ < REP_P6; ++rep_) { if (rep_) xcd_barrier(bar, wave0); PHASE_IDS();
            { const pg8::Gemm g = pg8::gemm_plain(HN, Wout, NTOK, 1024, 1024); pg8::StaticOrder S; S.init(g, G, bid); pg8::EpiResid E{Ua, rep_ + 1 < REP_P6 ? BIG : Ub, 1024, 0, SSP, (LAS float*)(lds + XCH_OFF), NTOK};
              pg8::gemm_phase<pg8::EpiResid, pg8::StaticOrder, PG8_ALIGN, PG8_SP2>(lds, g, S, E, tid); }
            const bf16* KVc = (const bf16*)(ws + WS_KV + (size_t)(layer & 1) * (WS_KV2 - WS_KV));
            if (!foldh) { const pg8::Gemm g{KVc, Wq, 256, 1024, 256, 2048, 1024, 32, 4, (size_t)256 * 2048, 256, 0, 256}; pg8::StaticOrder S; S.init(g, G, bid);
              pg8::EpiBf16<0> E{WQKl, 1024, 4, (size_t)1024 * 1024, (size_t)256 * 1024, 0.0625f * 1.4426950408889634f, 1 << 30, nullptr, nullptr};
              pg8::gemm_phase<pg8::EpiBf16<0>, pg8::StaticOrder, PG8_ALIGN, PG8_SP2>(lds, g, S, E, tid); }
            if (!foldh) { const pg8::Gemm g{Wo, KVc + 1024, 1024, 256, 256, 1024, 2048, 32, 4, 0, 256, (size_t)256 * 2048, 256}; pg8::StaticOrder S; S.init(g, G, (bid + G / 2) % G);
              pg8::EpiBf16<0> E{VWOl, 1024, 4, (size_t)1024 * 1024, 256, 1.f, 0, nullptr, nullptr};
              pg8::gemm_phase<pg8::EpiBf16<0>, pg8::StaticOrder, PG8_ALIGN, PG8_SP2>(lds, g, S, E, tid); }
        }
        SEAMG(pb + 6, pb + 8);
        if (IN(pb + 8)) for (int rep_ = 0; rep_ < REP_LOGITS; ++rep_) { if (rep_) xcd_barrier(bar, wave0); PHASE_IDS(); const pg8::Gemm g{Ub, WQKl, SEQ, 1024, 1024, 1024, 1024, 8, 1, (size_t)SEQ * 1024, 0, (size_t)1024 * 1024, 0}; pg8::StaticOrder S; S.init(g, G, bid); S.rev = BOUS;
            pg8::EpiSoftmax E{BIG, 1024, (size_t)SEQ * 1024, (LAS float*)(lds + XCH_OFF), SSP, SEQ, (LAS float*)(lds + XCH_OFF + 8192)};
            pg8::gemm_phase<pg8::EpiSoftmax, pg8::StaticOrder, true, PG8_SP2>(lds, g, S, E, tid); }
        SEAMG(pb + 8, pb + 9);
        if (IN(pb + 9)) for (int rep_ = 0; rep_ < REP_P9; ++rep_) { if (rep_) xcd_barrier(bar, wave0); PHASE_IDS(); const pg8::Gemm g{BIG, VWOl, (rep_ + 1 < REP_P9 && PROBE_P9_MODE == 9) ? 0 : SEQ, 1024, 1024, 1024, 1024, 8, 1, (size_t)SEQ * 1024, 0, (size_t)1024 * 1024, 0}; pg8::StaticOrder S; S.init(g, G, bid); pg8::EpiResid E{Ub, rep_ + 1 < REP_P9 ? HN : Ua, 1024, (size_t)SEQ * 1024, SSP, (LAS float*)(lds + XCH_OFF), SEQ, (rep_ + 1 < REP_P9) ? PROBE_P9_MODE : 0};
            pg8::gemm_phase<pg8::EpiResid, pg8::StaticOrder, PG8_ALIGN, PG8_SP2>(lds, g, S, E, tid); }
        pf_w(W1, DFF, 1024, false, bid, wave0); SEAMG(pb + 9, pb + 11);
        if (IN(pb + 11)) for (int rep_ = 0; rep_ < REP_MLP1; ++rep_) { if (rep_) xcd_barrier(bar, wave0); PHASE_IDS(); pg8::Gemm g = pg8::gemm_plain(Ua, W1, (rep_ + 1 < REP_MLP1) ? PROBE_MLP1_ROWS : NTOK, DFF, 1024); if (PROBE_MLP1_HOT == 1 && rep_ + 1 < REP_MLP1) { g.lda = 0; g.ldb = 0; } if (PROBE_MLP1_HOT == 2 && rep_ + 1 < REP_MLP1) { g.M = 256; g.N = 256; g.nz = 2048; g.zdiv = 1; g.sA1 = 0; g.sA2 = 0; g.sB1 = 0; g.sB2 = 0; }     pg8::StaticOrder S; S.init(g, G, bid); S.rev = BOUS; pg8::EpiBf16<1, true> E{BIG, HIDLD, 1, 0, 0, 1.f, 0, SSP, (LAS float*)(lds + XCH_OFF + 8192)};
            pg8::gemm_phase<pg8::EpiBf16<1, true>, pg8::StaticOrder, PG8_ALIGN_BIG, PG8_SP2>(lds, g, S, E, tid); }
        pf_w(W2, 1024, DFF, MLP2_REV && !BOUS, bid, wave0); SEAMG(pb + 11, pb + 12);
        if (IN(pb + 12)) for (int rep_ = 0; rep_ < REP_P12; ++rep_) { if (rep_) xcd_barrier(bar, wave0); PHASE_IDS(); pg8::Gemm g = pg8::gemm_plain(BIG, W2, NTOK, 1024, DFF); g.lda = HIDLD; g.krev = (MLP2_REV && !BOUS) ? 2 : 0; pg8::StaticOrder S; S.init(g, G, bid); S.rev = MLP2_REV && !BOUS;     pg8::EpiResid E{Ua, (layer == 3 || rep_ + 1 < REP_P12) ? HN : Ub, 1024, 0, SSP, (LAS float*)(lds + XCH_OFF), NTOK};
            pg8::gemm_phase<pg8::EpiResid, pg8::StaticOrder, PG8_ALIGN, PG8_SP2>(lds, g, S, E, tid); }
        if (layer == 0 || layer == 2) pf_w(wptr(ws, (unsigned char*)args.out, layer + 1, 0), QKVW, 1024, false, bid, wave0);
        if (layer < 3) SEAMG(pb + 12, pb + 13); else SEAM2(pb + 12, pb + 13);
    }
    if (IN(PH_FINAL)) { PHASE_IDS(); for (int m = gw; m < NTOK; m += 4 * NGW) rows4_bf16_to_f32_norm(HN, INP(4), out, m, NGW, NTOK, lane); }
#undef IN
#undef SEAM2
#undef SEAMG
}

extern "C" void kernel_launch(void* const* d_in, const int* in_sizes, int n_in, void* d_out, int out_size, void* d_ws, size_t ws_size, hipStream_t stream) {
    static int grid = 0;
    if (grid == 0) {
        if (n_in != 34 || out_size != NTOK * DM || ws_size < WS_END) { fprintf(stderr, "kernel_launch: unexpected shapes (n_in %d out %d ws %zu)\n", n_in, out_size, ws_size); grid = -1; return; }
        int dev = 0, cus = 0;
        if (hipGetDevice(&dev) != hipSuccess || hipDeviceGetAttribute(&cus, hipDeviceAttributeMultiprocessorCount, dev) != hipSuccess) { grid = -1; return; }
        if (hipFuncSetAttribute((const void*)fwd, hipFuncAttributeMaxDynamicSharedMemorySize, LDS_BYTES) != hipSuccess) { grid = -1; return; }
        int per_cu = 0;
        (void)hipOccupancyMaxActiveBlocksPerMultiprocessor(&per_cu, (const void*)fwd, NWAVES * 64, LDS_BYTES);
        (void)hipGetLastError();
        grid = cus;
    }
    if (grid < 0) return;
    (void)hipMemsetAsync((char*)d_ws + WS_CTL, 0, CTL_ZERO_BYTES, stream);
    Args a{};
    for (int i = 0; i < 34; ++i) a.in[i] = (const float*)d_in[i];
    a.out = (float*)d_out; a.ws = (unsigned char*)d_ws;
    a.ph_lo = 0; a.ph_hi = PH_TOTAL; a.li = 0;
    hipLaunchKernelGGL(fwd, dim3(grid), dim3(NWAVES * 64), LDS_BYTES, stream, a);
}
```
